# Optimizing an MI355X kernel written in HIP

```python
import math
import jax, jax.numpy as jnp
from jax import lax
import numpy as np

D_MODEL = 1024
BATCH = 8
SEQ = 4096
DEPTH = 2

CHUNK = 64
POOL_W = 256
POOL_WINDOWS = (2, 4, 8, 16)
POOL_GROUPS = len(POOL_WINDOWS)
POOL_GC = POOL_W // POOL_GROUPS
CONV_W = 256
CONV_K = 31
N_HEADS = 4
QK_NOPE = 128
QK_ROPE = 64
QK_HEAD = QK_NOPE + QK_ROPE
V_DIM = 128
Q_LORA = 256
KV_LORA = 128
ATTN_W = N_HEADS * V_DIM
ROPE_THETA = 10000.0
Q_BLOCK = 128
D_MIX = POOL_W + CONV_W + ATTN_W
D_IN = POOL_W + 2 * CONV_W + Q_LORA + KV_LORA + QK_ROPE
N_EXPERTS = 32
TOP_K = 4
D_FF = D_MODEL
SWIGLU_LIMIT = 7.0
SWIGLU_ALPHA = 1.702
EXPERT_BLOCK = 256
EPS = 1e-6

kernel_name = "hybrid_pool_conv_mla_moe_chunk_causal"


def rmsnorm(x, g):
    xf = x.astype(jnp.float32)
    y = xf * lax.rsqrt(jnp.mean(xf * xf, axis=-1, keepdims=True) + EPS)
    return (y * g.astype(jnp.float32)).astype(x.dtype)


def layernorm(x, g, b):
    xf = x.astype(jnp.float32)
    mu = jnp.mean(xf, axis=-1, keepdims=True)
    var = jnp.mean(jnp.square(xf - mu), axis=-1, keepdims=True)
    y = (xf - mu) * lax.rsqrt(var + EPS) * g.astype(jnp.float32) + b.astype(jnp.float32)
    return y.astype(x.dtype)


def rope_tables(positions):
    inv_freq = 1.0 / (ROPE_THETA ** (jnp.arange(0, QK_ROPE, 2, dtype=jnp.float32) / QK_ROPE))
    ang = positions.astype(jnp.float32)[..., None] * inv_freq
    return jnp.cos(ang), jnp.sin(ang)


def apply_rope(x, cos, sin):
    xf = x.astype(jnp.float32)
    x1, x2 = xf[..., : QK_ROPE // 2], xf[..., QK_ROPE // 2:]
    c, s = cos[:, :, None, :], sin[:, :, None, :]
    return jnp.concatenate([x1 * c - x2 * s, x2 * c + x1 * s], axis=-1).astype(x.dtype)


def pool_mixer(u, w_pool, pool_scale):
    B, S, _ = u.shape
    uf = u.astype(jnp.float32)
    cs = jnp.cumsum(uf, axis=1)
    cs = jnp.concatenate([jnp.zeros_like(cs[:, :1]), cs], axis=1)
    csg = cs.reshape(B, S + 1, POOL_GROUPS, POOL_GC)
    ug = uf.reshape(B, S, POOL_GROUPS, POOL_GC)
    t = jnp.arange(S)
    outs = []
    for g, w in enumerate(POOL_WINDOWS):
        lo = jnp.maximum(t + 1 - w, 0)
        win_sum = csg[:, 1:, g] - csg[:, lo, g]
        cnt = jnp.minimum(t + 1, w).astype(jnp.float32)[None, :, None]
        outs.append(win_sum / cnt - ug[:, :, g])
    pooled = jnp.stack(outs, axis=2).astype(u.dtype)
    y = jnp.einsum('bsgc,gcd->bsgd', pooled, w_pool) * pool_scale.reshape(POOL_GROUPS, POOL_GC)
    return y.reshape(B, S, POOL_W)


def conv_mixer(u, conv_dw, conv_dw_b, conv_ln_g, conv_ln_b, conv_pw, conv_pw_b):
    a, gate = jnp.split(u, 2, axis=-1)
    v = a * jax.nn.sigmoid(gate)
    v = lax.conv_general_dilated(
        v, conv_dw[:, None, :], window_strides=(1,), padding=[(CONV_K - 1, 0)],
        dimension_numbers=('NWC', 'WIO', 'NWC'), feature_group_count=CONV_W) + conv_dw_b
    v = jax.nn.silu(layernorm(v, conv_ln_g, conv_ln_b))
    return v @ conv_pw + conv_pw_b


def chunk_causal_attention(q, k, v):
    B, S, H, Dh = q.shape
    nb = S // Q_BLOCK
    scale = 1.0 / math.sqrt(Dh)
    qb = q.reshape(B, nb, Q_BLOCK, H, Dh).transpose(1, 0, 2, 3, 4)
    k_chunk = jnp.arange(S) // CHUNK

    def one_block(args):
        qi, i = args
        s = jnp.einsum('bqhd,bkhd->bhqk', qi, k).astype(jnp.float32) * scale
        q_chunk = (i * Q_BLOCK + jnp.arange(Q_BLOCK)) // CHUNK
        mask = k_chunk[None, :] <= q_chunk[:, None]
        s = jnp.where(mask, s, -jnp.inf)
        p = jax.nn.softmax(s, axis=-1).astype(v.dtype)
        return jnp.einsum('bhqk,bkhd->bqhd', p, v)

    o = lax.map(one_block, (qb, jnp.arange(nb)))
    return o.transpose(1, 0, 2, 3, 4).reshape(B, S, H, v.shape[-1])


def mla_mixer(c_q, c_kv, k_rope, cos, sin, q_a_g, w_uq, kv_a_g, w_ukv, q_norm_g, k_norm_g):
    B, S, _ = c_q.shape
    q = (rmsnorm(c_q, q_a_g) @ w_uq).reshape(B, S, N_HEADS, QK_HEAD)
    kv = (rmsnorm(c_kv, kv_a_g) @ w_ukv).reshape(B, S, N_HEADS, QK_NOPE + V_DIM)
    k_nope, v = kv[..., :QK_NOPE], kv[..., QK_NOPE:]
    k = jnp.concatenate([k_nope, jnp.broadcast_to(k_rope[:, :, None, :], (B, S, N_HEADS, QK_ROPE))], axis=-1)
    q = rmsnorm(q, q_norm_g)
    k = rmsnorm(k, k_norm_g)
    q = jnp.concatenate([q[..., :QK_NOPE], apply_rope(q[..., QK_NOPE:], cos, sin)], axis=-1)
    k = jnp.concatenate([k[..., :QK_NOPE], apply_rope(k[..., QK_NOPE:], cos, sin)], axis=-1)
    return chunk_causal_attention(q, k, v).reshape(B, S, ATTN_W)


def moe_ffn(h, w_router, b_router, w_gu, b_gu, w_down, b_down):
    B, S, D = h.shape
    T = B * S
    ht = h.reshape(T, D)
    logits = (ht @ w_router).astype(jnp.float32) + b_router.astype(jnp.float32)
    top_vals, top_idx = lax.top_k(logits, TOP_K)
    gates = jax.nn.softmax(top_vals, axis=-1)
    flat_e = top_idx.reshape(-1)
    flat_tok = jnp.repeat(jnp.arange(T, dtype=jnp.int32), TOP_K)
    flat_g = gates.reshape(-1)
    order = jnp.argsort(flat_e)
    se = flat_e[order]
    counts = jnp.bincount(flat_e, length=N_EXPERTS)
    padded = (counts + EXPERT_BLOCK - 1) // EXPERT_BLOCK * EXPERT_BLOCK
    start = jnp.cumsum(counts) - counts
    pend = jnp.cumsum(padded)
    pstart = pend - padded
    dest = pstart[se] + (jnp.arange(T * TOP_K) - start[se])
    n_blocks = -(-(T * TOP_K) // EXPERT_BLOCK) + N_EXPERTS
    n_rows = n_blocks * EXPERT_BLOCK
    row_tok = jnp.full((n_rows,), T, dtype=jnp.int32).at[dest].set(flat_tok[order])
    row_gate = jnp.zeros((n_rows,), jnp.float32).at[dest].set(flat_g[order])
    block_exp = jnp.minimum(jnp.searchsorted(pend, jnp.arange(n_blocks) * EXPERT_BLOCK, side='right'),
                            N_EXPERTS - 1)
    x_pad = jnp.concatenate([ht, jnp.zeros((1, D), ht.dtype)], axis=0)

    def expert_block(args):
        tok_b, e = args
        xb = x_pad[tok_b]
        hgu = xb @ w_gu[e] + b_gu[e]
        x_glu = jnp.minimum(hgu[:, ::2], SWIGLU_LIMIT)
        x_lin = jnp.clip(hgu[:, 1::2], -SWIGLU_LIMIT, SWIGLU_LIMIT)
        act = x_glu * jax.nn.sigmoid(SWIGLU_ALPHA * x_glu) * (x_lin + 1.0)
        return act @ w_down[e] + b_down[e]

    yb = lax.map(expert_block, (row_tok.reshape(n_blocks, EXPERT_BLOCK), block_exp))
    yb = yb.reshape(n_rows, D) * row_gate[:, None].astype(yb.dtype)
    out = jnp.zeros((T + 1, D), yb.dtype).at[row_tok].add(yb)
    return out[:T].reshape(B, S, D)


def setup_inputs(seed: int = 0) -> dict:
    key = jax.random.key(seed)
    ks = jax.random.split(key, 32)
    L = DEPTH
    f32 = jnp.float32

    def nrm(k, shape, fan_in):
        return jax.random.normal(k, shape, f32) * (fan_in ** -0.5)

    def gain(k, shape):
        return 1.0 + 0.05 * jax.random.normal(k, shape, f32)

    def bias(k, shape, s=0.02):
        return s * jax.random.normal(k, shape, f32)

    x = jax.random.normal(ks[0], (BATCH, SEQ, D_MODEL), f32)
    offset = jax.random.randint(ks[1], (BATCH, 1), 0, 100000, dtype=jnp.int32)
    positions = offset + jnp.arange(SEQ, dtype=jnp.int32)[None, :]
    return {
        "x": x,
        "positions": positions,
        "attn_norm_g": gain(ks[2], (L, D_MODEL)),
        "w_in": nrm(ks[3], (L, D_MODEL, D_IN), D_MODEL),
        "pool_w": nrm(ks[4], (L, POOL_GROUPS, POOL_GC, POOL_GC), POOL_GC),
        "pool_scale": gain(ks[5], (L, POOL_W)),
        "conv_dw": nrm(ks[6], (L, CONV_K, CONV_W), CONV_K),
        "conv_dw_b": bias(ks[7], (L, CONV_W)),
        "conv_ln_g": gain(ks[8], (L, CONV_W)),
        "conv_ln_b": bias(ks[9], (L, CONV_W)),
        "conv_pw": nrm(ks[10], (L, CONV_W, CONV_W), CONV_W),
        "conv_pw_b": bias(ks[11], (L, CONV_W)),
        "q_a_g": gain(ks[12], (L, Q_LORA)),
        "w_uq": nrm(ks[13], (L, Q_LORA, N_HEADS * QK_HEAD), Q_LORA),
        "kv_a_g": gain(ks[14], (L, KV_LORA)),
        "w_ukv": nrm(ks[15], (L, KV_LORA, N_HEADS * (QK_NOPE + V_DIM)), KV_LORA),
        "q_norm_g": gain(ks[16], (L, QK_HEAD)),
        "k_norm_g": gain(ks[17], (L, QK_HEAD)),
        "pool_out_g": gain(ks[18], (L, POOL_W)),
        "conv_out_g": gain(ks[19], (L, CONV_W)),
        "attn_out_g": gain(ks[20], (L, ATTN_W)),
        "w_o": nrm(ks[21], (L, D_MIX, D_MODEL), D_MIX),
        "ffn_norm_g": gain(ks[22], (L, D_MODEL)),
        "w_router": nrm(ks[23], (L, D_MODEL, N_EXPERTS), D_MODEL),
        "b_router": bias(ks[24], (L, N_EXPERTS), 0.01),
        "w_gu": nrm(ks[25], (L, N_EXPERTS, D_MODEL, 2 * D_FF), D_MODEL),
        "b_gu": bias(ks[26], (L, N_EXPERTS, 2 * D_FF)),
        "w_down": nrm(ks[27], (L, N_EXPERTS, D_FF, D_MODEL), D_FF),
        "b_down": bias(ks[28], (L, N_EXPERTS, D_MODEL)),
    }


def reference(x, positions, attn_norm_g, w_in, pool_w, pool_scale, conv_dw, conv_dw_b, conv_ln_g,
              conv_ln_b, conv_pw, conv_pw_b, q_a_g, w_uq, kv_a_g, w_ukv, q_norm_g, k_norm_g,
              pool_out_g, conv_out_g, attn_out_g, w_o, ffn_norm_g, w_router, b_router, w_gu, b_gu,
              w_down, b_down):
    cos, sin = rope_tables(positions)
    s0 = POOL_W
    s1 = s0 + 2 * CONV_W
    s2 = s1 + Q_LORA
    s3 = s2 + KV_LORA
    for l in range(DEPTH):
        h = rmsnorm(x, attn_norm_g[l])
        z = h @ w_in[l]
        y_pool = pool_mixer(z[..., :s0], pool_w[l], pool_scale[l])
        y_conv = conv_mixer(z[..., s0:s1], conv_dw[l], conv_dw_b[l], conv_ln_g[l], conv_ln_b[l],
                            conv_pw[l], conv_pw_b[l])
        y_attn = mla_mixer(z[..., s1:s2], z[..., s2:s3], z[..., s3:], cos, sin, q_a_g[l], w_uq[l],
                           kv_a_g[l], w_ukv[l], q_norm_g[l], k_norm_g[l])
        mix = jnp.concatenate([rmsnorm(y_pool, pool_out_g[l]), rmsnorm(y_conv, conv_out_g[l]),
                               rmsnorm(y_attn, attn_out_g[l])], axis=-1)
        x = x + mix @ w_o[l]
        x = x + moe_ffn(rmsnorm(x, ffn_norm_g[l]), w_router[l], b_router[l], w_gu[l], b_gu[l],
                        w_down[l], b_down[l])
    return x
```

```cpp
#include <hip/hip_runtime.h>
#include <cstdio>
#include <cstdint>

#ifndef OUTPROJ_FP8
#define OUTPROJ_FP8 0
#endif
#ifndef PROBE_FIX
#define PROBE_FIX 0
#endif
#ifndef MOE_FP8
#define MOE_FP8 1
#define PV_PIPE 1
#define ATT_PV8 1
#define ATT_QK8 1
#endif
#define LAS __attribute__((address_space(3)))
typedef unsigned short bf16_t;
typedef short bf16x8 __attribute__((ext_vector_type(8)));
typedef float f32x4 __attribute__((ext_vector_type(4)));
typedef float f32x2 __attribute__((ext_vector_type(2)));
typedef unsigned u32x4 __attribute__((ext_vector_type(4)));
typedef unsigned u32x2 __attribute__((ext_vector_type(2)));

constexpr int T = 32768, DM = 1024, SEQ = 4096, NBATCH = 8, NLAYER = 2;
constexpr int DIN = 1216, DINP = 1280;
constexpr int NEXP = 32, TOPK = 4, DFF = 1024;
constexpr int MOE_ROWS = T * TOPK + NEXP * 256;
constexpr float EPS = 1e-6f;
constexpr int NTHR = 512, NWAVE = 8;

enum { I_X = 0, I_POS, I_ANG, I_WIN, I_POOLW, I_POOLS, I_CDW, I_CDWB, I_CLNG, I_CLNB, I_CPW, I_CPWB, I_QAG, I_WUQ, I_KVAG, I_WUKV,
       I_QNG, I_KNG, I_POG, I_COG, I_AOG, I_WO, I_FNG, I_WR, I_BR, I_WGU, I_BGU, I_WDN, I_BDN, N_IN };

constexpr size_t MiB = 1u << 20;
constexpr size_t WS_CTL = 0, CTL_ZERO_BYTES = 1 * MiB;
constexpr size_t WS_COS = 1 * MiB;
constexpr size_t WS_WIN = 9 * MiB;
constexpr size_t WS_WMIX = 14 * MiB;
constexpr size_t WS_WQ = 15 * MiB;
constexpr size_t WS_WKV = 16 * MiB;
constexpr size_t WS_WO = 17 * MiB;
constexpr size_t WS_WR = 21 * MiB;
constexpr size_t WS_WGU = 22 * MiB;
constexpr size_t WS_WD = 278 * MiB;
constexpr size_t WS_HB = 406 * MiB;
constexpr size_t WS_RS = 406 * MiB;
constexpr size_t WS_Z = 470 * MiB;
constexpr size_t WS_A2 = 550 * MiB;
constexpr size_t WS_YMIX = 582 * MiB;
constexpr size_t WS_QRAW = 614 * MiB;
constexpr size_t WS_KVRAW = 662 * MiB;
constexpr size_t WS_Q = 726 * MiB;
constexpr size_t WS_KIMG = 774 * MiB;
constexpr size_t WS_VIMG = 822 * MiB;
constexpr size_t WS_YATT = 854 * MiB;
constexpr size_t WS_MIX = 918 * MiB;
constexpr size_t WS_LTOK = 982 * MiB;
constexpr size_t WS_LGATE = 986 * MiB;
constexpr size_t WS_ASG = 990 * MiB;
constexpr size_t WS_PAR = 991 * MiB;
constexpr int P_CDW = 0, P_CDWB = 15872, P_CLNG = 16384, P_CLNB = 16896, P_CPWB = 17408, P_QNG = 17920, P_KNG = 18304, P_BR = 18688, P_MIXB = 19456, P_BGU = 20480, P_BDN = 151552, P_END = 217088;
static_assert((size_t)P_END * 4 <= 1 * MiB, "param area");
constexpr size_t WS_ACT = 992 * MiB;
constexpr size_t WS_YB = 1264 * MiB;
constexpr size_t WS_HB8 = 1536 * MiB;
constexpr size_t WS_XB = 1568 * MiB;
constexpr size_t WS_END = 1632 * MiB;
static_assert((size_t)MOE_ROWS * 1024 * 2 <= 272 * MiB, "act buffer");

constexpr int CW_BAR = 4096;
constexpr int CW_GCNT = 16384;

constexpr int LDS_BYTES = 163840;
constexpr int LDS_CTL = 162816;
constexpr int LDS_TOKT = 131072, LDS_BIAST = 131072 + 28 * 512;

__device__ __forceinline__ unsigned f2bf(float f) { unsigned u = __builtin_bit_cast(unsigned, f); return (u + 0x7fffu + ((u >> 16) & 1u)) >> 16; }
typedef __bf16 bf16x2_hw __attribute__((ext_vector_type(2)));
__device__ __forceinline__ unsigned pk2(float lo, float hi) { typedef float f2_ __attribute__((ext_vector_type(2))); const f2_ v = {lo, hi}; return __builtin_bit_cast(unsigned, __builtin_convertvector(v, bf16x2_hw)); }
__device__ __forceinline__ float bf2f(unsigned b) { return __builtin_bit_cast(float, b << 16); }
__device__ __forceinline__ float bflo(unsigned w) { return __builtin_bit_cast(float, w << 16); }
__device__ __forceinline__ float bfhi(unsigned w) { return __builtin_bit_cast(float, w & 0xffff0000u); }
__device__ __forceinline__ float wave_sum(float v) {
#pragma unroll
    for (int o = 1; o < 64; o <<= 1) v += __shfl_xor(v, o);
    return v;
}
__device__ __forceinline__ float grp16_sum(float v) {
#pragma unroll
    for (int o = 1; o < 16; o <<= 1) v += __shfl_xor(v, o);
    return v;
}
__device__ __forceinline__ unsigned pk4_fp8(float a, float b, float c, float d) { unsigned w = 0; w = __builtin_amdgcn_cvt_pk_fp8_f32(a, b, w, false); w = __builtin_amdgcn_cvt_pk_fp8_f32(c, d, w, true); return w; }
__device__ __forceinline__ float sigmoidf_(float x) { return 1.0f / (1.0f + __expf(-x)); }

struct Ctx {
    const float* x; float* out; unsigned char* ws; LAS unsigned char* lds;
    int tid, lane, wave, G, bid;
};
#define WSP(T_, off) ((T_*)(C.ws + (off)))
__device__ __forceinline__ Ctx phase_enter(const Ctx& C0) {
    Ctx C = C0; int t = threadIdx.x; asm volatile("" : "+v"(t)); C.tid = t; C.lane = t & 63; C.wave = __builtin_amdgcn_readfirstlane(t >> 6);
    unsigned long long w = (unsigned long long)C0.ws, o = (unsigned long long)C0.out, x = (unsigned long long)C0.x;
    asm volatile("" : "+s"(w), "+s"(o), "+s"(x));
    C.ws = (unsigned char*)(__attribute__((address_space(1))) unsigned char*)w; C.out = (float*)(__attribute__((address_space(1))) float*)o; C.x = (const float*)(const __attribute__((address_space(1))) float*)x; return C; }

__device__ __forceinline__ int kimg_off(int r, int c) { return (c >> 1) * 2048 + (c & 1) * 1024 + (r >> 5) * 512 + (r & 31) * 16; }
__device__ __forceinline__ int v_st(int k, int c) { const int kk = (k & ~0xC) | ((k & 4) << 1) | ((k & 8) >> 1); return ((kk >> 3) * 4 + (c >> 5)) * 512 + ((kk & 7) * 32 + (c & 31)) * 2; }

template <class RowMap>
__device__ __forceinline__ void tconv_item(const float* W, int N, int k0, int n0, const float* kscale, bf16_t* WT, int ldk, RowMap rm, LAS float* scr, int lane) {
#pragma unroll 8
    for (int i = 0; i < 32; ++i) { const int kk = 2 * i + (lane >> 5); float v = W[(size_t)(k0 + kk) * N + n0 + (lane & 31)]; if (kscale) v *= kscale[k0 + kk]; scr[kk * 33 + (lane & 31)] = v; }
    asm volatile("s_waitcnt lgkmcnt(0)" ::: "memory");
    const int c = lane & 7;
#pragma unroll
    for (int j = 0; j < 4; ++j) { const int n = (lane >> 3) + 8 * j; const LAS float* s = scr + (8 * c) * 33 + n;
        u32x4 o; o.x = pk2(s[0 * 33], s[1 * 33]); o.y = pk2(s[2 * 33], s[3 * 33]); o.z = pk2(s[4 * 33], s[5 * 33]); o.w = pk2(s[6 * 33], s[7 * 33]);
        *(u32x4*)(WT + (size_t)rm(n0 + n) * ldk + k0 + 8 * c) = o; }
    asm volatile("s_waitcnt lgkmcnt(0)" ::: "memory");
}
template <class RowMap>
__device__ __forceinline__ void tconv128_item(const float* W, int N, int k0, int n0, const float* kscale, bf16_t* WT, int ldk, RowMap rm, LAS unsigned* scr, int lane) {
    const float* src = W + (size_t)k0 * N + n0 + 2 * lane;
#pragma unroll 8
    for (int kp = 0; kp < 32; ++kp) {
        const f32x2 r0 = *(const f32x2*)(src + (size_t)(2 * kp) * N), r1 = *(const f32x2*)(src + (size_t)(2 * kp + 1) * N);
        const float s0 = kscale ? kscale[k0 + 2 * kp] : 1.f, s1 = kscale ? kscale[k0 + 2 * kp + 1] : 1.f;
        scr[(2 * lane) * 33 + kp] = pk2(r0.x * s0, r1.x * s1); scr[(2 * lane + 1) * 33 + kp] = pk2(r0.y * s0, r1.y * s1); }
    asm volatile("s_waitcnt lgkmcnt(0)" ::: "memory");
    const int c = lane & 7;
#pragma unroll 4
    for (int j = 0; j < 16; ++j) { const int n = (lane >> 3) + 8 * j; const LAS unsigned* p = scr + n * 33 + 4 * c;
        *(u32x4*)(WT + (size_t)rm(n0 + n) * ldk + k0 + 8 * c) = (u32x4){p[0], p[1], p[2], p[3]}; }
    asm volatile("s_waitcnt lgkmcnt(0)" ::: "memory");
}
template <class RowMap>
__device__ __forceinline__ void tconv128_f8_item(const float* W, int N, int k0, int n0, const float* kscale, float wscale, unsigned char* WT, int ldk, RowMap rm, LAS unsigned* scr, int lane) {
    const float* src = W + (size_t)k0 * N + n0 + 2 * lane;
#pragma unroll 8
    for (int kq = 0; kq < 32; ++kq) {
        const f32x2 r0 = *(const f32x2*)(src + (size_t)(4 * kq) * N), r1 = *(const f32x2*)(src + (size_t)(4 * kq + 1) * N), r2 = *(const f32x2*)(src + (size_t)(4 * kq + 2) * N), r3 = *(const f32x2*)(src + (size_t)(4 * kq + 3) * N);
        float s0 = wscale, s1 = wscale, s2 = wscale, s3 = wscale;
        if (kscale) { s0 *= kscale[k0 + 4 * kq]; s1 *= kscale[k0 + 4 * kq + 1]; s2 *= kscale[k0 + 4 * kq + 2]; s3 *= kscale[k0 + 4 * kq + 3]; }
        scr[(2 * lane) * 33 + kq] = pk4_fp8(r0.x * s0, r1.x * s1, r2.x * s2, r3.x * s3); scr[(2 * lane + 1) * 33 + kq] = pk4_fp8(r0.y * s0, r1.y * s1, r2.y * s2, r3.y * s3); }
    asm volatile("s_waitcnt lgkmcnt(0)" ::: "memory");
    const int c = lane & 7;
#pragma unroll 4
    for (int j = 0; j < 16; ++j) { const int n = (lane >> 3) + 8 * j; const LAS unsigned* p = scr + n * 33 + 4 * c;
        *(u32x4*)(WT + (size_t)rm(n0 + n) * ldk + k0 + 16 * c) = (u32x4){p[0], p[1], p[2], p[3]}; }
    asm volatile("s_waitcnt lgkmcnt(0)" ::: "memory");
}
struct RmId { __device__ __forceinline__ int operator()(int n) const { return n; } };
struct RmGu { __device__ __forceinline__ int operator()(int n) const { const int j = n >> 1, half = n & 1; return ((j >> 7) << 8) + (half << 7) + (j & 127); } };

struct Args;
__device__ __forceinline__ void ph_prologue(const Ctx& C, const float* const* in_) {
#define PIN(i) (in_[i])
    LAS float* scr = (LAS float*)(C.lds + C.wave * 16384);
    const int gw = C.bid * NWAVE + C.wave, NGW = C.G * NWAVE;
    constexpr int I_IN = 16 * 38, I_O = 16 * 32;
    constexpr int N_IN_ = NLAYER * I_IN, N_O_ = NLAYER * I_O;
    for (int it = gw; it < N_IN_ + N_O_; it += NGW) {
        int r = it;
        if (r < N_IN_) { const int l = r / I_IN, q = r % I_IN, kb = q / 38, nb = q % 38;
            tconv_item(PIN(I_WIN) + (size_t)l * 1024 * DIN, DIN, kb * 64, nb * 32, PIN(I_ANG) + l * 1024, WSP(bf16_t, WS_WIN) + (size_t)l * DINP * 1024, 1024, RmId(), scr, C.lane); continue; }
        r -= N_IN_;
#if !OUTPROJ_FP8
        { const int l = r / I_O, q = r % I_O, kb = q / 32, nb = q % 32, k0 = kb * 64;
            const float* ks = (k0 < 256) ? (PIN(I_POG) + l * 256) : (k0 < 512) ? (PIN(I_COG) + l * 256 - 256) : (PIN(I_AOG) + l * 512 - 512);
            tconv_item(PIN(I_WO) + (size_t)l * 1024 * 1024, 1024, k0, nb * 32, ks, WSP(bf16_t, WS_WO) + (size_t)l * 1024 * 1024, 1024, RmId(), scr, C.lane); }
#endif
    }
    __syncthreads();
    { LAS unsigned* scr2 = (LAS unsigned*)(C.lds + C.wave * 16896);
#if OUTPROJ_FP8
      for (int it = gw; it < NLAYER * 64; it += NGW) { const int l = it >> 6, q = it & 63, kb = q >> 3, nb = q & 7, k0 = kb * 128;
          const float* ks = (k0 < 256) ? (PIN(I_POG) + l * 256) : (k0 < 512) ? (PIN(I_COG) + l * 256 - 256) : (PIN(I_AOG) + l * 512 - 512);
          tconv128_f8_item(PIN(I_WO) + (size_t)l * 1024 * 1024, 1024, k0, nb * 128, ks, 32.f, C.ws + WS_WO + (size_t)l * 1024 * 1024, 1024, RmId(), scr2, C.lane); }
#endif
#if MOE_FP8
      constexpr int I_GU = 8 * 16, I_DN = 8 * 8;
      constexpr int N_GU_ = NLAYER * NEXP * I_GU, N_DN_ = NLAYER * NEXP * I_DN;
      for (int it = gw; it < N_GU_ + N_DN_; it += NGW) {
        if (it < N_GU_) { const int le = it / I_GU, q = it % I_GU, kb = q / 16, nb = q % 16, l = le / NEXP;
            tconv128_f8_item(PIN(I_WGU) + (size_t)le * 1024 * 2048, 2048, kb * 128, nb * 128, PIN(I_FNG) + l * 1024, 32.f, C.ws + WS_WGU + (size_t)le * 2048 * 1024, 1024, RmGu(), scr2, C.lane);
        } else { const int r = it - N_GU_, le = r / I_DN, q = r % I_DN, kb = q / 8, nb = q % 8;
            tconv128_f8_item(PIN(I_WDN) + (size_t)le * 1024 * 1024, 1024, kb * 128, nb * 128, nullptr, 32.f, C.ws + WS_WD + (size_t)le * 1024 * 1024, 1024, RmId(), scr2, C.lane); }
      } }
#else
      constexpr int I_GU = 16 * 16, I_DN = 16 * 8;
      constexpr int N_GU_ = NLAYER * NEXP * I_GU, N_DN_ = NLAYER * NEXP * I_DN;
      for (int it = gw; it < N_GU_ + N_DN_; it += NGW) {
        if (it < N_GU_) { const int le = it / I_GU, q = it % I_GU, kb = q / 16, nb = q % 16, l = le / NEXP;
            tconv128_item(PIN(I_WGU) + (size_t)le * 1024 * 2048, 2048, kb * 64, nb * 128, PIN(I_FNG) + l * 1024, WSP(bf16_t, WS_WGU) + (size_t)le * 2048 * 1024, 1024, RmGu(), scr2, C.lane);
        } else { const int r = it - N_GU_, le = r / I_DN, q = r % I_DN, kb = q / 8, nb = q % 8;
            tconv128_item(PIN(I_WDN) + (size_t)le * 1024 * 1024, 1024, kb * 64, nb * 128, nullptr, WSP(bf16_t, WS_WD) + (size_t)le * 1024 * 1024, 1024, RmId(), scr2, C.lane); }
      } }
#endif
    const int gt = C.bid * NTHR + C.tid, NGT = C.G * NTHR;
    for (int i = gt; i < NLAYER * 512 * 512; i += NGT) {
        const int l = i / (512 * 512), n = (i / 512) % 512, k = i % 512; float v = 0.f;
        if (n < 256) { const int g = n >> 6, d = n & 63; if (k < 256 && (k >> 6) == g) v = PIN(I_POOLW)[((size_t)(l * 4 + g) * 64 + (k & 63)) * 64 + d] * PIN(I_POOLS)[l * 256 + n]; }
        else { if (k >= 256) v = PIN(I_CPW)[((size_t)l * 256 + (k - 256)) * 256 + (n - 256)]; }
        WSP(bf16_t, WS_WMIX)[i] = (bf16_t)f2bf(v);
    }
    for (int i = gt; i < NLAYER * 768 * 256; i += NGT) {
        const int l = i / (768 * 256), n = (i / 256) % 768, k = i % 256;
        WSP(bf16_t, WS_WQ)[i] = (bf16_t)f2bf(PIN(I_WUQ)[((size_t)l * 256 + k) * 768 + n] * PIN(I_QAG)[l * 256 + k]);
    }
    for (int i = gt; i < NLAYER * 1024 * 256; i += NGT) {
        const int l = i / (1024 * 256), n = (i / 256) % 1024, k = i % 256;
        WSP(bf16_t, WS_WKV)[i] = (bf16_t)(k < 128 ? f2bf(PIN(I_WUKV)[((size_t)l * 128 + k) * 1024 + n] * PIN(I_KVAG)[l * 128 + k]) : 0u);
    }
    for (int i = gt; i < NLAYER * 32 * 1024; i += NGT) {
        const int l = i / (32 * 1024), e = (i / 1024) % 32, k = i % 1024;
        const float wv = PIN(I_WR)[((size_t)l * 1024 + k) * 32 + e] * PIN(I_FNG)[l * 1024 + k];
        const unsigned hi = f2bf(wv); const float rem = wv - bf2f(hi);
        WSP(bf16_t, WS_WR)[((size_t)(l * 2 + 0) * 32 + e) * 1024 + k] = (bf16_t)hi; WSP(bf16_t, WS_WR)[((size_t)(l * 2 + 1) * 32 + e) * 1024 + k] = (bf16_t)f2bf(rem);
    }
    for (int i = gt; i < NLAYER * 64 * 1024; i += NGT) {
        const int l = i / (64 * 1024), r = (i / 1024) % 64, k = i % 1024;
        WSP(bf16_t, WS_WIN)[((size_t)l * DINP + DIN + r) * 1024 + k] = 0;
    }
    { float* P = WSP(float, WS_PAR);
      for (int i = gt; i < 2 * 31 * 256; i += NGT) P[P_CDW + i] = PIN(I_CDW)[i];
      for (int i = gt; i < 512; i += NGT) { P[P_CDWB + i] = PIN(I_CDWB)[i]; P[P_CLNG + i] = PIN(I_CLNG)[i]; P[P_CLNB + i] = PIN(I_CLNB)[i]; P[P_CPWB + i] = PIN(I_CPWB)[i]; }
      for (int i = gt; i < 384; i += NGT) { P[P_QNG + i] = PIN(I_QNG)[i]; P[P_KNG + i] = PIN(I_KNG)[i]; }
      for (int i = gt; i < 64; i += NGT) P[P_BR + i] = PIN(I_BR)[i];
      for (int i = gt; i < 1024; i += NGT) { const int l_ = i >> 9, n_ = i & 511; P[P_MIXB + i] = (n_ >= 256) ? PIN(I_CPWB)[l_ * 256 + n_ - 256] : 0.f; }
      for (int i = gt; i < 2 * 32 * 2048; i += NGT) P[P_BGU + i] = PIN(I_BGU)[i];
      for (int i = gt; i < 2 * 32 * 1024; i += NGT) P[P_BDN + i] = PIN(I_BDN)[i]; }
    const float invf = (float)exp(-9.210340371976184 * (double)(gt & 31) / 32.0);
    for (int i = gt; i < T * 32; i += NGT) {
        const int t = i >> 5;
        const float ang = (float)((const int*)PIN(I_POS))[t] * invf;
        double r = (double)ang; r = r - 6.283185307179586476925 * rint(r * 0.15915494309189533577);
        const float rf = (float)r;
        WSP(f32x2, WS_COS)[i] = (f32x2){cosf(rf), sinf(rf)};
    }
    f32x4 vn[4], vn2[4];
    if (gw < T) { const f32x4* xr = (const f32x4*)(PIN(I_X) + (size_t)gw * DM) + C.lane;
#pragma unroll
        for (int j = 0; j < 4; ++j) { vn[j] = xr[64 * j]; vn2[j] = vn[j]; } }
    if (gw + NGW < T) { const f32x4* xr = (const f32x4*)(PIN(I_X) + (size_t)(gw + NGW) * DM) + C.lane;
#pragma unroll
        for (int j = 0; j < 4; ++j) vn2[j] = xr[64 * j]; }
    for (int m = gw; m < T; m += NGW) {
        f32x4 v[4]; float s = 0.f;
#pragma unroll
        for (int j = 0; j < 4; ++j) { v[j] = vn[j]; vn[j] = vn2[j]; s += (v[j].x * v[j].x + v[j].y * v[j].y) + (v[j].z * v[j].z + v[j].w * v[j].w); }
        if (m + 2 * NGW < T) { const f32x4* xr = (const f32x4*)(PIN(I_X) + (size_t)(m + 2 * NGW) * DM) + C.lane;
#pragma unroll
            for (int j = 0; j < 4; ++j) vn2[j] = xr[64 * j]; }
        const float rs = rsqrtf(wave_sum(s) * (1.f / DM) + EPS);
        u32x2* o = (u32x2*)(WSP(bf16_t, WS_XB) + (size_t)m * DM) + C.lane;
#pragma unroll
        for (int j = 0; j < 4; ++j) o[64 * j] = (u32x2){pk2(v[j].x, v[j].y), pk2(v[j].z, v[j].w)};
        if (C.lane == 0) WSP(float, WS_RS)[m] = rs;
    }
}
#undef PIN

template <int NBT, class RowPtr, class Epi>
__device__ __forceinline__ void sg_tile(const Ctx& C, RowPtr rowptr, const bf16_t* Bt0, const bf16_t* Bt1, int K, Epi epi) {
    constexpr int LDR = 40;
    LAS bf16_t* SA = (LAS bf16_t*)C.lds; LAS bf16_t* SB = SA + 128 * LDR;
    const int tid = C.tid, lane = C.lane, wid = C.wave, wr = wid >> 1, wc = wid & 1, fr = lane & 15, fq = lane >> 4;
    const int sr = tid >> 2, sc = (tid & 3) * 8;
    const bf16_t* ap = rowptr(sr) + sc;
    const bf16_t* bp0 = Bt0 + (size_t)sr * K + sc; const bf16_t* bp1 = (NBT == 2) ? (Bt1 + (size_t)sr * K + sc) : bp0;
    f32x4 acc[NBT][2][4];
#pragma unroll
    for (int b = 0; b < NBT; ++b)
#pragma unroll
        for (int m = 0; m < 2; ++m)
#pragma unroll
            for (int n = 0; n < 4; ++n) acc[b][m][n] = (f32x4){0.f, 0.f, 0.f, 0.f};
    for (int kt = 0; kt < K / 32; ++kt) {
        const bf16x8 av = *(const bf16x8*)(ap + kt * 32); const bf16x8 bv0 = *(const bf16x8*)(bp0 + kt * 32); bf16x8 bv1 = bv0; if (NBT == 2) bv1 = *(const bf16x8*)(bp1 + kt * 32);
        __syncthreads();
        *(LAS bf16x8*)(SA + sr * LDR + sc) = av; *(LAS bf16x8*)(SB + sr * LDR + sc) = bv0; if (NBT == 2) *(LAS bf16x8*)(SB + (128 + sr) * LDR + sc) = bv1;
        __syncthreads();
        bf16x8 a[2], b[NBT][4];
#pragma unroll
        for (int m = 0; m < 2; ++m) a[m] = *(const LAS bf16x8*)(SA + (wr * 32 + m * 16 + fr) * LDR + fq * 8);
#pragma unroll
        for (int bt = 0; bt < NBT; ++bt)
#pragma unroll
            for (int n = 0; n < 4; ++n) b[bt][n] = *(const LAS bf16x8*)(SB + (bt * 128 + wc * 64 + n * 16 + fr) * LDR + fq * 8);
#pragma unroll
        for (int bt = 0; bt < NBT; ++bt)
#pragma unroll
            for (int m = 0; m < 2; ++m)
#pragma unroll
                for (int n = 0; n < 4; ++n) acc[bt][m][n] = __builtin_amdgcn_mfma_f32_16x16x32_bf16(a[m], b[bt][n], acc[bt][m][n], 0, 0, 0);
    }
#pragma unroll
    for (int m = 0; m < 2; ++m)
#pragma unroll
        for (int n = 0; n < 4; ++n)
#pragma unroll
            for (int j = 0; j < 4; ++j) {
                const int r = wr * 32 + m * 16 + fq * 4 + j, c = wc * 64 + n * 16 + fr;
                if (NBT == 2) epi(r, c, acc[0][m][n][j], acc[NBT - 1][m][n][j]); else epi(r, c, acc[0][m][n][j], 0.f);
            }
    __syncthreads();
}


namespace g8 {
constexpr int BM = 256, BK = 64, HALF = 128, HTB = HALF * BK * 2, STAGE_BYTES = 8 * HTB;
__device__ __forceinline__ int lds_byte(int r, int c) { const int st = (r >> 4) * 2 + (c >> 5), rr = r & 15, cc = c & 31, ob = rr * 64 + cc * 2; return st * 1024 + (ob ^ (((ob >> 9) & 1) << 5)); }
__device__ __forceinline__ void stage_rc(int b, int& R, int& Cc) { const int st = b / 1024, sb = b % 1024, swz = sb ^ (((sb >> 9) & 1) << 5); R = (st >> 1) * 16 + swz / 64; Cc = (st & 1) * 32 + (swz % 64) / 2; }
__device__ __forceinline__ int perm32(int rho) { const int n = rho >> 4, i = rho & 15; return 8 * (i >> 2) + 4 * n + (i & 3); }
__device__ __forceinline__ int h8(int x) { return (int)((0x64753120u >> (4 * x)) & 7u); }
template <bool F8> __device__ __forceinline__ void stage_map(int b, int& R, int& Cc) {
    if constexpr (F8) { const int q = b >> 4; R = q >> 3; Cc = ((q & 7) ^ h8((R >> 1) & 7)) * 8; } else stage_rc(b, R, Cc); }
struct GUnit { const unsigned char* A; const unsigned char* B; int row0, col0, e, aux; };
__device__ __forceinline__ void tile_of(int L, int nM, int nN, int& pm, int& pn) {
    const int nwg = nM * nN; int wgid = L; { const int q = nwg / 8, r = nwg % 8, xcd = wgid % 8, off = wgid / 8; wgid = (xcd < r ? xcd * (q + 1) : r * (q + 1) + (xcd - r) * q) + off; }
    const int nig = 8 * nN, gid = wgid / nig, fm = gid * 8, gsz = (nM - fm) < 8 ? (nM - fm) : 8;
    pm = fm + ((wgid % nig) % gsz); pn = (wgid % nig) / gsz;
}
typedef int v8i_t __attribute__((ext_vector_type(8)));
typedef int v4i_t __attribute__((ext_vector_type(4)));
__device__ __forceinline__ v8i_t cat8(bf16x8 lo, bf16x8 hi) { return __builtin_shufflevector(__builtin_bit_cast(v4i_t, lo), __builtin_bit_cast(v4i_t, hi), 0, 1, 2, 3, 4, 5, 6, 7); }
__device__ __forceinline__ void mfma_f8(f32x4& acc, v8i_t a, v8i_t b) { asm("s_nop 1\n\tv_mfma_f32_16x16x128_f8f6f4 %0, %1, %2, %0" : "+v"(acc) : "v"(a), "v"(b)); }
template <class Epi, class Sched, bool ALIGN_EPI, bool SP2, bool F8 = false, int PM = 0>
__device__ __forceinline__ void gemm_phase(LAS unsigned char* lds, const int K, const Sched& S, const Epi& E) {
    constexpr int ES = F8 ? 1 : 2;
    int tid = threadIdx.x; asm volatile("" : "+v"(tid));
    const int wid = __builtin_amdgcn_readfirstlane(tid >> 6), lane = tid & 63, wr = wid >> 2, wc = wid & 3, fr = lane & 15, fq = lane >> 4;
    const int nt = (PM == 2) ? 4 : K * ES / 128;
    unsigned voffB[2];
#pragma unroll
    for (int i = 0; i < 2; ++i) { int R, Cc; stage_map<F8>(tid * 16 + i * 8192, R, Cc); const int Rb = (Epi::PERM == 1) ? ((R & ~31) + perm32(R & 31)) : (Epi::PERM == 2) ? (64 * (R >> 5) + 16 * ((R >> 2) & 3) + 4 * ((R >> 4) & 1) + (R & 3)) : R;
        voffB[i] = (unsigned)(Rb * K * ES + Cc * 2); }
#define PG8_LOAD_IDS(U) do { int tz_ = threadIdx.x; asm volatile("" : "+v"(tz_)); int R0_, C0_, R1_, C1_; stage_map<F8>(tz_ * 16, R0_, C0_); stage_map<F8>(tz_ * 16 + 8192, R1_, C1_); \
        id00 = S.rowid(U, R0_); id01 = S.rowid(U, R1_); id10 = S.rowid(U, HALF + R0_); id11 = S.rowid(U, HALF + R1_); } while (0)
#define PG8_IDS_TO_VA() do { int tz_ = threadIdx.x; asm volatile("" : "+v"(tz_)); int R0_, C0_, R1_, C1_; stage_map<F8>(tz_ * 16, R0_, C0_); stage_map<F8>(tz_ * 16 + 8192, R1_, C1_); \
        va00 = S.idoff(id00) + (unsigned)C0_ * 2u; va01 = S.idoff(id01) + (unsigned)C1_ * 2u; va10 = S.idoff(id10) + (unsigned)C0_ * 2u; va11 = S.idoff(id11) + (unsigned)C1_ * 2u; } while (0)
    const size_t kstep = (size_t)(BK * 2);
    const size_t hstepB = (size_t)(Epi::PERM == 2 ? 8 : HALF) * K * ES;
    const unsigned ldsw = (unsigned)wid * 1024u;
    const int aoff = F8 ? ((wr * 64 + fr) * 128 + 16 * ((2 * fq) ^ h8((fr >> 1) & 7))) : lds_byte(wr * 64 + fr, fq * 8), boff = F8 ? ((wc * 32 + fr) * 128 + 16 * ((2 * fq) ^ h8((fr >> 1) & 7))) : lds_byte(wc * 32 + fr, fq * 8);
    const int aoff1 = F8 ? (aoff ^ 16) : (aoff + 1024), boff1 = F8 ? (boff ^ 16) : (boff + 1024);
#define PG8_SA(b, h) (((b) * 2 + (h)) * HTB)
#define PG8_SB(b, h) ((4 + (b) * 2 + (h)) * HTB)
#define PG8_STAGE2(bufoff, gbase, v0, v1) do { \
        __builtin_amdgcn_global_load_lds((const unsigned*)((const unsigned char*)(gbase) + (v0)), (LAS unsigned*)(lds + (bufoff) + ldsw), 16, 0, 0); \
        __builtin_amdgcn_global_load_lds((const unsigned*)((const unsigned char*)(gbase) + (v1)), (LAS unsigned*)(lds + (bufoff) + ldsw + 8192), 16, 0, 0); } while (0)
#define PG8_STAGE_B(bufoff, gbase) PG8_STAGE2(bufoff, gbase, voffB[0], voffB[1])
#define PG8_LDA(dst, b, h) do { _Pragma("unroll") for (int m = 0; m < 4; ++m) _Pragma("unroll") for (int k = 0; k < 2; ++k) dst[m][k] = *(const LAS bf16x8*)(lds + PG8_SA(b, h) + (k ? aoff1 : aoff) + m * 2048); } while (0)
#define PG8_LDB(dst, b, h) do { _Pragma("unroll") for (int n = 0; n < 2; ++n) _Pragma("unroll") for (int k = 0; k < 2; ++k) dst[n][k] = *(const LAS bf16x8*)(lds + PG8_SB(b, h) + (k ? boff1 : boff) + n * 2048); } while (0)
#define PG8_MMA(ai, bj, At, Bt) do { __builtin_amdgcn_s_setprio(1); if constexpr (F8) { _Pragma("unroll") for (int m = 0; m < 4; ++m) _Pragma("unroll") for (int n = 0; n < 2; ++n) \
        mfma_f8(acc[ai][bj][m][n], cat8(Bt[n][0], Bt[n][1]), cat8(At[m][0], At[m][1])); } else { \
        _Pragma("unroll") for (int m = 0; m < 4; ++m) _Pragma("unroll") for (int n = 0; n < 2; ++n) _Pragma("unroll") for (int k = 0; k < 2; ++k) \
        acc[ai][bj][m][n] = __builtin_amdgcn_mfma_f32_16x16x32_bf16(Bt[n][k], At[m][k], acc[ai][bj][m][n], 0, 0, 0); } __builtin_amdgcn_s_setprio(0); } while (0)
#define PG8_WAIT_V(n) asm volatile("s_waitcnt vmcnt(" #n ")" ::: "memory")
#define PG8_WAIT_L(n) asm volatile("s_waitcnt lgkmcnt(" #n ")" ::: "memory")
#define PG8_BAR __builtin_amdgcn_s_barrier()
#define PG8_SCHED __builtin_amdgcn_sched_barrier(0)
    GUnit cur, nxt; int ui = 0;
    if (!S.next(0, cur)) return;
    f32x4 acc[2][2][4][2];
#pragma unroll
    for (int a = 0; a < 2; ++a)
#pragma unroll
        for (int b = 0; b < 2; ++b)
#pragma unroll
            for (int m = 0; m < 4; ++m)
#pragma unroll
                for (int n = 0; n < 2; ++n) acc[a][b][m][n] = (f32x4){0.f, 0.f, 0.f, 0.f};
    bf16x8 At[4][2], B0[2][2], B1[2][2];
    const unsigned char* cA = cur.A; const unsigned char* cB = cur.B;
    unsigned va00, va01, va10, va11; int id00, id01, id10, id11; PG8_LOAD_IDS(cur); PG8_IDS_TO_VA();
    if constexpr (SP2) {
        PG8_STAGE_B(PG8_SB(0, 0), cB); PG8_STAGE_B(PG8_SB(0, 1), cB + hstepB); PG8_STAGE2(PG8_SA(0, 0), cA, va00, va01); PG8_STAGE2(PG8_SA(0, 1), cA, va10, va11);
        if (wr == 1) PG8_BAR;
        PG8_WAIT_V(2); PG8_BAR;
        PG8_STAGE_B(PG8_SB(1, 0), cB + kstep); PG8_STAGE2(PG8_SA(1, 0), cA + kstep, va00, va01); PG8_STAGE_B(PG8_SB(1, 1), cB + hstepB + kstep);
        PG8_WAIT_V(6); PG8_BAR;
    } else {
        PG8_STAGE_B(PG8_SB(0, 0), cB); PG8_STAGE2(PG8_SA(0, 0), cA, va00, va01); PG8_STAGE_B(PG8_SB(0, 1), cB + hstepB); PG8_STAGE2(PG8_SA(0, 1), cA, va10, va11);
        if (wr == 1) PG8_BAR;
        PG8_WAIT_V(4); PG8_BAR;
        PG8_STAGE_B(PG8_SB(1, 0), cB + kstep); PG8_STAGE2(PG8_SA(1, 0), cA + kstep, va00, va01); PG8_STAGE_B(PG8_SB(1, 1), cB + hstepB + kstep);
        PG8_WAIT_V(6); PG8_BAR;
    }
    for (;;) {
        const bool has_next = S.next(ui + 1, nxt);
        const unsigned char* nA = has_next ? nxt.A : cA; const unsigned char* nB = has_next ? nxt.B : cB;
        if (has_next) PG8_LOAD_IDS(nxt);
        for (int t = 0; t < nt; t += 2) {
            const bool last = (t == nt - 2);
            const unsigned char* a1 = cA + (size_t)(t + 1) * kstep;
            PG8_STAGE2(PG8_SA(1, 1), a1, va10, va11);
            if (last && has_next) PG8_IDS_TO_VA();
            const unsigned char* a2 = last ? nA : cA + (size_t)(t + 2) * kstep; const unsigned char* b2 = last ? nB : cB + (size_t)(t + 2) * kstep;
            const unsigned char* a3 = a2 + kstep; const unsigned char* b3 = b2 + kstep;
            if constexpr (SP2) {
            PG8_LDB(B0, 0, 0); PG8_LDB(B1, 0, 1); PG8_SCHED; PG8_LDA(At, 0, 0);
            PG8_WAIT_V(8); PG8_WAIT_L(0); PG8_BAR; PG8_MMA(0, 0, At, B0); PG8_MMA(0, 1, At, B1); PG8_BAR; PG8_SCHED;
            PG8_LDA(At, 0, 1); PG8_STAGE_B(PG8_SB(0, 0), b2); PG8_STAGE_B(PG8_SB(0, 1), b2 + hstepB); PG8_STAGE2(PG8_SA(0, 0), a2, va00, va01);
            PG8_WAIT_V(8); PG8_WAIT_L(0); PG8_BAR; PG8_MMA(1, 0, At, B0); PG8_MMA(1, 1, At, B1); PG8_BAR; PG8_SCHED;
            PG8_LDB(B0, 1, 0); PG8_LDB(B1, 1, 1); PG8_SCHED; PG8_LDA(At, 1, 0); PG8_STAGE2(PG8_SA(0, 1), a2, va10, va11);
            PG8_WAIT_V(8); PG8_WAIT_L(0); PG8_BAR; PG8_MMA(0, 0, At, B0); PG8_MMA(0, 1, At, B1); PG8_BAR; PG8_SCHED;
            PG8_LDA(At, 1, 1); PG8_STAGE_B(PG8_SB(1, 0), b3); PG8_STAGE_B(PG8_SB(1, 1), b3 + hstepB); PG8_STAGE2(PG8_SA(1, 0), a3, va00, va01);
            PG8_WAIT_V(8); PG8_WAIT_L(0); PG8_BAR; PG8_MMA(1, 0, At, B0); PG8_MMA(1, 1, At, B1); PG8_BAR; PG8_SCHED;
            } else {
            PG8_LDB(B0, 0, 0); PG8_SCHED; PG8_LDA(At, 0, 0);
            PG8_WAIT_L(8); PG8_BAR; PG8_WAIT_L(0); PG8_MMA(0, 0, At, B0); PG8_BAR; PG8_SCHED;
            PG8_LDB(B1, 0, 1); PG8_STAGE_B(PG8_SB(0, 0), b2);
            PG8_BAR; PG8_WAIT_L(0); PG8_MMA(0, 1, At, B1); PG8_BAR;
            PG8_LDA(At, 0, 1); PG8_STAGE2(PG8_SA(0, 0), a2, va00, va01);
            PG8_BAR; PG8_WAIT_L(0); PG8_MMA(1, 0, At, B0); PG8_BAR; PG8_SCHED;
            PG8_STAGE_B(PG8_SB(0, 1), b2 + hstepB);
            PG8_WAIT_V(6); PG8_BAR; PG8_MMA(1, 1, At, B1); PG8_BAR;
            PG8_LDB(B0, 1, 0); PG8_SCHED; PG8_LDA(At, 1, 0); PG8_STAGE2(PG8_SA(0, 1), a2, va10, va11);
            PG8_WAIT_L(8); PG8_BAR; PG8_WAIT_L(0); PG8_MMA(0, 0, At, B0); PG8_BAR; PG8_SCHED;
            PG8_LDB(B1, 1, 1); PG8_STAGE_B(PG8_SB(1, 0), b3);
            PG8_BAR; PG8_WAIT_L(0); PG8_MMA(0, 1, At, B1); PG8_BAR;
            PG8_LDA(At, 1, 1); PG8_STAGE2(PG8_SA(1, 0), a3, va00, va01);
            PG8_BAR; PG8_WAIT_L(0); PG8_MMA(1, 0, At, B0); PG8_BAR; PG8_SCHED;
            PG8_STAGE_B(PG8_SB(1, 1), b3 + hstepB);
            PG8_WAIT_V(6); PG8_BAR; PG8_MMA(1, 1, At, B1); PG8_BAR;
            }
        }
        if constexpr (ALIGN_EPI) { if (wr == 0) PG8_BAR; }
        if constexpr (F8) { PG8_SCHED; asm volatile("s_nop 15" ::: "memory"); PG8_SCHED; }
        if constexpr (PM != 1) E(acc, cur, wr, wc, fr, fq);
        if (!has_next) break;
#pragma unroll
        for (int a = 0; a < 2; ++a)
#pragma unroll
            for (int b = 0; b < 2; ++b)
#pragma unroll
                for (int m = 0; m < 4; ++m)
#pragma unroll
                    for (int n = 0; n < 2; ++n) acc[a][b][m][n] = (f32x4){0.f, 0.f, 0.f, 0.f};
        cur = nxt; cA = nA; cB = nB; ++ui;
        if constexpr (ALIGN_EPI) { if (wr == 1) PG8_BAR; }
    }
    PG8_WAIT_V(0);
    if constexpr (!ALIGN_EPI) { if (wr == 0) PG8_BAR; }
    PG8_BAR;
#undef PG8_SA
#undef PG8_SB
#undef PG8_STAGE2
#undef PG8_STAGE_B
#undef PG8_LOAD_IDS
#undef PG8_IDS_TO_VA
#undef PG8_LDA
#undef PG8_LDB
#undef PG8_MMA
#undef PG8_WAIT_V
#undef PG8_WAIT_L
#undef PG8_BAR
#undef PG8_SCHED
}
typedef f32x4 AccT[2][2][4][2];
struct EpiBf16 {
    static constexpr int PERM = 1;
    bf16_t* O; int ldc; const float* bias;
    __device__ __forceinline__ void operator()(const AccT& acc, const GUnit& u, int wr, int wc, int fr, int fq) const {
        const int row0 = u.row0 + wr * 64 + fr, col0 = u.col0 + wc * 32 + 8 * fq;
        f32x4 bv[2][2];
#pragma unroll
        for (int bj = 0; bj < 2; ++bj)
#pragma unroll
            for (int n = 0; n < 2; ++n) bv[bj][n] = bias ? *(const f32x4*)(bias + col0 + bj * HALF + 4 * n) : (f32x4){0.f, 0.f, 0.f, 0.f};
#pragma unroll
        for (int ai = 0; ai < 2; ++ai)
#pragma unroll
            for (int m = 0; m < 4; ++m) { bf16_t* rowp = O + (size_t)(row0 + ai * HALF + m * 16) * ldc + col0;
#pragma unroll
                for (int bj = 0; bj < 2; ++bj) { const f32x4 v0 = acc[ai][bj][m][0] + bv[bj][0], v1 = acc[ai][bj][m][1] + bv[bj][1];
                    *(u32x4*)(rowp + bj * HALF) = (u32x4){pk2(v0[0], v0[1]), pk2(v0[2], v0[3]), pk2(v1[0], v1[1]), pk2(v1[2], v1[3])}; } }
    }
};
struct EpiBf16Rs {
    static constexpr int PERM = 1;
    bf16_t* O; int ldc; const float* rs;
    __device__ __forceinline__ void operator()(const AccT& acc, const GUnit& u, int wr, int wc, int fr, int fq) const {
        const int row0 = u.row0 + wr * 64 + fr, col0 = u.col0 + wc * 32 + 8 * fq;
#pragma unroll
        for (int ai = 0; ai < 2; ++ai)
#pragma unroll
            for (int m = 0; m < 4; ++m) { const int row = row0 + ai * HALF + m * 16; const float sc = rs[row]; bf16_t* rowp = O + (size_t)row * ldc + col0;
#pragma unroll
                for (int bj = 0; bj < 2; ++bj) { const f32x4 v0 = acc[ai][bj][m][0] * sc, v1 = acc[ai][bj][m][1] * sc;
                    *(u32x4*)(rowp + bj * HALF) = (u32x4){pk2(v0[0], v0[1]), pk2(v0[2], v0[3]), pk2(v1[0], v1[1]), pk2(v1[2], v1[3])}; } }
    }
};
struct EpiResF32 {
    static constexpr int PERM = 0;
    const float* xin; float* out; int ldc; float ascale;
    __device__ __forceinline__ void operator()(const AccT& acc, const GUnit& u, int wr, int wc, int fr, int fq) const {
        const int row0 = u.row0 + wr * 64 + fr, col0 = u.col0 + wc * 32 + 4 * fq;
#pragma unroll
        for (int ai = 0; ai < 2; ++ai)
#pragma unroll
            for (int m = 0; m < 4; ++m) { const size_t off = (size_t)(row0 + ai * HALF + m * 16) * ldc + col0;
#pragma unroll
                for (int bj = 0; bj < 2; ++bj)
#pragma unroll
                    for (int n = 0; n < 2; ++n) { const f32x4 b = *(const f32x4*)(xin + off + bj * HALF + n * 16); *(f32x4*)(out + off + bj * HALF + n * 16) = b + acc[ai][bj][m][n] * ascale; }
                asm volatile("" ::: "memory"); }
    }
};
struct EpiResBf16 {
    static constexpr int PERM = 1;
    const float* xin32; const bf16_t* xin16; bf16_t* out;
    __device__ __forceinline__ void operator()(const AccT& acc, const GUnit& u, int wr, int wc, int fr, int fq) const {
        const int row0 = u.row0 + wr * 64 + fr, col0 = u.col0 + wc * 32 + 8 * fq;
#pragma unroll
        for (int ai = 0; ai < 2; ++ai)
#pragma unroll
            for (int m = 0; m < 4; ++m) { const size_t off = (size_t)(row0 + ai * HALF + m * 16) * 1024 + col0;
#pragma unroll
                for (int bj = 0; bj < 2; ++bj) { f32x4 v0 = acc[ai][bj][m][0], v1 = acc[ai][bj][m][1];
                    if (xin32) { v0 += *(const f32x4*)(xin32 + off + bj * HALF); v1 += *(const f32x4*)(xin32 + off + bj * HALF + 4); }
                    else { const u32x4 w = *(const u32x4*)(xin16 + off + bj * HALF); v0 += (f32x4){bflo(w.x), bfhi(w.x), bflo(w.y), bfhi(w.y)}; v1 += (f32x4){bflo(w.z), bfhi(w.z), bflo(w.w), bfhi(w.w)}; }
                    *(u32x4*)(out + off + bj * HALF) = (u32x4){pk2(v0[0], v0[1]), pk2(v0[2], v0[3]), pk2(v1[0], v1[1]), pk2(v1[2], v1[3])}; }
                asm volatile("" ::: "memory"); }
    }
};
struct EpiGlu {
    static constexpr int PERM = 1;
    bf16_t* act; const float* bgu_l;
    __device__ __forceinline__ void operator()(const AccT& acc, const GUnit& u, int wr, int wc, int fr, int fq) const {
        const int row0 = u.row0 + wr * 64 + fr, j0 = (u.col0 >> 1) + wc * 32 + 8 * fq;
        const float* bg = bgu_l + (size_t)u.e * 2048 + 2 * j0;
        f32x4 b0 = *(const f32x4*)(bg), b1 = *(const f32x4*)(bg + 4), b2 = *(const f32x4*)(bg + 8), b3 = *(const f32x4*)(bg + 12);
        const float bgl[8] = {b0[0], b0[2], b1[0], b1[2], b2[0], b2[2], b3[0], b3[2]}, bll[8] = {b0[1], b0[3], b1[1], b1[3], b2[1], b2[3], b3[1], b3[3]};
#pragma unroll
        for (int ai = 0; ai < 2; ++ai)
#pragma unroll
            for (int m = 0; m < 4; ++m) { float r[8];
#pragma unroll
                for (int n = 0; n < 2; ++n)
#pragma unroll
                    for (int i = 0; i < 4; ++i) { const float vg = acc[ai][0][m][n][i] + bgl[4 * n + i], vl = acc[ai][1][m][n][i] + bll[4 * n + i];
                        const float xg = fminf(vg, 7.f), xl = fminf(fmaxf(vl, -7.f), 7.f);
                        r[4 * n + i] = xg * (xl + 1.f) * __builtin_amdgcn_rcpf(1.f + __builtin_amdgcn_exp2f(-2.4554669595930156f * xg)); }
                *(u32x4*)(act + (size_t)(row0 + ai * HALF + m * 16) * 1024 + j0) = (u32x4){pk2(r[0], r[1]), pk2(r[2], r[3]), pk2(r[4], r[5]), pk2(r[6], r[7])}; }
    }
};
constexpr float W8_SCALE = 32.f, W8_INV = 1.f / 32.f;
struct EpiGlu8 {
    static constexpr int PERM = 1;
    unsigned char* act; const float* bgu_l; LAS const float* btab; int nbt;
    __device__ __forceinline__ void operator()(const AccT& acc, const GUnit& u, int wr, int wc, int fr, int fq) const {
        const int row0 = u.row0 + wr * 64 + fr, j0 = (u.col0 >> 1) + wc * 32 + 8 * fq;
        f32x4 b0, b1, b2, b3;
        const int ui_ = u.aux >> 16;
        if (ui_ < nbt) { const LAS float* bl = btab + ui_ * 256 + 2 * (wc * 32 + 8 * fq); b0 = *(const LAS f32x4*)(bl); b1 = *(const LAS f32x4*)(bl + 4); b2 = *(const LAS f32x4*)(bl + 8); b3 = *(const LAS f32x4*)(bl + 12); }
        else { const float* bg = bgu_l + (size_t)u.e * 2048 + 2 * j0; b0 = *(const f32x4*)(bg); b1 = *(const f32x4*)(bg + 4); b2 = *(const f32x4*)(bg + 8); b3 = *(const f32x4*)(bg + 12); }
        const f32x2 bgp[4] = {(f32x2){b0[0], b0[2]}, (f32x2){b1[0], b1[2]}, (f32x2){b2[0], b2[2]}, (f32x2){b3[0], b3[2]}};
        const f32x2 blp[4] = {(f32x2){b0[1] + 1.f, b0[3] + 1.f}, (f32x2){b1[1] + 1.f, b1[3] + 1.f}, (f32x2){b2[1] + 1.f, b2[3] + 1.f}, (f32x2){b3[1] + 1.f, b3[3] + 1.f}};
#pragma unroll
        for (int ai = 0; ai < 2; ++ai)
#pragma unroll
            for (int m = 0; m < 4; ++m) { f32x2 r[4];
#pragma unroll
                for (int n = 0; n < 2; ++n)
#pragma unroll
                    for (int hp = 0; hp < 2; ++hp) { const f32x2 ag = (f32x2){acc[ai][0][m][n][2 * hp], acc[ai][0][m][n][2 * hp + 1]}, al = (f32x2){acc[ai][1][m][n][2 * hp], acc[ai][1][m][n][2 * hp + 1]};
                        f32x2 vg = ag * W8_INV + bgp[2 * n + hp], vl = al * W8_INV + blp[2 * n + hp];
                        vg.x = fminf(vg.x, 7.f); vg.y = fminf(vg.y, 7.f); vl.x = __builtin_amdgcn_fmed3f(vl.x, -6.f, 8.f); vl.y = __builtin_amdgcn_fmed3f(vl.y, -6.f, 8.f);
                        const f32x2 t = vg * -2.4554669595930156f; f32x2 d; d.x = __builtin_amdgcn_exp2f(t.x); d.y = __builtin_amdgcn_exp2f(t.y); d = d + 1.f;
                        f32x2 rc; rc.x = __builtin_amdgcn_rcpf(d.x); rc.y = __builtin_amdgcn_rcpf(d.y);
                        r[2 * n + hp] = (vg * vl) * rc; }
                *(u32x2*)(act + (size_t)(row0 + ai * HALF + m * 16) * 1024 + j0) = (u32x2){pk4_fp8(r[0].x, r[0].y, r[1].x, r[1].y), pk4_fp8(r[2].x, r[2].y, r[3].x, r[3].y)}; }
    }
};
struct EpiDown {
    static constexpr int PERM = 1;
    bf16_t* yb; const float* bdn_l; const float* lgate; LAS const int* cnt; float ascale;
    __device__ __forceinline__ void operator()(const AccT& acc, const GUnit& u, int wr, int wc, int fr, int fq) const {
        const int rl0 = wr * 64 + fr, col0 = u.col0 + wc * 32 + 8 * fq; const int n_valid = __builtin_amdgcn_readfirstlane(cnt[u.e]);
        const float* bd = bdn_l + (size_t)u.e * 1024 + col0;
        f32x4 bv[2][2];
#pragma unroll
        for (int bj = 0; bj < 2; ++bj)
#pragma unroll
            for (int n = 0; n < 2; ++n) bv[bj][n] = *(const f32x4*)(bd + bj * HALF + 4 * n);
#pragma unroll
        for (int ai = 0; ai < 2; ++ai)
#pragma unroll
            for (int m = 0; m < 4; ++m) { const int rl = rl0 + ai * HALF + m * 16, li = u.aux + rl; const float g = (li < n_valid) ? lgate[(size_t)u.e * T + li] : 0.f;
                bf16_t* rowp = yb + (size_t)(u.row0 + rl) * 1024 + col0;
#pragma unroll
                for (int bj = 0; bj < 2; ++bj) { const f32x4 v0 = (acc[ai][bj][m][0] * ascale + bv[bj][0]) * g, v1 = (acc[ai][bj][m][1] * ascale + bv[bj][1]) * g;
                    *(u32x4*)(rowp + bj * HALF) = (u32x4){pk2(v0[0], v0[1]), pk2(v0[2], v0[3]), pk2(v1[0], v1[1]), pk2(v1[2], v1[3])}; } }
    }
};
constexpr float YB_SCALE = 8.f;
struct EpiDown8 {
    static constexpr int PERM = 2;
    unsigned char* yb; const float* bdn_l; LAS const float* btab; int nbt;
    __device__ __forceinline__ void operator()(const AccT& acc, const GUnit& u, int wr, int wc, int fr, int fq) const {
        const int rl0 = wr * 64 + fr, col0 = u.col0 + wc * 64 + 16 * fq;
        const float* bd = bdn_l + (size_t)u.e * 1024 + col0;
        f32x4 bv[2][2]; const int ui_ = u.aux >> 16;
        if (ui_ < nbt) { const LAS float* bl = btab + ui_ * 256 + wc * 64 + 16 * fq;
#pragma unroll
            for (int bj = 0; bj < 2; ++bj)
#pragma unroll
                for (int n = 0; n < 2; ++n) bv[bj][n] = *(const LAS f32x4*)(bl + 8 * bj + 4 * n) * YB_SCALE; }
        else {
#pragma unroll
        for (int bj = 0; bj < 2; ++bj)
#pragma unroll
            for (int n = 0; n < 2; ++n) bv[bj][n] = *(const f32x4*)(bd + 8 * bj + 4 * n) * YB_SCALE; }
#pragma unroll
        for (int ai = 0; ai < 2; ++ai)
#pragma unroll
            for (int m = 0; m < 4; ++m) { const int rl = rl0 + ai * HALF + m * 16;
                u32x4 o;
#pragma unroll
                for (int bj = 0; bj < 2; ++bj)
#pragma unroll
                    for (int n = 0; n < 2; ++n) { const f32x4 v = acc[ai][bj][m][n] * (W8_INV * YB_SCALE) + bv[bj][n]; o[2 * bj + n] = pk4_fp8(v[0], v[1], v[2], v[3]); }
                *(u32x4*)(yb + (size_t)(u.row0 + rl) * 1024 + col0) = o; }
    }
};
struct DenseSched {
    const unsigned char* A; const unsigned char* Bt; int lda, K, nM, nN, G, c, es;
    __device__ __forceinline__ bool next(int i, GUnit& u) const { const int L = i * G + c; if (L >= nM * nN) return false; int pm, pn; tile_of(L, nM, nN, pm, pn);
        u.A = A + (size_t)pm * 256 * lda * es; u.B = Bt + (size_t)pn * 256 * K * es; u.row0 = pm * 256; u.col0 = pn * 256; u.e = 0; u.aux = 0; return true; }
    __device__ __forceinline__ int rowid(const GUnit&, int R) const { return R; }
    __device__ __forceinline__ unsigned idoff(int id) const { return (unsigned)(id * lda * es); }
};
template <bool GATHER, int RB> struct MoeSched {
    const unsigned char* A; const unsigned char* Wt; const int* ltok; LAS const int* ctl; int nN, G, c;
    LAS const unsigned short* tokt; int ntab; int fix;
    __device__ __forceinline__ bool locate(int i, int& pm, int& pn, int& e, int& rb) const { const int nM = __builtin_amdgcn_readfirstlane(ctl[32 + NEXP]); const int L = i * G + c; if (L >= nM * nN) return false; tile_of(L, nM, nN, pm, pn);
        e = 0;
        for (int k = 1; k < NEXP; ++k) e += (__builtin_amdgcn_readfirstlane(ctl[32 + k]) <= pm) ? 1 : 0;
        rb = __builtin_amdgcn_readfirstlane(ctl[32 + e]); return true; }
    __device__ __forceinline__ bool next(int i, GUnit& u) const { int pm, pn, e, rb; if (!locate(i, pm, pn, e, rb)) return false;
        u.A = GATHER ? A : A + (size_t)((fix & 2) ? 0 : pm) * 256 * RB; u.B = Wt + ((size_t)((fix & 1) ? 0 : e) * nN + ((fix & 1) ? 0 : pn)) * 256 * RB;   u.row0 = pm * 256; u.col0 = pn * 256; u.e = e; u.aux = (i << 16) | (pm - rb); return true; }
    __device__ __forceinline__ int rowid(const GUnit& u, int R) const {
        if (GATHER) return (int)tokt[(u.aux >> 16) * 256 + R];
        return R; }
    __device__ __forceinline__ unsigned idoff(int id) const { return (unsigned)id * (unsigned)RB; }
};
}

__device__ __forceinline__ void moe_tables(const Ctx& C, int l) {
    LAS int* ctl = (LAS int*)(C.lds + LDS_CTL);
    __syncthreads();
    if (C.tid < NEXP) ctl[C.tid] = (int)__hip_atomic_load(WSP(unsigned, WS_CTL) + CW_GCNT + (l * NEXP + C.tid) * 64, __ATOMIC_RELAXED, __HIP_MEMORY_SCOPE_AGENT);
    __syncthreads();
    if (C.tid == 0) { int a = 0; for (int e = 0; e < NEXP; ++e) { ctl[32 + e] = a; a += (ctl[e] + 255) >> 8; } ctl[32 + NEXP] = a; }
    __syncthreads();
}
__device__ __forceinline__ int moe_find_expert(const Ctx& C, int rt) {
    LAS int* ctl = (LAS int*)(C.lds + LDS_CTL);
    int e = 0;
    for (int k = 1; k < NEXP; ++k) e += (ctl[32 + k] <= rt) ? 1 : 0;
    return e;
}

__device__ __forceinline__ void ph_inproj(const Ctx& C, int l) {
    const bf16_t* hb = WSP(bf16_t, WS_HB); const bf16_t* W = WSP(bf16_t, WS_WIN) + (size_t)l * DINP * 1024; bf16_t* z = WSP(bf16_t, WS_Z);
    for (int u = C.bid; u < 256 * 10; u += C.G) { const int rt = u / 10, ct = u % 10;
        sg_tile<1>(C, [&](int r) { return hb + (size_t)(rt * 128 + r) * 1024; }, W + (size_t)ct * 128 * 1024, nullptr, 1024,
                   [&](int r, int c, float v, float) { z[(size_t)(rt * 128 + r) * DINP + ct * 128 + c] = (bf16_t)f2bf(v); });
    }
}
template <int SKIP = 0> __device__ __forceinline__ void ph_mix1(const Ctx& C, int l) {
    const bf16_t* z = WSP(bf16_t, WS_Z); bf16_t* A2 = WSP(bf16_t, WS_A2);
    LAS float* vs = (LAS float*)C.lds;
    LAS float* dw = (LAS float*)(C.lds + 62 * 256 * 4);
    const int tid = C.tid, c = tid & 255, half = tid >> 8;
    float wj[31];
#pragma unroll
    for (int j = 0; j < 31; ++j) wj[j] = WSP(float, WS_PAR)[P_CDW + (l * 31 + j) * 256 + c];
    const float cb = WSP(float, WS_PAR)[P_CDWB + l * 256 + c];
    u32x4 ga[4], gg[4];
#define MIX1_LOAD(TILE) do { const int tok0_ = (TILE) * 32, s0_ = tok0_ % SEQ; _Pragma("unroll") for (int p = 0; p < 4; ++p) { const int row = p * 16 + (tid >> 5), ch8 = (tid & 31) * 8; const int srow = s0_ - 30 + row; \
              if (row < 62 && srow >= 0) { const bf16_t* zr = z + (size_t)(tok0_ - 30 + row) * DINP; ga[p] = *(const u32x4*)(zr + 256 + ch8); gg[p] = *(const u32x4*)(zr + 512 + ch8); } \
              else { ga[p] = (u32x4){0u, 0u, 0u, 0u}; gg[p] = (u32x4){0u, 0u, 0u, 0u}; } } } while (0)
    if (C.bid < T / 32 && !(SKIP & 4)) MIX1_LOAD(C.bid);
    for (int tile = C.bid; tile < T / 32; tile += C.G) {
        const int tok0 = tile * 32, s0 = tok0 % SEQ;
        if (!(SKIP & 4)) {
#pragma unroll
          for (int p = 0; p < 4; ++p) { const int row = p * 16 + (tid >> 5), ch8 = (tid & 31) * 8;
              if (row < 62) { const u32x4 a = ga[p], g = gg[p]; float v[8];
                  v[0] = bflo(a.x) * sigmoidf_(bflo(g.x)); v[1] = bfhi(a.x) * sigmoidf_(bfhi(g.x)); v[2] = bflo(a.y) * sigmoidf_(bflo(g.y)); v[3] = bfhi(a.y) * sigmoidf_(bfhi(g.y));
                  v[4] = bflo(a.z) * sigmoidf_(bflo(g.z)); v[5] = bfhi(a.z) * sigmoidf_(bfhi(g.z)); v[6] = bflo(a.w) * sigmoidf_(bflo(g.w)); v[7] = bfhi(a.w) * sigmoidf_(bfhi(g.w));
                  *(LAS f32x4*)(vs + row * 256 + ch8) = (f32x4){v[0], v[1], v[2], v[3]}; *(LAS f32x4*)(vs + row * 256 + ch8 + 4) = (f32x4){v[4], v[5], v[6], v[7]}; } }
          if (tile + C.G < T / 32) MIX1_LOAD(tile + C.G); }
        __syncthreads();
        if (!(SKIP & 2)) { float vv[46];
#pragma unroll
            for (int r = 0; r < 46; ++r) vv[r] = vs[(half * 16 + r) * 256 + c];
#pragma unroll
            for (int i = 0; i < 16; ++i) { float acc = cb;
#pragma unroll
                for (int j = 0; j < 31; ++j) acc += vv[i + j] * wj[j];
                dw[(half * 16 + i) * 256 + c] = acc; } }
        __syncthreads();
        if (!(SKIP & 8)) for (int q = 0; q < 4; ++q) { const int tl = C.wave * 4 + q, ch = C.lane * 4;
            const f32x4 x = *(const LAS f32x4*)(dw + tl * 256 + ch);
            const float mean = wave_sum((x.x + x.y) + (x.z + x.w)) * (1.f / 256.f);
            const f32x4 d = x - mean;
            const float var = wave_sum((d.x * d.x + d.y * d.y) + (d.z * d.z + d.w * d.w)) * (1.f / 256.f);
            const float rstd = rsqrtf(var + EPS);
            const f32x4 g = *(const f32x4*)(WSP(float, WS_PAR) + P_CLNG + l * 256 + ch), b = *(const f32x4*)(WSP(float, WS_PAR) + P_CLNB + l * 256 + ch);
            f32x4 y = d * rstd * g + b;
            y.x *= sigmoidf_(y.x); y.y *= sigmoidf_(y.y); y.z *= sigmoidf_(y.z); y.w *= sigmoidf_(y.w);
            *(u32x2*)(A2 + (size_t)(tok0 + tl) * 512 + 256 + ch) = (u32x2){pk2(y.x, y.y), pk2(y.z, y.w)}; }
        if (!(SKIP & 1)) { const int cp = tid & 127, tg = tid >> 7, g = cp >> 5, tf = s0 + tg * 8; const bf16_t* zc = z + (size_t)(tok0 - s0) * DINP + 2 * cp;
          float u0[23], u1[23];
#pragma unroll
          for (int d = 0; d < 23; ++d) { const int sq = tf - 15 + d; const unsigned wv = (sq >= 0) ? *(const unsigned*)(zc + (size_t)sq * DINP) : 0u; u0[d] = bflo(wv); u1[d] = bfhi(wv); }
          bf16_t* ao = A2 + (size_t)(tok0 - s0 + tf) * 512 + 2 * cp;
#define POOL_W(W) do { _Pragma("unroll") for (int i = 0; i < 8; ++i) { float sa = 0.f, sb = 0.f; _Pragma("unroll") for (int d = 0; d < (W); ++d) { sa += u0[15 + i - d]; sb += u1[15 + i - d]; } \
              const int sq = tf + i; const int cnt = (sq + 1 < (W)) ? (sq + 1) : (W); const float rc = __builtin_amdgcn_rcpf((float)cnt); \
              *(unsigned*)(ao + (size_t)i * 512) = pk2(sa * rc - u0[15 + i], sb * rc - u1[15 + i]); } } while (0)
          if (g == 0) POOL_W(2); else if (g == 1) POOL_W(4); else if (g == 2) POOL_W(8); else POOL_W(16);
#undef POOL_W
        }
        __syncthreads();
    }
#undef MIX1_LOAD
}
__device__ __forceinline__ void ph_smallgemm(const Ctx& C, int l) {
    const bf16_t* z = WSP(bf16_t, WS_Z); const bf16_t* A2 = WSP(bf16_t, WS_A2);
    const bf16_t* Wm = WSP(bf16_t, WS_WMIX) + (size_t)l * 512 * 512; const bf16_t* Wq = WSP(bf16_t, WS_WQ) + (size_t)l * 768 * 256; const bf16_t* Wkv = WSP(bf16_t, WS_WKV) + (size_t)l * 1024 * 256;
    bf16_t* ymix = WSP(bf16_t, WS_YMIX); bf16_t* qraw = WSP(bf16_t, WS_QRAW); bf16_t* kvraw = WSP(bf16_t, WS_KVRAW);
    const float* pwb = WSP(float, WS_PAR) + P_CPWB + l * 256;
    for (int u = C.bid; u < 256 * (4 + 6 + 8); u += C.G) { const int rt = u / 18, q = u % 18;
        if (q < 4) { const int ct = q;
            sg_tile<1>(C, [&](int r) { return A2 + (size_t)(rt * 128 + r) * 512; }, Wm + (size_t)ct * 128 * 512, nullptr, 512,
                       [&](int r, int c, float v, float) { const int col = ct * 128 + c; if (col >= 256) v += pwb[col - 256]; ymix[(size_t)(rt * 128 + r) * 512 + col] = (bf16_t)f2bf(v); });
        } else if (q < 10) { const int ct = q - 4;
            sg_tile<1>(C, [&](int r) { return z + (size_t)(rt * 128 + r) * DINP + 768; }, Wq + (size_t)ct * 128 * 256, nullptr, 256,
                       [&](int r, int c, float v, float) { qraw[(size_t)(rt * 128 + r) * 768 + ct * 128 + c] = (bf16_t)f2bf(v); });
        } else { const int ct = q - 10;
            sg_tile<1>(C, [&](int r) { return z + (size_t)(rt * 128 + r) * DINP + 1024; }, Wkv + (size_t)ct * 128 * 256, nullptr, 256,
                       [&](int r, int c, float v, float) { kvraw[(size_t)(rt * 128 + r) * 1024 + ct * 128 + c] = (bf16_t)f2bf(v); });
        }
    }
}
struct QkIn { u32x2 cq; unsigned ckv; f32x2 cs0, cs1; u32x4 qa; unsigned qp1, qp2; u32x4 ka; unsigned kp1, kp2; u32x4 vv; };
__device__ __forceinline__ QkIn qk_load(const Ctx& C, int t, int lane) {
    const bf16_t* zr = WSP(bf16_t, WS_Z) + (size_t)t * DINP; const int h = lane >> 4, l16 = lane & 15;
    const bf16_t* qr = WSP(bf16_t, WS_QRAW) + (size_t)t * 768 + 192 * h; const bf16_t* kr = WSP(bf16_t, WS_KVRAW) + (size_t)t * 1024 + 256 * h; const f32x2* cs = WSP(f32x2, WS_COS) + (size_t)t * 32 + 2 * l16;
    QkIn r; r.cq = *(const u32x2*)(zr + 768 + 4 * lane); r.ckv = *(const unsigned*)(zr + 1024 + 2 * lane); r.cs0 = cs[0]; r.cs1 = cs[1];
    r.qa = *(const u32x4*)(qr + 8 * l16); r.qp1 = *(const unsigned*)(qr + 128 + 2 * l16); r.qp2 = *(const unsigned*)(qr + 160 + 2 * l16);
    r.ka = *(const u32x4*)(kr + 8 * l16); r.kp1 = *(const unsigned*)(zr + 1152 + 2 * l16); r.kp2 = *(const unsigned*)(zr + 1184 + 2 * l16); r.vv = ATT_PV8 ? (u32x4){0u, 0u, 0u, 0u} : *(const u32x4*)(kr + 128 + 8 * l16);
    return r;
}
template <int SKIP = 0> __device__ __forceinline__ void ph_qkfin(const Ctx& C, int l) {
    bf16_t* Qb = WSP(bf16_t, WS_Q);
    const int lane = C.lane, h = lane >> 4, l16 = lane & 15;
    const float* qg = WSP(float, WS_PAR) + P_QNG + l * 192; const float* kg = WSP(float, WS_PAR) + P_KNG + l * 192;
    float gq[12], gk[12];
#pragma unroll
    for (int i = 0; i < 8; ++i) { gq[i] = qg[8 * l16 + i]; gk[i] = kg[8 * l16 + i]; }
#pragma unroll
    for (int i = 0; i < 2; ++i) { gq[8 + i] = qg[128 + 2 * l16 + i]; gq[10 + i] = qg[160 + 2 * l16 + i]; gk[8 + i] = kg[128 + 2 * l16 + i]; gk[10 + i] = kg[160 + 2 * l16 + i]; }
    const int stride = C.G * NWAVE; int t = C.bid * NWAVE + C.wave;
    if (t >= T) return;
    QkIn cur = qk_load(C, t, lane), cur2 = cur;
    if (t + stride < T) cur2 = qk_load(C, t + stride, lane);
    for (; t < T; t += stride) {
        const QkIn in = cur; cur = cur2;
        if (t + 2 * stride < T) cur2 = qk_load(C, t + 2 * stride, lane);
        float rsq, rskv;
        { const float x0 = bflo(in.cq.x), x1 = bfhi(in.cq.x), x2 = bflo(in.cq.y), x3 = bfhi(in.cq.y);
          rsq = rsqrtf(wave_sum((x0 * x0 + x1 * x1) + (x2 * x2 + x3 * x3)) * (1.f / 256.f) + EPS); }
        { const float x0 = bflo(in.ckv), x1 = bfhi(in.ckv);
          rskv = rsqrtf(wave_sum(x0 * x0 + x1 * x1) * (1.f / 128.f) + EPS); }
        const f32x2 cs0 = in.cs0, cs1 = in.cs1;
        { const u32x4 a = in.qa; const unsigned p1 = in.qp1, p2 = in.qp2;
          float v[12] = {bflo(a.x), bfhi(a.x), bflo(a.y), bfhi(a.y), bflo(a.z), bfhi(a.z), bflo(a.w), bfhi(a.w), bflo(p1), bfhi(p1), bflo(p2), bfhi(p2)};
          float ss = 0.f;
#pragma unroll
          for (int i = 0; i < 12; ++i) { v[i] *= rsq; ss += v[i] * v[i]; }
          const float rh = rsqrtf(grp16_sum(ss) * (1.f / 192.f) + EPS);
#pragma unroll
          for (int i = 0; i < 12; ++i) v[i] *= rh * gq[i];
          const float o10 = v[8] * cs0.x - v[10] * cs0.y, o20 = v[10] * cs0.x + v[8] * cs0.y, o11 = v[9] * cs1.x - v[11] * cs1.y, o21 = v[11] * cs1.x + v[9] * cs1.y;
#if ATT_QK8
          unsigned char* qo = (unsigned char*)Qb + (size_t)t * 768 + 192 * h;
          if (!(SKIP & 4)) { *(u32x2*)(qo + 8 * l16) = (u32x2){pk4_fp8(v[0], v[1], v[2], v[3]), pk4_fp8(v[4], v[5], v[6], v[7])};
              *(unsigned*)(qo + 128 + 4 * l16) = pk4_fp8(o10, o11, o20, o21); } }
#else
          bf16_t* qo = Qb + (size_t)t * 768 + 192 * h;
          if (!(SKIP & 4)) { *(u32x4*)(qo + 8 * l16) = (u32x4){pk2(v[0], v[1]), pk2(v[2], v[3]), pk2(v[4], v[5]), pk2(v[6], v[7])};
              *(u32x2*)(qo + 128 + 4 * l16) = (u32x2){pk2(o10, o11), pk2(o20, o21)}; } }
#endif
        { const u32x4 a = in.ka; const unsigned p1 = in.kp1, p2 = in.kp2;
          float v[12] = {bflo(a.x) * rskv, bfhi(a.x) * rskv, bflo(a.y) * rskv, bfhi(a.y) * rskv, bflo(a.z) * rskv, bfhi(a.z) * rskv, bflo(a.w) * rskv, bfhi(a.w) * rskv, bflo(p1), bfhi(p1), bflo(p2), bfhi(p2)};
          float ss = 0.f;
#pragma unroll
          for (int i = 0; i < 12; ++i) ss += v[i] * v[i];
          const float rh = rsqrtf(grp16_sum(ss) * (1.f / 192.f) + EPS);
#pragma unroll
          for (int i = 0; i < 12; ++i) v[i] *= rh * gk[i];
          const float o10 = v[8] * cs0.x - v[10] * cs0.y, o20 = v[10] * cs0.x + v[8] * cs0.y, o11 = v[9] * cs1.x - v[11] * cs1.y, o21 = v[11] * cs1.x + v[9] * cs1.y;
#if ATT_QK8
          unsigned char* ko = C.ws + WS_KIMG + (size_t)t * 768 + 192 * h;
          if (!(SKIP & 1)) { *(u32x2*)(ko + 8 * l16) = (u32x2){pk4_fp8(v[0], v[1], v[2], v[3]), pk4_fp8(v[4], v[5], v[6], v[7])};
              *(unsigned*)(ko + 128 + 4 * l16) = pk4_fp8(o10, o11, o20, o21); }
#else
          bf16_t* ko = WSP(bf16_t, WS_KIMG) + (size_t)t * 768 + 192 * h;
          if (!(SKIP & 1)) { *(u32x4*)(ko + 8 * l16) = (u32x4){pk2(v[0], v[1]), pk2(v[2], v[3]), pk2(v[4], v[5]), pk2(v[6], v[7])};
              *(u32x2*)(ko + 128 + 4 * l16) = (u32x2){pk2(o10, o11), pk2(o20, o21)}; }
#endif
          const u32x4 vv = in.vv;
          if (!(SKIP & 2) && !ATT_PV8) *(u32x4*)(WSP(bf16_t, WS_VIMG) + (size_t)t * 512 + 128 * h + 8 * l16) = (u32x4){pk2(bflo(vv.x) * rskv, bfhi(vv.x) * rskv), pk2(bflo(vv.y) * rskv, bfhi(vv.y) * rskv), pk2(bflo(vv.z) * rskv, bfhi(vv.z) * rskv), pk2(bflo(vv.w) * rskv, bfhi(vv.w) * rskv)}; }
    }
}
#if ATT_PV8
__device__ __forceinline__ void ph_vtbuild(const Ctx& C, int l) {
    const bf16_t* z = WSP(bf16_t, WS_Z); const bf16_t* kv = WSP(bf16_t, WS_KVRAW); unsigned char* vt = C.ws + WS_VIMG;
    LAS unsigned char* img = C.lds; LAS float* rsl = (LAS float*)(C.lds + 32768);
    const int tid = C.tid, lane = C.lane, w = C.wave;
    __syncthreads();
    for (int it = C.bid; it < T / 64; it += C.G) { const int tok0 = it * 64;
        { const int tt = tid >> 3, part = tid & 7; const u32x4* cp = (const u32x4*)(z + (size_t)(tok0 + tt) * DINP + 1024 + 16 * part); const u32x4 a = cp[0], b = cp[1];
          float ss = bflo(a.x) * bflo(a.x) + bfhi(a.x) * bfhi(a.x) + bflo(a.y) * bflo(a.y) + bfhi(a.y) * bfhi(a.y) + bflo(a.z) * bflo(a.z) + bfhi(a.z) * bfhi(a.z) + bflo(a.w) * bflo(a.w) + bfhi(a.w) * bfhi(a.w)
                   + bflo(b.x) * bflo(b.x) + bfhi(b.x) * bfhi(b.x) + bflo(b.y) * bflo(b.y) + bfhi(b.y) * bfhi(b.y) + bflo(b.z) * bflo(b.z) + bfhi(b.z) * bfhi(b.z) + bflo(b.w) * bflo(b.w) + bfhi(b.w) * bfhi(b.w);
          ss += __shfl_xor(ss, 1); ss += __shfl_xor(ss, 2); ss += __shfl_xor(ss, 4);
          if (part == 0) rsl[tt] = rsqrtf(ss * (1.f / 128.f) + EPS); }
        const int hh = w >> 1, vc0 = (w & 1) * 64;
        const u32x4* vp = (const u32x4*)(kv + (size_t)(tok0 + lane) * 1024 + 256 * hh + 128 + vc0);
        u32x4 v8[8];
#pragma unroll
        for (int i = 0; i < 8; ++i) v8[i] = vp[i];
        __syncthreads();
        const float rs = rsl[lane];
        LAS unsigned char* dst = img + (size_t)((hh * 128 + vc0) * 64 + lane);
#pragma unroll
        for (int i = 0; i < 8; ++i) { const u32x4 q = v8[i];
            const unsigned w0 = pk4_fp8(bflo(q.x) * rs, bfhi(q.x) * rs, bflo(q.y) * rs, bfhi(q.y) * rs), w1 = pk4_fp8(bflo(q.z) * rs, bfhi(q.z) * rs, bflo(q.w) * rs, bfhi(q.w) * rs);
#pragma unroll
            for (int j = 0; j < 4; ++j) { dst[(8 * i + j) * 64] = (unsigned char)(w0 >> (8 * j)); dst[(8 * i + 4 + j) * 64] = (unsigned char)(w1 >> (8 * j)); } }
        __syncthreads();
#pragma unroll
        for (int k = 0; k < 4; ++k) { const int q = tid + 512 * k; *(u32x4*)(vt + (size_t)it * 32768 + (size_t)q * 16) = *(const LAS u32x4*)(img + q * 16); }
        __syncthreads();
    }
}
#endif
typedef float f32x16 __attribute__((ext_vector_type(16)));
typedef short s16x4 __attribute__((ext_vector_type(4)));
constexpr int AT_KB = ATT_QK8 ? 12288 : 24576, AT_VB = ATT_PV8 ? 8192 : 16384, AT_NS = 3;
constexpr int AT_K = 0, AT_V = AT_NS * AT_KB, AT_WS = AT_V + AT_NS * AT_VB;
constexpr float AT_SCALE = 0.07216878364870323f;
constexpr float AT_THR = 8.f;
#define SBAR() __builtin_amdgcn_sched_barrier(0)
__device__ __forceinline__ int crow(int r, int hi) { return (r & 3) + 8 * (r >> 2) + 4 * hi; }
__device__ __forceinline__ unsigned cvtpk(float lo, float hi) { unsigned r; asm volatile("v_cvt_pk_bf16_f32 %0, %1, %2" : "=v"(r) : "v"(lo), "v"(hi)); return r; }
__device__ __forceinline__ void glds16(const void* sbase, unsigned voff, unsigned lds_dst) { unsigned keep;
    asm volatile("s_mov_b32 %0, m0\n\ts_mov_b32 m0, %3\n\ts_nop 0\n\tglobal_load_lds_dwordx4 %1, %2\n\ts_mov_b32 m0, %0" : "=&s"(keep) : "v"(voff), "s"(sbase), "s"(lds_dst) : "memory"); }
__device__ __forceinline__ const unsigned char* uniform_ptr(const unsigned char* p) { const unsigned long long v = (unsigned long long)p;
    const unsigned lo = __builtin_amdgcn_readfirstlane((unsigned)v), hi = __builtin_amdgcn_readfirstlane((unsigned)(v >> 32)); return (const unsigned char*)(((unsigned long long)hi << 32) | lo); }
__device__ __forceinline__ void at_partialSM(f32x16& p0, f32x16& p1, float& m_reg, float& mn, float& alpha) {
    constexpr float Cc = AT_SCALE * 1.4426950408889634f;
    float pmax = p0[0];
#pragma unroll
    for (int r = 1; r < 16; ++r) pmax = fmaxf(pmax, p0[r]);
#pragma unroll
    for (int r = 0; r < 16; ++r) pmax = fmaxf(pmax, p1[r]);
    { auto rr = __builtin_amdgcn_permlane32_swap(__float_as_uint(pmax), __float_as_uint(pmax), false, false);
      pmax = fmaxf(__uint_as_float(rr[0]), __uint_as_float(rr[1])); }
    if (__builtin_expect(__all(pmax - m_reg <= AT_THR / AT_SCALE), 1)) { mn = m_reg; alpha = 1.f; }
    else { mn = fmaxf(m_reg, pmax); alpha = __builtin_amdgcn_exp2f((m_reg - mn) * Cc); m_reg = mn; }
    const float mnC = -mn * Cc + (ATT_PV8 ? 4.f : 0.f);
#pragma unroll
    for (int r = 0; r < 16; ++r) p0[r] = fmaf(p0[r], Cc, mnC);
#pragma unroll
    for (int r = 0; r < 16; ++r) p1[r] = fmaf(p1[r], Cc, mnC);
#pragma unroll
    for (int r = 0; r < 16; ++r) p0[r] = __builtin_amdgcn_exp2f(p0[r]);
}
__device__ __forceinline__ void at_finishSM(f32x16& p0, f32x16& p1, float alpha, float& l_reg, bf16x8& pa0, bf16x8& pa1, bf16x8& pa2, bf16x8& pa3) {
#pragma unroll
    for (int r = 0; r < 16; ++r) p1[r] = __builtin_amdgcn_exp2f(p1[r]);
    float ps = 0.f;
#pragma unroll
    for (int r = 0; r < 16; ++r) ps += p0[r];
#pragma unroll
    for (int r = 0; r < 16; ++r) ps += p1[r];
    { auto rr = __builtin_amdgcn_permlane32_swap(__float_as_uint(ps), __float_as_uint(ps), false, false);
      ps = __uint_as_float(rr[0]) + __uint_as_float(rr[1]); }
    l_reg = l_reg * alpha + ps;
#define PK4(P, BASE, OUT) do { unsigned a0 = cvtpk(P[BASE + 0], P[BASE + 1]), a1 = cvtpk(P[BASE + 2], P[BASE + 3]);   \
    unsigned b0 = cvtpk(P[BASE + 4], P[BASE + 5]), b1 = cvtpk(P[BASE + 6], P[BASE + 7]);                              \
    auto r0 = __builtin_amdgcn_permlane32_swap(a0, b0, false, false); auto r1 = __builtin_amdgcn_permlane32_swap(a1, b1, false, false); \
    u32x4 w = {r0[0], r1[0], r0[1], r1[1]}; OUT = __builtin_bit_cast(bf16x8, w); } while (0)
    PK4(p0, 0, pa0); PK4(p0, 8, pa1); PK4(p1, 0, pa2); PK4(p1, 8, pa3);
#undef PK4
}
__device__ __forceinline__ void at_qkt(f32x16& p0, f32x16& p1, const LAS char* ks, const int (&kro)[4], const bf16x8* qr) {
    p0 = f32x16{}; p1 = f32x16{};
#pragma unroll
    for (int d0 = 0; d0 < 12; ++d0) {
        const bf16x8 b0 = *(const LAS bf16x8*)(ks + kro[d0 & 3] + 128 * (d0 >> 2));
        const bf16x8 b1 = *(const LAS bf16x8*)(ks + kro[d0 & 3] + 128 * (d0 >> 2) + 12288);
        p0 = __builtin_amdgcn_mfma_f32_32x32x16_bf16(b0, qr[d0], p0, 0, 0, 0);
        p1 = __builtin_amdgcn_mfma_f32_32x32x16_bf16(b1, qr[d0], p1, 0, 0, 0); }
}
#if ATT_QK8
typedef int at_v8i __attribute__((ext_vector_type(8)));
__device__ __forceinline__ at_v8i at_cat8(u32x4 lo, u32x4 hi) { return (at_v8i){(int)lo.x, (int)lo.y, (int)lo.z, (int)lo.w, (int)hi.x, (int)hi.y, (int)hi.z, (int)hi.w}; }
__device__ __forceinline__ void at_qkt8(f32x16& p0, f32x16& p1, const LAS char* ks, int kb0, int kb1, const at_v8i* qf) {
    p0 = f32x16{}; p1 = f32x16{};
#pragma unroll
    for (int s = 0; s < 3; ++s) {
        const u32x4 a0 = *(const LAS u32x4*)(ks + kb0 + 64 * s), a1 = *(const LAS u32x4*)(ks + kb1 + 64 * s);
        const u32x4 b0 = *(const LAS u32x4*)(ks + kb0 + 64 * s + 6144), b1 = *(const LAS u32x4*)(ks + kb1 + 64 * s + 6144);
        p0 = __builtin_amdgcn_mfma_scale_f32_32x32x64_f8f6f4(at_cat8(a0, a1), qf[s], p0, 0, 0, 0, 0, 0, 0);
        p1 = __builtin_amdgcn_mfma_scale_f32_32x32x64_f8f6f4(at_cat8(b0, b1), qf[s], p1, 0, 0, 0, 0, 0, 0); }
}
#endif
#if ATT_PV8
__device__ __forceinline__ unsigned pk4_bf8(float a, float b, float c, float d) { unsigned w = 0; w = __builtin_amdgcn_cvt_pk_bf8_f32(a, b, w, false); w = __builtin_amdgcn_cvt_pk_bf8_f32(c, d, w, true); return w; }
__device__ __forceinline__ void at_packP8(const f32x16& p0, const f32x16& p1, at_v8i& PA) {
#pragma unroll
    for (int g = 0; g < 4; ++g) { const unsigned a = pk4_bf8(p0[4 * g], p0[4 * g + 1], p0[4 * g + 2], p0[4 * g + 3]), b = pk4_bf8(p1[4 * g], p1[4 * g + 1], p1[4 * g + 2], p1[4 * g + 3]);
        auto r = __builtin_amdgcn_permlane32_swap(a, b, false, false); PA[2 * g] = (int)r[0]; PA[2 * g + 1] = (int)r[1]; }
}
__device__ __forceinline__ void at_finishSM8(f32x16& p0, f32x16& p1, float alpha, float& l_reg, at_v8i& PA) {
#pragma unroll
    for (int r = 0; r < 16; ++r) p1[r] = __builtin_amdgcn_exp2f(p1[r]);
    float ps = 0.f;
#pragma unroll
    for (int r = 0; r < 16; ++r) ps += p0[r];
#pragma unroll
    for (int r = 0; r < 16; ++r) ps += p1[r];
    { auto rr = __builtin_amdgcn_permlane32_swap(__float_as_uint(ps), __float_as_uint(ps), false, false);
      ps = __uint_as_float(rr[0]) + __uint_as_float(rr[1]); }
    l_reg = l_reg * alpha + ps;
    at_packP8(p0, p1, PA);
}
__device__ __forceinline__ void pv8(f32x16* o, const LAS char* vs, int vk0, int vk1, const at_v8i& PA) {
#pragma unroll
    for (int d0 = 0; d0 < 4; ++d0) { const u32x4 a = *(const LAS u32x4*)(vs + vk0 + 2048 * d0), b = *(const LAS u32x4*)(vs + vk1 + 2048 * d0);
        o[d0] = __builtin_amdgcn_mfma_scale_f32_32x32x64_f8f6f4(PA, at_cat8(a, b), o[d0], 1, 0, 0, 0, 0, 0); }
}
#endif
__device__ __forceinline__ int v_rd_base(int lane) { return ((lane & 3) << 3) | (((lane >> 2) & 3) << 6) | (((lane >> 4) & 1) << 5) | (((lane >> 5) & 1) << 8); }
constexpr int v_rd_off(int d0, int ks, int half) { return d0 * 512 + ks * 4096 + half * 2048; }
template <int OFF> __device__ __forceinline__ s16x4 tr_read(int vb) { s16x4 r; asm volatile("ds_read_b64_tr_b16 %0, %1 offset:%2" : "=&v"(r) : "v"(vb), "i"(OFF) : "memory"); return r; }
template <int D0> __device__ __forceinline__ void pv_one(f32x16& od, int vb, bf16x8 pa0, bf16x8 pa1, bf16x8 pa2, bf16x8 pa3) {
    const s16x4 l0 = tr_read<v_rd_off(D0, 0, 0)>(vb), h0 = tr_read<v_rd_off(D0, 0, 1)>(vb), l1 = tr_read<v_rd_off(D0, 1, 0)>(vb), h1 = tr_read<v_rd_off(D0, 1, 1)>(vb);
    const s16x4 l2 = tr_read<v_rd_off(D0, 2, 0)>(vb), h2 = tr_read<v_rd_off(D0, 2, 1)>(vb), l3 = tr_read<v_rd_off(D0, 3, 0)>(vb), h3 = tr_read<v_rd_off(D0, 3, 1)>(vb);
    asm volatile("s_waitcnt lgkmcnt(0)" ::: "memory"); SBAR();
#define PKV(L, H) (bf16x8){L[0], L[1], L[2], L[3], H[0], H[1], H[2], H[3]}
    od = __builtin_amdgcn_mfma_f32_32x32x16_bf16(pa0, PKV(l0, h0), od, 0, 0, 0);
    od = __builtin_amdgcn_mfma_f32_32x32x16_bf16(pa1, PKV(l1, h1), od, 0, 0, 0);
    od = __builtin_amdgcn_mfma_f32_32x32x16_bf16(pa2, PKV(l2, h2), od, 0, 0, 0);
    od = __builtin_amdgcn_mfma_f32_32x32x16_bf16(pa3, PKV(l3, h3), od, 0, 0, 0);
#undef PKV
}
#if PV_PIPE
__device__ __forceinline__ void pv_d0(f32x16* o, int vb, bf16x8 pa0, bf16x8 pa1, bf16x8 pa2, bf16x8 pa3) {
#define TRSET(D0, N) const s16x4 N##0 = tr_read<v_rd_off(D0, 0, 0)>(vb), N##1 = tr_read<v_rd_off(D0, 0, 1)>(vb), N##2 = tr_read<v_rd_off(D0, 1, 0)>(vb), N##3 = tr_read<v_rd_off(D0, 1, 1)>(vb), \
                                   N##4 = tr_read<v_rd_off(D0, 2, 0)>(vb), N##5 = tr_read<v_rd_off(D0, 2, 1)>(vb), N##6 = tr_read<v_rd_off(D0, 3, 0)>(vb), N##7 = tr_read<v_rd_off(D0, 3, 1)>(vb)
#define PKV(L, H) (bf16x8){L[0], L[1], L[2], L[3], H[0], H[1], H[2], H[3]}
#define PVM(OD, N) do { OD = __builtin_amdgcn_mfma_f32_32x32x16_bf16(pa0, PKV(N##0, N##1), OD, 0, 0, 0); OD = __builtin_amdgcn_mfma_f32_32x32x16_bf16(pa1, PKV(N##2, N##3), OD, 0, 0, 0); \
                        OD = __builtin_amdgcn_mfma_f32_32x32x16_bf16(pa2, PKV(N##4, N##5), OD, 0, 0, 0); OD = __builtin_amdgcn_mfma_f32_32x32x16_bf16(pa3, PKV(N##6, N##7), OD, 0, 0, 0); } while (0)
    TRSET(0, a); TRSET(1, b);
    asm volatile("s_waitcnt lgkmcnt(8)" ::: "memory"); SBAR(); PVM(o[0], a);
    TRSET(2, c);
    asm volatile("s_waitcnt lgkmcnt(8)" ::: "memory"); SBAR(); PVM(o[1], b);
    TRSET(3, d);
    asm volatile("s_waitcnt lgkmcnt(8)" ::: "memory"); SBAR(); PVM(o[2], c);
    asm volatile("s_waitcnt lgkmcnt(0)" ::: "memory"); SBAR(); PVM(o[3], d);
#undef TRSET
#undef PKV
#undef PVM
}
#else
__device__ __forceinline__ void pv_d0(f32x16* o, int vb, bf16x8 pa0, bf16x8 pa1, bf16x8 pa2, bf16x8 pa3) {
    pv_one<0>(o[0], vb, pa0, pa1, pa2, pa3); pv_one<1>(o[1], vb, pa0, pa1, pa2, pa3); pv_one<2>(o[2], vb, pa0, pa1, pa2, pa3); pv_one<3>(o[3], vb, pa0, pa1, pa2, pa3);
}
#endif
#define AT_WAITBAR(N) asm volatile("s_waitcnt vmcnt(" #N ") lgkmcnt(0)\n\ts_barrier" ::: "memory")
#define AT_WAITBAR_N(N) AT_WAITBAR(N)

__device__ __forceinline__ void attn_unit(const Ctx& C, int b, int h, int qb) {
    const bf16_t* Qb = WSP(bf16_t, WS_Q); float* ya = WSP(float, WS_YATT);
    const int lane = C.lane, wid = C.wave, r32 = lane & 31, hi = lane >> 5;
    const int rowbase = b * SEQ, q0 = qb * 256;
    const unsigned lds0 = (unsigned)(uintptr_t)C.lds;
    LAS float* wsf = (LAS float*)(C.lds + AT_WS) + wid * 64; LAS float* li_l = wsf; LAS float* al_l = wsf + 32;
    const unsigned char* kimg = uniform_ptr(C.ws + WS_KIMG + ((size_t)rowbase * 768 + h * 192) * (ATT_QK8 ? 1 : 2));
#if ATT_PV8
    const unsigned char* vimg = uniform_ptr(C.ws + WS_VIMG + ((size_t)(rowbase / 64) * 4 + h) * 8192);
#else
    const unsigned char* vimg = uniform_ptr(C.ws + WS_VIMG + ((size_t)rowbase * 512 + h * 128) * 2);
#endif
#if ATT_QK8
    unsigned kvoff[2];
#pragma unroll
    for (int i = 0; i < 2; ++i) { const int q = 64 * (wid + 8 * i) + lane, row = q / 12, cp = q % 12, c = (cp & ~3) | ((cp & 3) ^ ((row >> 2) & 3)); kvoff[i] = (unsigned)(row * 768 + c * 16); }
#else
    unsigned kvoff[3];
#pragma unroll
    for (int i = 0; i < 3; ++i) { const int q = 64 * (wid + 8 * i) + lane, row = q / 24, cp = q % 24, c = (cp & ~7) | ((cp & 7) ^ ((row >> 1) & 7)); kvoff[i] = (unsigned)(row * 1536 + c * 16); }
#endif
#if ATT_PV8
    unsigned vvoff[1];
    { const int q = 64 * wid + lane, row = q >> 2, cp = q & 3; vvoff[0] = (unsigned)(row * 64 + ((cp ^ ((row >> 2) & 3)) * 16)); }
#else
    unsigned vvoff[2];
#pragma unroll
    for (int j = 0; j < 2; ++j) { const int P = wid + 8 * j, sub = 2 * P + (lane >> 5), kk = (sub >> 2) * 8 + ((lane & 31) >> 2), k = (kk & ~0xC) | ((kk & 4) << 1) | ((kk & 8) >> 1), col = (sub & 3) * 32 + (lane & 3) * 8;
        vvoff[j] = (unsigned)(k * 1024 + col * 2); }
#endif
    const unsigned kdst = lds0 + AT_K + wid * 1024, vdst = lds0 + AT_V + wid * 1024;
#if ATT_PV8
#define AT_DMA(t, slot) do { const unsigned char* ks_ = kimg + (size_t)(t) * (64 * 768); const unsigned char* vs_ = vimg + (size_t)(t) * 32768; \
        const unsigned kd_ = (unsigned)__builtin_amdgcn_readfirstlane(kdst + (slot) * AT_KB), vd_ = (unsigned)__builtin_amdgcn_readfirstlane(vdst + (slot) * AT_VB); \
        glds16(vs_, vvoff[0], vd_); glds16(ks_, kvoff[0], kd_); if (wid < 4) glds16(ks_, kvoff[1], kd_ + 8192); } while (0)
#define AT_NDMA 2
#elif ATT_QK8
#define AT_DMA(t, slot) do { const unsigned char* ks_ = kimg + (size_t)(t) * (64 * 768); const unsigned char* vs_ = vimg + (size_t)(t) * (64 * 1024); \
        const unsigned kd_ = (unsigned)__builtin_amdgcn_readfirstlane(kdst + (slot) * AT_KB), vd_ = (unsigned)__builtin_amdgcn_readfirstlane(vdst + (slot) * AT_VB); \
        glds16(vs_, vvoff[0], vd_); glds16(vs_, vvoff[1], vd_ + 8192); glds16(ks_, kvoff[0], kd_); if (wid < 4) glds16(ks_, kvoff[1], kd_ + 8192); } while (0)
#define AT_NDMA 3
#else
#define AT_DMA(t, slot) do { const unsigned char* ks_ = kimg + (size_t)(t) * (64 * 1536); const unsigned char* vs_ = vimg + (size_t)(t) * (64 * 1024); \
        const unsigned kd_ = (unsigned)__builtin_amdgcn_readfirstlane(kdst + (slot) * AT_KB), vd_ = (unsigned)__builtin_amdgcn_readfirstlane(vdst + (slot) * AT_VB); \
        glds16(ks_, kvoff[0], kd_); glds16(ks_, kvoff[1], kd_ + 8192); glds16(ks_, kvoff[2], kd_ + 16384); glds16(vs_, vvoff[0], vd_); glds16(vs_, vvoff[1], vd_ + 8192); } while (0)
#define AT_NDMA 5
#endif
    const int NT = 4 * qb + 4, jlim = 4 * qb + (wid >> 1);
#if ATT_QK8
    at_v8i qf[3];
    { const unsigned char* Qw = (const unsigned char*)Qb + (size_t)(rowbase + q0 + wid * 32 + r32) * 768 + h * 192 + hi * 32;
#pragma unroll
      for (int s = 0; s < 3; ++s) qf[s] = at_cat8(*(const u32x4*)(Qw + 64 * s), *(const u32x4*)(Qw + 64 * s + 16)); }
    const int kb0 = r32 * 192 + 16 * ((2 * hi) ^ ((r32 >> 2) & 3)), kb1 = kb0 ^ 16;
#define AT_QKT(C0, C1, KS) at_qkt8(C0, C1, KS, kb0, kb1, qf)
#else
    bf16x8 qr[12];
    { const bf16_t* Qw = Qb + (size_t)(rowbase + q0 + wid * 32 + r32) * 768 + h * 192 + hi * 8;
#pragma unroll
      for (int d0 = 0; d0 < 12; ++d0) qr[d0] = *(const bf16x8*)(Qw + d0 * 16); }
#define AT_QKT(C0, C1, KS) at_qkt(C0, C1, KS, kro, qr)
#endif
    AT_DMA(0, 0); AT_DMA(1, 1);
    const LAS char* kp0 = (const LAS char*)C.lds + AT_K;
#if !ATT_QK8
    int kro[4];
#pragma unroll
    for (int j = 0; j < 4; ++j) kro[j] = r32 * 384 + 16 * ((2 * j + hi) ^ ((r32 >> 1) & 7));
#endif
    float m_reg = -1e30f, l_reg = 0.f; f32x16 o[4] = {};
    f32x16 pA0, pA1, pB0, pB1; float mnA, mnB, alA, alB;
#if ATT_PV8
    const LAS char* vp0 = (const LAS char*)C.lds + AT_V; const int vk0 = r32 * 64 + 16 * ((2 * hi) ^ ((r32 >> 2) & 3)), vk1 = vk0 ^ 16;
    at_v8i PA;
#define AT_FIN(P0, P1, ALP) at_finishSM8(P0, P1, ALP, l_reg, PA)
#define AT_PV(SLOT) pv8(o, vp0 + (SLOT) * AT_VB, vk0, vk1, PA)
#else
    const int vb0 = (int)(lds0 + AT_V) + v_rd_base(lane);
    bf16x8 pa0, pa1, pa2, pa3;
#define AT_FIN(P0, P1, ALP) at_finishSM(P0, P1, ALP, l_reg, pa0, pa1, pa2, pa3)
#define AT_PV(SLOT) pv_d0(o, vb0 + (SLOT) * AT_VB, pa0, pa1, pa2, pa3)
#endif
#define AT_RESC(a) do { if (__any((a) < 1.f)) { if (hi == 0) al_l[r32] = (a); asm volatile("s_waitcnt lgkmcnt(0)" ::: "memory"); \
        _Pragma("unroll") for (int d = 0; d < 4; ++d) _Pragma("unroll") for (int r = 0; r < 16; ++r) o[d][r] *= al_l[crow(r, hi)]; } } while (0)
#define AT_MASKED(P0, P1) do { _Pragma("unroll") for (int r = 0; r < 16; ++r) { P0[r] = -1e30f; P1[r] = -1e30f; } } while (0)
#define AT_STEP(C0, C1, MNC, ALC, P0, P1, ALP, j) do { const int sj_ = (j) % 3, sp_ = ((j) + 2) % 3; \
        SBAR(); if ((j) <= jlim) AT_QKT(C0, C1, kp0 + sj_ * AT_KB); else AT_MASKED(C0, C1); \
        AT_FIN(P0, P1, ALP); SBAR(); \
        if ((j) - 1 <= jlim) AT_PV(sp_); \
        at_partialSM(C0, C1, m_reg, MNC, ALC); \
        AT_WAITBAR(0); \
        if ((j) + 2 < NT) AT_DMA((j) + 2, sp_); \
        AT_RESC(ALC); } while (0)
    AT_WAITBAR_N(AT_NDMA);
    AT_QKT(pA0, pA1, kp0); at_partialSM(pA0, pA1, m_reg, mnA, alA);
    AT_DMA(2, 2);
    AT_WAITBAR_N(AT_NDMA);
    AT_RESC(alA);
    for (int j = 1; j + 1 < NT; j += 2) {
        AT_STEP(pB0, pB1, mnB, alB, pA0, pA1, alA, j);
        AT_STEP(pA0, pA1, mnA, alA, pB0, pB1, alB, j + 1);
    }
    AT_STEP(pB0, pB1, mnB, alB, pA0, pA1, alA, NT - 1);
    AT_FIN(pB0, pB1, alB); SBAR();
    if (NT - 1 <= jlim) AT_PV((NT - 1) % 3);
    if (hi == 0) li_l[r32] = l_reg;
    asm volatile("s_waitcnt lgkmcnt(0)" ::: "memory");
    float rli[16];
#pragma unroll
    for (int r = 0; r < 16; ++r) rli[r] = __builtin_amdgcn_rcpf(li_l[crow(r, hi)]);
    float* Ow = ya + (size_t)(rowbase + q0 + wid * 32) * 512 + h * 128;
#pragma unroll
    for (int r = 0; r < 16; ++r) { const int orow = crow(r, hi);
#pragma unroll
        for (int d0 = 0; d0 < 4; ++d0) Ow[(size_t)orow * 512 + d0 * 32 + r32] = o[d0][r] * rli[r]; }
    AT_WAITBAR(0);
#undef AT_FIN
#undef AT_PV
#undef AT_DMA
#undef AT_NDMA
#undef AT_QKT
#undef AT_RESC
#undef AT_MASKED
#undef AT_STEP
}
__device__ __forceinline__ void ph_attn(const Ctx& C, int l) {
    const int vcu = (C.G % 8 == 0) ? (C.bid % 8) * (C.G / 8) + C.bid / 8 : C.bid;
    for (int p = vcu; p < 256; p += C.G) { const int bh = p >> 3, s = p & 7;
        for (int u = 0; u < 2; ++u) attn_unit(C, bh >> 2, bh & 3, u ? s : 15 - s); }
}
__device__ __forceinline__ void ph_mixnorm(const Ctx& C, int l) {
    const bf16_t* ymix = WSP(bf16_t, WS_YMIX); const float* ya = WSP(float, WS_YATT); bf16_t* mix = WSP(bf16_t, WS_MIX);
    const int lane = C.lane, stride = C.G * NWAVE; int t = C.bid * NWAVE + C.wave;
    if (t >= T) return;
    u32x2 pn = *(const u32x2*)(ymix + (size_t)t * 512 + 4 * lane), qn = *(const u32x2*)(ymix + (size_t)t * 512 + 256 + 4 * lane);
    f32x4 a0n = *(const f32x4*)(ya + (size_t)t * 512 + 8 * lane), a1n = *(const f32x4*)(ya + (size_t)t * 512 + 8 * lane + 4);
    u32x2 pn2 = pn, qn2 = qn; f32x4 a0n2 = a0n, a1n2 = a1n;
    if (t + stride < T) { const int tn = t + stride;
        pn2 = *(const u32x2*)(ymix + (size_t)tn * 512 + 4 * lane); qn2 = *(const u32x2*)(ymix + (size_t)tn * 512 + 256 + 4 * lane);
        a0n2 = *(const f32x4*)(ya + (size_t)tn * 512 + 8 * lane); a1n2 = *(const f32x4*)(ya + (size_t)tn * 512 + 8 * lane + 4); }
    for (; t < T; t += stride) {
        const u32x2 p = pn, q = qn; const f32x4 a0 = a0n, a1 = a1n;
        pn = pn2; qn = qn2; a0n = a0n2; a1n = a1n2;
        if (t + 2 * stride < T) { const int tn = t + 2 * stride;
            pn2 = *(const u32x2*)(ymix + (size_t)tn * 512 + 4 * lane); qn2 = *(const u32x2*)(ymix + (size_t)tn * 512 + 256 + 4 * lane);
            a0n2 = *(const f32x4*)(ya + (size_t)tn * 512 + 8 * lane); a1n2 = *(const f32x4*)(ya + (size_t)tn * 512 + 8 * lane + 4); }
        const float p0 = bflo(p.x), p1 = bfhi(p.x), p2 = bflo(p.y), p3 = bfhi(p.y), q0 = bflo(q.x), q1 = bfhi(q.x), q2 = bflo(q.y), q3 = bfhi(q.y);
        const float rp = rsqrtf(wave_sum((p0 * p0 + p1 * p1) + (p2 * p2 + p3 * p3)) * (1.f / 256.f) + EPS);
        const float rq = rsqrtf(wave_sum((q0 * q0 + q1 * q1) + (q2 * q2 + q3 * q3)) * (1.f / 256.f) + EPS);
        const float ra = rsqrtf(wave_sum((a0.x * a0.x + a0.y * a0.y) + (a0.z * a0.z + a0.w * a0.w) + (a1.x * a1.x + a1.y * a1.y) + (a1.z * a1.z + a1.w * a1.w)) * (1.f / 512.f) + EPS);
#if OUTPROJ_FP8
        unsigned char* mr8 = C.ws + WS_MIX + (size_t)t * 1024;
        *(unsigned*)(mr8 + 4 * lane) = pk4_fp8(p0 * rp, p1 * rp, p2 * rp, p3 * rp);
        *(unsigned*)(mr8 + 256 + 4 * lane) = pk4_fp8(q0 * rq, q1 * rq, q2 * rq, q3 * rq);
        *(u32x2*)(mr8 + 512 + 8 * lane) = (u32x2){pk4_fp8(a0.x * ra, a0.y * ra, a0.z * ra, a0.w * ra), pk4_fp8(a1.x * ra, a1.y * ra, a1.z * ra, a1.w * ra)};
#else
        bf16_t* mr = mix + (size_t)t * 1024;
        *(u32x2*)(mr + 4 * lane) = (u32x2){pk2(p0 * rp, p1 * rp), pk2(p2 * rp, p3 * rp)};
        *(u32x2*)(mr + 256 + 4 * lane) = (u32x2){pk2(q0 * rq, q1 * rq), pk2(q2 * rq, q3 * rq)};
        *(u32x4*)(mr + 512 + 8 * lane) = (u32x4){pk2(a0.x * ra, a0.y * ra), pk2(a0.z * ra, a0.w * ra), pk2(a1.x * ra, a1.y * ra), pk2(a1.z * ra, a1.w * ra)};
#endif
    }
}
__device__ __forceinline__ void ph_outproj(const Ctx& C, int l) {
    const bf16_t* mix = WSP(bf16_t, WS_MIX); const bf16_t* W = WSP(bf16_t, WS_WO) + (size_t)l * 1024 * 1024;
    const float* xin = (l == 0) ? C.x : C.out; float* xo = C.out;
    for (int u = C.bid; u < 256 * 8; u += C.G) { const int rt = u / 8, ct = u % 8;
        sg_tile<1>(C, [&](int r) { return mix + (size_t)(rt * 128 + r) * 1024; }, W + (size_t)ct * 128 * 1024, nullptr, 1024,
                   [&](int r, int c, float v, float) { const size_t o = (size_t)(rt * 128 + r) * 1024 + ct * 128 + c; xo[o] = xin[o] + v; });
    }
}
typedef float f32x16_r __attribute__((ext_vector_type(16)));
__device__ __forceinline__ void ph_route(const Ctx& C, int l, int dummy = 0) {
    const bf16_t* x = WSP(bf16_t, WS_XB); const bf16_t* Wh = WSP(bf16_t, WS_WR) + (size_t)(l * 2) * 32 * 1024; const bf16_t* Wl = Wh + 32 * 1024;
    int* ltok = dummy ? WSP(int, WS_YB) : WSP(int, WS_LTOK); float* lgate = dummy ? WSP(float, WS_YB + 8 * MiB) : WSP(float, WS_LGATE); unsigned* asg = dummy ? WSP(unsigned, WS_YB + 16 * MiB) : WSP(unsigned, WS_ASG);
    unsigned* gcnt = WSP(unsigned, WS_CTL) + CW_GCNT + l * NEXP * 64 + (dummy ? 8192 : 0);
    constexpr int XROW = 2064;
    LAS unsigned char* xt = C.lds;
    LAS float* red = (LAS float*)(C.lds + 66048);
    LAS float* lg = (LAS float*)(C.lds + 98816);
    LAS float* rsv = (LAS float*)(C.lds + 102912);
    LAS float* tmpv = (LAS float*)(C.lds + 103040) + C.wave * 4;
    LAS int* sel_e = (LAS int*)(C.lds + 103424);
    LAS float* sel_g = (LAS float*)(C.lds + 105472);
    LAS int* ctl = (LAS int*)(C.lds + LDS_CTL);
    const int lane = C.lane, w = C.wave, tid = C.tid, r32 = lane & 31, hi = lane >> 5;
    bf16x8 ah[8], al[8];
#pragma unroll
    for (int ks = 0; ks < 8; ++ks) { ah[ks] = *(const bf16x8*)(Wh + (size_t)r32 * 1024 + 128 * w + 16 * ks + 8 * hi); al[ks] = *(const bf16x8*)(Wl + (size_t)r32 * 1024 + 128 * w + 16 * ks + 8 * hi); }
    const float* bias = WSP(float, WS_PAR) + P_BR + l * 32;
    for (int chunk = C.bid; chunk < T / 128; chunk += C.G) {
        const int tok0 = chunk * 128;
        if (tid < 32) ctl[96 + tid] = 0;
        u32x4 q[4][2];
#pragma unroll
        for (int i = 0; i < 4; ++i) { const u32x4* xr = (const u32x4*)(x + (size_t)(tok0 + 4 * w + i) * DM + 16 * lane); q[i][0] = xr[0]; q[i][1] = xr[1]; }
        for (int tile = 0; tile < 4; ++tile) {
#pragma unroll
            for (int i = 0; i < 4; ++i) { const int t = tok0 + 32 * tile + 4 * w + i; const u32x4 a = q[i][0], b = q[i][1];
                float v[16] = {bflo(a.x), bfhi(a.x), bflo(a.y), bfhi(a.y), bflo(a.z), bfhi(a.z), bflo(a.w), bfhi(a.w), bflo(b.x), bfhi(b.x), bflo(b.y), bfhi(b.y), bflo(b.z), bfhi(b.z), bflo(b.w), bfhi(b.w)};
                float ss = 0.f;
#pragma unroll
                for (int j = 0; j < 16; ++j) ss += v[j] * v[j];
                const float rs = rsqrtf(wave_sum(ss) * (1.f / DM) + EPS);
                *(u32x4*)(C.ws + WS_HB8 + (size_t)t * 1024 + 16 * lane) = (u32x4){pk4_fp8(v[0] * rs, v[1] * rs, v[2] * rs, v[3] * rs), pk4_fp8(v[4] * rs, v[5] * rs, v[6] * rs, v[7] * rs),
                                                                                 pk4_fp8(v[8] * rs, v[9] * rs, v[10] * rs, v[11] * rs), pk4_fp8(v[12] * rs, v[13] * rs, v[14] * rs, v[15] * rs)};
                LAS u32x4* dst = (LAS u32x4*)(xt + (4 * w + i) * XROW + 32 * lane); dst[0] = a; dst[1] = b;
                if (lane == 0) rsv[4 * w + i] = rs; }
            if (tile < 3) {
#pragma unroll
                for (int i = 0; i < 4; ++i) { const u32x4* xr = (const u32x4*)(x + (size_t)(tok0 + 32 * (tile + 1) + 4 * w + i) * DM + 16 * lane); q[i][0] = xr[0]; q[i][1] = xr[1]; } }
            __syncthreads();
            { f32x16_r d = {};
#pragma unroll
              for (int ks = 0; ks < 8; ++ks) { const bf16x8 bx = *(const LAS bf16x8*)(xt + r32 * XROW + (128 * w + 16 * ks + 8 * hi) * 2);
                  d = __builtin_amdgcn_mfma_f32_32x32x16_bf16(ah[ks], bx, d, 0, 0, 0); d = __builtin_amdgcn_mfma_f32_32x32x16_bf16(al[ks], bx, d, 0, 0, 0); }
#pragma unroll
              for (int r = 0; r < 16; ++r) red[(w * 16 + r) * 64 + lane] = d[r]; }
            __syncthreads();
            { const int tk = tid & 31, hi_ = (tid >> 5) & 1, r0 = tid >> 6; const float rs = rsv[tk];
#pragma unroll
              for (int rr = 0; rr < 2; ++rr) { const int r = r0 + 8 * rr; float sm = 0.f;
#pragma unroll
                  for (int ww = 0; ww < 8; ++ww) sm += red[(ww * 16 + r) * 64 + tk + 32 * hi_];
                  const int e = (r & 3) + 8 * (r >> 2) + 4 * hi_; lg[tk * 32 + e] = sm * rs + bias[e]; } }
            __syncthreads();
#pragma unroll
            for (int i = 0; i < 4; ++i) { const int tk = 4 * w + i, e = lane & 31; const float mine = lg[tk * 32 + e]; int rank = 0;
#pragma unroll
                for (int c4 = 0; c4 < 8; ++c4) { const f32x4 qv = *(const LAS f32x4*)(lg + tk * 32 + 4 * c4);
                    rank += (qv.x > mine || (qv.x == mine && 4 * c4 + 0 < e)) ? 1 : 0; rank += (qv.y > mine || (qv.y == mine && 4 * c4 + 1 < e)) ? 1 : 0;
                    rank += (qv.z > mine || (qv.z == mine && 4 * c4 + 2 < e)) ? 1 : 0; rank += (qv.w > mine || (qv.w == mine && 4 * c4 + 3 < e)) ? 1 : 0; }
                if (lane < 32 && rank < 4) tmpv[rank] = mine;
                asm volatile("s_waitcnt lgkmcnt(0)" ::: "memory");
                const f32x4 tv = *(const LAS f32x4*)tmpv;
                const float inv = 1.f / (1.f + __expf(tv.y - tv.x) + __expf(tv.z - tv.x) + __expf(tv.w - tv.x));
                if (lane < 32 && rank < 4) { const int tl = 32 * tile + tk; sel_e[tl * 4 + rank] = e; sel_g[tl * 4 + rank] = __expf(mine - tv.x) * inv; }
                asm volatile("s_waitcnt lgkmcnt(0)" ::: "memory"); }
        }
        __syncthreads();
        const int e = sel_e[tid]; const float gt = sel_g[tid];
        const int rank = __hip_atomic_fetch_add(&ctl[96 + e], 1, __ATOMIC_RELAXED, __HIP_MEMORY_SCOPE_WORKGROUP);
        __syncthreads();
        if (tid < 32) ctl[128 + tid] = (int)__hip_atomic_fetch_add(gcnt + tid * 64, (unsigned)ctl[96 + tid], __ATOMIC_RELAXED, __HIP_MEMORY_SCOPE_AGENT);
        __syncthreads();
        const int slot = ctl[128 + e] + rank, tok = tok0 + (tid >> 2);
        ltok[(size_t)e * T + slot] = tok; lgate[(size_t)tok * 4 + (tid & 3)] = gt; asg[(size_t)tok * 4 + (tid & 3)] = ((unsigned)e << 24) | (unsigned)slot;
        __syncthreads();
    }
}
__device__ __forceinline__ void ph_gateup(const Ctx& C, int l) {
    moe_tables(C, l);
    LAS int* ctl = (LAS int*)(C.lds + LDS_CTL);
    const bf16_t* hb = WSP(bf16_t, WS_HB); const int* ltok = WSP(int, WS_LTOK); bf16_t* act = WSP(bf16_t, WS_ACT);
    const int nrt = ctl[32 + NEXP];
    for (int u = C.bid; u < nrt * 2 * 8; u += C.G) { const int rt128 = u >> 3, pn = u & 7, rt = rt128 >> 1, sub = rt128 & 1;
        const int e = moe_find_expert(C, rt), cnt = ctl[e], lrow0 = (rt - ctl[32 + e]) * 256 + sub * 128;
        const bf16_t* W = WSP(bf16_t, WS_WGU) + ((size_t)(l * NEXP + e) * 2048 + pn * 256) * 1024;
        const float* bg = WSP(float, WS_PAR) + P_BGU + (size_t)(l * NEXP + e) * 2048;
        const size_t arow0 = (size_t)rt * 256 + sub * 128;
        sg_tile<2>(C, [&](int r) { const int li = lrow0 + r; const int tok = (li < cnt) ? ltok[(size_t)e * T + li] : 0; return hb + (size_t)tok * 1024; }, W, W + (size_t)128 * 1024, 1024,
                   [&](int r, int c, float vg, float vl) { const int j = pn * 128 + c; vg += bg[2 * j]; vl += bg[2 * j + 1];
                       const float xg = fminf(vg, 7.f), xl = fminf(fmaxf(vl, -7.f), 7.f);
                       act[(arow0 + r) * 1024 + j] = (bf16_t)f2bf(xg * sigmoidf_(1.702f * xg) * (xl + 1.f)); });
    }
}
__device__ __forceinline__ void ph_down(const Ctx& C, int l) {
    moe_tables(C, l);
    LAS int* ctl = (LAS int*)(C.lds + LDS_CTL);
    const bf16_t* act = WSP(bf16_t, WS_ACT); const float* lgate = WSP(float, WS_LGATE); bf16_t* yb = WSP(bf16_t, WS_YB);
    const int nrt = ctl[32 + NEXP];
    for (int u = C.bid; u < nrt * 2 * 8; u += C.G) { const int rt128 = u >> 3, ct = u & 7, rt = rt128 >> 1, sub = rt128 & 1;
        const int e = moe_find_expert(C, rt), cnt = ctl[e], lrow0 = (rt - ctl[32 + e]) * 256 + sub * 128;
        const bf16_t* W = WSP(bf16_t, WS_WD) + ((size_t)(l * NEXP + e) * 1024 + ct * 128) * 1024;
        const float* bd = WSP(float, WS_PAR) + P_BDN + (size_t)(l * NEXP + e) * 1024;
        const size_t arow0 = (size_t)rt * 256 + sub * 128;
        sg_tile<1>(C, [&](int r) { return act + (arow0 + r) * 1024; }, W, nullptr, 1024,
                   [&](int r, int c, float v, float) { const int li = lrow0 + r; const float g = (li < cnt) ? lgate[(size_t)e * T + li] : 0.f;
                       yb[(arow0 + r) * 1024 + ct * 128 + c] = (bf16_t)f2bf((v + bd[ct * 128 + c]) * g); });
    }
}
static_assert(MOE_FP8 == 1, "the combine phase reads the expert outputs as fp8 x16 (the MOE_FP8 path)");
struct CmbIn { u32x4 x0, x1; u32x4 y[4]; f32x4 g; };
__device__ __forceinline__ CmbIn cmb_load(const Ctx& C, int t, u32x4 a4, int lane) {
    LAS int* ctl = (LAS int*)(C.lds + LDS_CTL); CmbIn r;
    const u32x4* xr = (const u32x4*)(WSP(bf16_t, WS_XB) + (size_t)t * DM + 16 * lane); r.x0 = xr[0]; r.x1 = xr[1]; r.g = *(const f32x4*)(WSP(float, WS_LGATE) + (size_t)t * 4);
#pragma unroll
    for (int k = 0; k < 4; ++k) { const unsigned a = a4[k]; const int e = a >> 24, slot = a & 0xffffff; const size_t row = (size_t)ctl[32 + e] * 256 + slot;
        r.y[k] = *(const u32x4*)(C.ws + WS_YB + row * 1024 + 16 * lane); }
    return r;
}
__device__ __forceinline__ void ph_combine(const Ctx& C, int l, float ysc = 1.f) {
    moe_tables(C, l);
    const unsigned* asg = WSP(unsigned, WS_ASG); bf16_t* xb = WSP(bf16_t, WS_XB);
    const int lane = C.lane; const bool last_layer = (l == NLAYER - 1) && ysc == 1.f;
    const int stride = C.G * NWAVE; int t = C.bid * NWAVE + C.wave;
    if (t >= T) return;
    u32x4 a_nx = *(const u32x4*)(asg + (size_t)t * 4);
    CmbIn nx = cmb_load(C, t, a_nx, lane), nx2 = nx;
    if (t + stride < T) { a_nx = *(const u32x4*)(asg + (size_t)(t + stride) * 4); nx2 = cmb_load(C, t + stride, a_nx, lane); }
    if (t + 2 * stride < T) a_nx = *(const u32x4*)(asg + (size_t)(t + 2 * stride) * 4);
    for (; t < T; t += stride) {
        const CmbIn in = nx; nx = nx2;
        if (t + 2 * stride < T) { nx2 = cmb_load(C, t + 2 * stride, a_nx, lane); if (t + 3 * stride < T) a_nx = *(const u32x4*)(asg + (size_t)(t + 3 * stride) * 4); }
        f32x4 v[4];
        v[0] = (f32x4){bflo(in.x0.x), bfhi(in.x0.x), bflo(in.x0.y), bfhi(in.x0.y)}; v[1] = (f32x4){bflo(in.x0.z), bfhi(in.x0.z), bflo(in.x0.w), bfhi(in.x0.w)};
        v[2] = (f32x4){bflo(in.x1.x), bfhi(in.x1.x), bflo(in.x1.y), bfhi(in.x1.y)}; v[3] = (f32x4){bflo(in.x1.z), bfhi(in.x1.z), bflo(in.x1.w), bfhi(in.x1.w)};
#pragma unroll
        for (int k = 0; k < 4; ++k) { const float sc = ysc * (1.f / g8::YB_SCALE) * in.g[k];
#pragma unroll
            for (int j = 0; j < 4; ++j) { const f32x2 lo = __builtin_amdgcn_cvt_pk_f32_fp8((int)in.y[k][j], false), hi = __builtin_amdgcn_cvt_pk_f32_fp8((int)in.y[k][j], true);
                v[j].x += sc * lo.x; v[j].y += sc * lo.y; v[j].z += sc * hi.x; v[j].w += sc * hi.y; } }
        if (last_layer) { f32x4* o = (f32x4*)(C.out + (size_t)t * DM + 16 * lane);
#pragma unroll
            for (int j = 0; j < 4; ++j) o[j] = v[j];
            continue; }
        float s = 0.f;
#pragma unroll
        for (int j = 0; j < 4; ++j) s += (v[j].x * v[j].x + v[j].y * v[j].y) + (v[j].z * v[j].z + v[j].w * v[j].w);
        u32x4* xr = (u32x4*)(xb + (size_t)t * DM + 16 * lane);
        xr[0] = (u32x4){pk2(v[0].x, v[0].y), pk2(v[0].z, v[0].w), pk2(v[1].x, v[1].y), pk2(v[1].z, v[1].w)};
        xr[1] = (u32x4){pk2(v[2].x, v[2].y), pk2(v[2].z, v[2].w), pk2(v[3].x, v[3].y), pk2(v[3].z, v[3].w)};
        const float rs = rsqrtf(wave_sum(s) * (1.f / DM) + EPS);
        if (lane == 0) WSP(float, WS_RS)[t] = rs;
    }
}

#ifndef FAST_INPROJ
#define FAST_INPROJ 1
#endif
#ifndef FAST_SMALL
#define FAST_SMALL 1
#endif
#ifndef FAST_OUTPROJ
#define FAST_OUTPROJ 1
#endif
#ifndef FAST_GATEUP
#define FAST_GATEUP 1
#endif
#ifndef FAST_DOWN
#define FAST_DOWN 1
#endif
#ifndef G8_SP2
#define G8_SP2 true
#endif
#ifndef G8_ALIGN
#define G8_ALIGN true
#endif
__device__ __forceinline__ void ph_inproj_f(const Ctx& C, int l) {
    const g8::DenseSched S{C.ws + WS_XB, C.ws + WS_WIN + (size_t)l * DINP * 1024 * 2, 1024, 1024, T / 256, DINP / 256, C.G, C.bid, 2};
    const g8::EpiBf16Rs E{WSP(bf16_t, WS_Z), DINP, WSP(float, WS_RS)};
    g8::gemm_phase<g8::EpiBf16Rs, g8::DenseSched, G8_ALIGN, G8_SP2>(C.lds, 1024, S, E);
}
__device__ __forceinline__ void ph_mixgemm_f(const Ctx& C, int l) {
    const g8::DenseSched S{C.ws + WS_A2, C.ws + WS_WMIX + (size_t)l * 512 * 512 * 2, 512, 512, T / 256, 2, C.G, C.bid, 2};
    const g8::EpiBf16 E{WSP(bf16_t, WS_YMIX), 512, WSP(float, WS_PAR) + P_MIXB + l * 512};
    g8::gemm_phase<g8::EpiBf16, g8::DenseSched, G8_ALIGN, G8_SP2>(C.lds, 512, S, E);
}
__device__ __forceinline__ void ph_qkvgemm_f(const Ctx& C, int l) {
    { const g8::DenseSched S{C.ws + WS_Z + 768 * 2, C.ws + WS_WQ + (size_t)l * 768 * 256 * 2, DINP, 256, T / 256, 3, C.G, C.bid, 2};
      const g8::EpiBf16 E{WSP(bf16_t, WS_QRAW), 768, nullptr};
      g8::gemm_phase<g8::EpiBf16, g8::DenseSched, G8_ALIGN, G8_SP2>(C.lds, 256, S, E); }
    { const g8::DenseSched S{C.ws + WS_Z + 1024 * 2, C.ws + WS_WKV + (size_t)l * 1024 * 256 * 2, DINP, 256, T / 256, 4, C.G, C.bid, 2};
      const g8::EpiBf16 E{WSP(bf16_t, WS_KVRAW), 1024, nullptr};
      g8::gemm_phase<g8::EpiBf16, g8::DenseSched, G8_ALIGN, G8_SP2>(C.lds, 256, S, E); }
}
__device__ __forceinline__ void ph_smallgemm_f(const Ctx& C, int l) { ph_mixgemm_f(C, l); ph_qkvgemm_f(C, l); }
__device__ __forceinline__ void ph_outproj_f(const Ctx& C, int l) {
#if OUTPROJ_FP8
    const g8::DenseSched S{C.ws + WS_MIX, C.ws + WS_WO + (size_t)l * 1024 * 1024, 1024, 1024, T / 256, 4, C.G, C.bid, 1};
    const g8::EpiResF32 E{(l == 0) ? C.x : C.out, C.out, 1024, 1.f / 32.f};
    g8::gemm_phase<g8::EpiResF32, g8::DenseSched, G8_ALIGN, G8_SP2, true>(C.lds, 1024, S, E);
#else
    const g8::DenseSched S{C.ws + WS_MIX, C.ws + WS_WO + (size_t)l * 1024 * 1024 * 2, 1024, 1024, T / 256, 4, C.G, C.bid, 2};
    const g8::EpiResBf16 E{nullptr, WSP(bf16_t, WS_XB), WSP(bf16_t, WS_XB)};
    g8::gemm_phase<g8::EpiResBf16, g8::DenseSched, G8_ALIGN, G8_SP2>(C.lds, 1024, S, E);
#endif
}
template <int PM = 0> __device__ __forceinline__ void ph_gateup_f(const Ctx& C, int l) {
    moe_tables(C, l);
    LAS const int* ctl = (LAS const int*)(C.lds + LDS_CTL);
    LAS unsigned short* tokt = (LAS unsigned short*)(C.lds + LDS_TOKT); LAS float* btab = (LAS float*)(C.lds + LDS_BIAST); constexpr int NTAB = 28, NBT = 17;
    g8::MoeSched<true, 1024> S{C.ws + WS_HB8, C.ws + WS_WGU + (size_t)l * NEXP * 2048 * 1024, WSP(int, WS_LTOK), ctl, 8, C.G, C.bid, tokt, 0, 0};
    const float* bgu_l = WSP(float, WS_PAR) + P_BGU + (size_t)l * NEXP * 2048;
    int nu = 0;
    for (int i = 0; i < NTAB; ++i) { int pm, pn, e, rb; if (!S.locate(i, pm, pn, e, rb)) break; nu = i + 1;
        if (C.tid < 256) { const int li = (pm - rb) * 256 + C.tid, nv = ctl[e]; tokt[i * 256 + C.tid] = (unsigned short)S.ltok[(size_t)e * T + (li < nv ? li : nv - 1)]; }
        else if (i < NBT) btab[i * 256 + (C.tid - 256)] = bgu_l[(size_t)e * 2048 + pn * 256 + (C.tid - 256)]; }
    S.ntab = nu;
    __syncthreads();
    const g8::EpiGlu8 E{C.ws + (PM ? 1600 * MiB : WS_ACT), bgu_l, btab, nu < NBT ? nu : NBT};
    if constexpr (PM == 3) { const g8::MoeSched<false, 1024> S2{C.ws + WS_HB8, C.ws + WS_WGU + (size_t)l * NEXP * 2048 * 1024, WSP(int, WS_LTOK), ctl, 8, C.G, C.bid, nullptr, 0, PROBE_FIX};
        g8::gemm_phase<g8::EpiGlu8, g8::MoeSched<false, 1024>, G8_ALIGN, G8_SP2, true, 1>(C.lds, 1024, S2, E); }
    else g8::gemm_phase<g8::EpiGlu8, g8::MoeSched<true, 1024>, G8_ALIGN, G8_SP2, true, PM>(C.lds, 1024, S, E);
}
template <int PM = 0> __device__ __forceinline__ void ph_down_f(const Ctx& C, int l) {
    moe_tables(C, l);
    LAS const int* ctl = (LAS const int*)(C.lds + LDS_CTL);
    LAS float* btab = (LAS float*)(C.lds + LDS_BIAST); constexpr int NBT = 17;
    const g8::MoeSched<false, 1024> S{C.ws + WS_ACT, C.ws + WS_WD + (size_t)l * NEXP * 1024 * 1024, WSP(int, WS_LTOK), ctl, 4, C.G, C.bid, nullptr, 0, PM ? PROBE_FIX : 0};
    const float* bdn_l = WSP(float, WS_PAR) + P_BDN + (size_t)l * NEXP * 1024;
    int nu = 0;
    for (int i = 0; i < NBT; ++i) { int pm, pn, e, rb; if (!S.locate(i, pm, pn, e, rb)) break; nu = i + 1;
        if (C.tid < 256) btab[i * 256 + C.tid] = bdn_l[(size_t)e * 1024 + pn * 256 + C.tid]; }
    __syncthreads();
    const g8::EpiDown8 E{C.ws + (PM ? 1600 * MiB : WS_YB), bdn_l, btab, nu};
    g8::gemm_phase<g8::EpiDown8, g8::MoeSched<false, 1024>, G8_ALIGN, G8_SP2, true, PM>(C.lds, 1024, S, E);
}

#define XB_TMO      128
#define XB_XCNT(j)  (256  + 64 * (j))
#define XB_XSUB(j)  (1280 + 64 * (j))
#define XB_XGEN(j)  (2304 + 64 * (j))
#define XB_TOP      3328
#define XB_TOPGEN   3392
#define XCD_BAR_WORDS 3456
#define XB_SPIN_CAP (1u << 24)

__device__ __forceinline__ unsigned xb_ld(unsigned* p)              { return __hip_atomic_load(p, __ATOMIC_RELAXED, __HIP_MEMORY_SCOPE_AGENT); }
__device__ __forceinline__ unsigned xb_add(unsigned* p, unsigned v) { return __hip_atomic_fetch_add(p, v, __ATOMIC_RELAXED, __HIP_MEMORY_SCOPE_AGENT); }
__device__ __forceinline__ unsigned xb_xcc_id() { return (unsigned)__builtin_amdgcn_s_getreg((3 << 11) | 20) & 0xFu; }
#define XB_SPIN(cond, bar) do { unsigned _sp = 0; while (cond) { __builtin_amdgcn_s_sleep(1); \
    if ((++_sp & 255u) == 0u) { if (xb_ld(&(bar)[XB_TMO])) break; if (_sp > XB_SPIN_CAP) { atomicAdd(&(bar)[XB_TMO], 1u); break; } } } } while (0)

struct XcdBarrier {
    unsigned* bar; unsigned x;
    volatile LAS unsigned* st;
};

__device__ __forceinline__ XcdBarrier xcd_barrier_post(unsigned* bar, volatile LAS unsigned* st) {
    XcdBarrier b; b.bar = bar; b.x = xb_xcc_id(); b.st = st;
    if (threadIdx.x == 0) (void)xb_add(&bar[XB_XCNT(b.x)], 1u);
    return b;
}
__device__ __forceinline__ void xcd_barrier_complete(unsigned* bar, unsigned x, unsigned& nloc, unsigned& nx) {
    const unsigned G = gridDim.x * gridDim.y * gridDim.z;
    unsigned sum, cnt, mine, sp = 0u;
    for (;;) {
        sum = 0u; cnt = 0u; mine = 0u;
#pragma unroll
        for (unsigned j = 0; j < 16; ++j) { const unsigned c = xb_ld(&bar[XB_XCNT(j)]); sum += c; cnt += (c > 0u) ? 1u : 0u; mine = (j == x) ? c : mine; }
        if (sum == G) break;
        __builtin_amdgcn_s_sleep(1);
        if ((++sp & 255u) == 0u) { if (xb_ld(&bar[XB_TMO])) break; if (sp > XB_SPIN_CAP) { atomicAdd(&bar[XB_TMO], 1u); break; } }
    }
    nloc = mine > 0u ? mine : 1u; nx = cnt > 0u ? cnt : 1u;
}

__device__ __forceinline__ void xcd_barrier(const XcdBarrier& b) {
    asm volatile("s_waitcnt vmcnt(0)" ::: "memory");
    __syncthreads();
    if (threadIdx.x == 0) {
        unsigned* bar = b.bar;
        __builtin_amdgcn_s_waitcnt(0);
        unsigned nloc = b.st[0], nx = b.st[1];
        if (nloc == 0u) { xcd_barrier_complete(bar, b.x, nloc, nx); b.st[0] = nloc; b.st[1] = nx; }
        const unsigned old = xb_add(&bar[XB_XSUB(b.x)], 1u);
        const unsigned gen = old / nloc;
        if (old + 1u == (gen + 1u) * nloc) {
            __builtin_amdgcn_fence(__ATOMIC_RELEASE, "agent");
            asm volatile("s_waitcnt vmcnt(0)" ::: "memory");
            const unsigned og = xb_add(&bar[XB_TOP], 1u);
            const unsigned tg = og / nx;
            if (og + 1u == (tg + 1u) * nx) xb_add(&bar[XB_TOPGEN], 1u);
            else XB_SPIN(xb_ld(&bar[XB_TOPGEN]) == tg, bar);
            __builtin_amdgcn_fence(__ATOMIC_ACQUIRE, "agent");
            xb_add(&bar[XB_XGEN(b.x)], 1u);
            asm volatile("s_waitcnt vmcnt(0)" ::: "memory");
        } else {
            XB_SPIN(xb_ld(&bar[XB_XGEN(b.x)]) == gen, bar);
            __builtin_amdgcn_fence(__ATOMIC_ACQUIRE, "agent");
            asm volatile("s_waitcnt vmcnt(0)" ::: "memory");
        }
    }
    __syncthreads();
}

constexpr int NPH = 11;
struct Args { const float* in[N_IN]; float* out; unsigned char* ws; int ph_lo, ph_hi; };
__global__ void __launch_bounds__(NTHR, 2) fwd(Args args) {
    extern __shared__ __attribute__((aligned(16))) unsigned char lds_raw[];
    Ctx C;
    C.x = args.in[I_X]; C.out = args.out; C.ws = args.ws; C.lds = (LAS unsigned char*)lds_raw;
    C.tid = threadIdx.x; C.lane = C.tid & 63; C.wave = __builtin_amdgcn_readfirstlane(C.tid >> 6); C.G = gridDim.x; C.bid = blockIdx.x;
    const int lo = args.ph_lo, hi = args.ph_hi;
    if (C.tid < 4) ((LAS unsigned*)(C.lds + LDS_CTL))[160 + C.tid] = 0u;
    __syncthreads();
    XcdBarrier bar = xcd_barrier_post(WSP(unsigned, WS_CTL) + CW_BAR, (volatile LAS unsigned*)(C.lds + LDS_CTL) + 160);
#define IN(k) (lo <= (k) && (k) < hi)
#ifndef PROBE_DUP
#define PROBE_DUP 0
#endif
#ifndef PROBE_PM
#define PROBE_PM 0
#endif
#ifndef PROBE_BAR2
#define PROBE_BAR2 0
#endif
#define DUPN(bit) (((PROBE_DUP) >> (bit)) & 1 ? 2 : 1)
#define SEAM(k) do { if (IN(k) && IN((k) + 1)) { XcdBarrier b2_ = bar; unsigned long long p_ = (unsigned long long)b2_.bar; asm volatile("" : "+s"(p_)); b2_.bar = (unsigned*)p_; xcd_barrier(b2_); if (PROBE_BAR2) xcd_barrier(b2_); } } while (0)
    if (IN(0)) for (int r_ = 0; r_ < DUPN(0); ++r_) { const Ctx L = phase_enter(C); ph_prologue(L, args.in); }
    SEAM(0);
    for (int l = 0; l < NLAYER; ++l) {
        const int p0 = 1 + l * NPH;
        if (IN(p0 + 0)) for (int r_ = 0; r_ < (DUPN(1)); ++r_) { const Ctx L = phase_enter(C);
#if FAST_INPROJ
            ph_inproj_f(L, l);
#else
            ph_inproj(L, l);
#endif
        }
        SEAM(p0 + 0);
        if (IN(p0 + 1)) { for (int r_ = 0; r_ < (DUPN(2)); ++r_) { const Ctx L = phase_enter(C); if (r_ == 0 && DUPN(2) == 2 && PROBE_PM) ph_mix1<PROBE_PM>(L, l); else ph_mix1<0>(L, l); }
            for (int r_ = 0; r_ < (DUPN(3)); ++r_) { const Ctx L = phase_enter(C); ph_qkvgemm_f(L, l); } }
        SEAM(p0 + 1);
        if (IN(p0 + 2)) { for (int r_ = 0; r_ < (DUPN(3)); ++r_) { const Ctx L = phase_enter(C); ph_mixgemm_f(L, l); }
            for (int r_ = 0; r_ < (DUPN(4)); ++r_) { const Ctx L = phase_enter(C); if (r_ == 0 && DUPN(4) == 2 && PROBE_PM) ph_qkfin<PROBE_PM>(L, l); else ph_qkfin<0>(L, l); }
#if ATT_PV8
            { const Ctx L = phase_enter(C); ph_vtbuild(L, l); }
#endif
        }
        if (IN(p0 + 2) && !IN(p0 + 3)) {   }
        SEAM(p0 + 3);
                if (IN(p0 + 4)) for (int r_ = 0; r_ < (DUPN(5)); ++r_) { const Ctx L = phase_enter(C); ph_attn(L, l); }
        SEAM(p0 + 4);
        if (IN(p0 + 5)) for (int r_ = 0; r_ < (DUPN(6)); ++r_) { const Ctx L = phase_enter(C); ph_mixnorm(L, l); }
        SEAM(p0 + 5);
        if (IN(p0 + 6)) for (int r_ = 0; r_ < (l == 0 ? DUPN(7) : 1); ++r_) { const Ctx L = phase_enter(C);
#if FAST_OUTPROJ
            ph_outproj_f(L, l);
#else
            ph_outproj(L, l);
#endif
        }
        SEAM(p0 + 6);
        if (IN(p0 + 7)) { if (DUPN(10) == 2) { const Ctx L = phase_enter(C); ph_route(L, l, 1); } const Ctx L = phase_enter(C); ph_route(L, l); }
        SEAM(p0 + 7);
        if (IN(p0 + 8)) for (int r_ = 0; r_ < (DUPN(8)); ++r_) { const Ctx L = phase_enter(C);
#if FAST_GATEUP
            if (r_ == 0 && DUPN(8) == 2 && PROBE_PM) ph_gateup_f<PROBE_PM>(L, l); else ph_gateup_f<0>(L, l);
#else
            ph_gateup(L, l);
#endif
        }
        SEAM(p0 + 8);
        if (IN(p0 + 9)) for (int r_ = 0; r_ < (DUPN(9)); ++r_) { const Ctx L = phase_enter(C);
#if FAST_DOWN
            if (r_ == 0 && DUPN(9) == 2 && PROBE_PM) ph_down_f<PROBE_PM>(L, l); else ph_down_f<0>(L, l);
#else
            ph_down(L, l);
#endif
        }
        SEAM(p0 + 9);
        if (IN(p0 + 10)) { if (DUPN(11) == 2) { { const Ctx L = phase_enter(C); ph_combine(L, l, 0.5f); } xcd_barrier(bar); { const Ctx L = phase_enter(C); ph_combine(L, l, 0.5f); } } else { const Ctx L = phase_enter(C); ph_combine(L, l); } }
        SEAM(p0 + 10);
    }
#undef SEAM
#undef IN
}

extern "C" void kernel_launch(void* const* d_in, const int* in_sizes, int n_in, void* d_out, int out_size, void* d_ws, size_t ws_size, hipStream_t stream) {
    static int grid = 0;
    if (grid == 0) {
        if (n_in != N_IN || in_sizes[0] != T * DM || out_size != T * DM || ws_size < WS_END) {
            fprintf(stderr, "kernel_launch: shape mismatch (n_in %d, in0 %d, out %d, ws %zu need %zu)\n", n_in, n_in > 0 ? in_sizes[0] : -1, out_size, ws_size, (size_t)WS_END); grid = -1; return; }
        int dev = 0, cus = 0;
        if (hipGetDevice(&dev) != hipSuccess || hipDeviceGetAttribute(&cus, hipDeviceAttributeMultiprocessorCount, dev) != hipSuccess) { grid = -1; return; }
        if (hipFuncSetAttribute((const void*)fwd, hipFuncAttributeMaxDynamicSharedMemorySize, LDS_BYTES) != hipSuccess) { fprintf(stderr, "kernel_launch: hipFuncSetAttribute failed\n"); grid = -1; return; }
        if (cus < 160) { fprintf(stderr, "kernel_launch: built for a >= 160-CU device (per-workgroup unit tables); %d CUs\n", cus); grid = -1; return; }
        grid = cus;
    }
    if (grid < 0) return;
    (void)hipMemsetAsync((char*)d_ws + WS_CTL, 0, CTL_ZERO_BYTES, stream);
    Args a{};
    for (int i = 0; i < N_IN; ++i) a.in[i] = (const float*)d_in[i];
    a.out = (float*)d_out; a.ws = (unsigned char*)d_ws;
    const int nphase = 1 + NLAYER * NPH;
#if defined(MK_PER_PHASE)
    for (int p = 0; p < nphase; ++p) { a.ph_lo = p; a.ph_hi = p + 1; hipLaunchKernelGGL(fwd, dim3(grid), dim3(NTHR), LDS_BYTES, stream, a); }
#else
    a.ph_lo = 0; a.ph_hi = nphase;
    hipLaunchKernelGGL(fwd, dim3(grid), dim3(NTHR), LDS_BYTES, stream, a);
#endif
}
```

```cpp
#include <hip/hip_runtime.h>
#include <cstdio>
#include <cstdint>

#ifndef OUTPROJ_FP8
#define OUTPROJ_FP8 0
#endif
#ifndef PROBE_FIX
#define PROBE_FIX 0
#endif
#ifndef MOE_FP8
#define MOE_FP8 1
#define PV_PIPE 1
#define ATT_PV8 1
#define ATT_QK8 1
#endif
#define LAS __attribute__((address_space(3)))
typedef unsigned short bf16_t;
typedef short bf16x8 __attribute__((ext_vector_type(8)));
typedef float f32x4 __attribute__((ext_vector_type(4)));
typedef float f32x2 __attribute__((ext_vector_type(2)));
typedef unsigned u32x4 __attribute__((ext_vector_type(4)));
typedef unsigned u32x2 __attribute__((ext_vector_type(2)));

constexpr int T = 32768, DM = 1024, SEQ = 4096, NBATCH = 8, NLAYER = 2;
constexpr int DIN = 1216, DINP = 1280;
constexpr int NEXP = 32, TOPK = 4, DFF = 1024;
constexpr int MOE_ROWS = T * TOPK + NEXP * 256;
constexpr float EPS = 1e-6f;
constexpr int NTHR = 512, NWAVE = 8;

enum { I_X = 0, I_POS, I_ANG, I_WIN, I_POOLW, I_POOLS, I_CDW, I_CDWB, I_CLNG, I_CLNB, I_CPW, I_CPWB, I_QAG, I_WUQ, I_KVAG, I_WUKV,
       I_QNG, I_KNG, I_POG, I_COG, I_AOG, I_WO, I_FNG, I_WR, I_BR, I_WGU, I_BGU, I_WDN, I_BDN, N_IN };

constexpr size_t MiB = 1u << 20;
constexpr size_t WS_CTL = 0, CTL_ZERO_BYTES = 1 * MiB;
constexpr size_t WS_COS = 1 * MiB;
constexpr size_t WS_WIN = 9 * MiB;
constexpr size_t WS_WMIX = 14 * MiB;
constexpr size_t WS_WQ = 15 * MiB;
constexpr size_t WS_WKV = 16 * MiB;
constexpr size_t WS_WO = 17 * MiB;
constexpr size_t WS_WR = 21 * MiB;
constexpr size_t WS_WGU = 22 * MiB;
constexpr size_t WS_WD = 278 * MiB;
constexpr size_t WS_HB = 406 * MiB;
constexpr size_t WS_RS = 406 * MiB;
constexpr size_t WS_Z = 470 * MiB;
constexpr size_t WS_A2 = 550 * MiB;
constexpr size_t WS_YMIX = 582 * MiB;
constexpr size_t WS_QRAW = 614 * MiB;
constexpr size_t WS_KVRAW = 662 * MiB;
constexpr size_t WS_Q = 726 * MiB;
constexpr size_t WS_KIMG = 774 * MiB;
constexpr size_t WS_VIMG = 822 * MiB;
constexpr size_t WS_YATT = 854 * MiB;
constexpr size_t WS_MIX = 918 * MiB;
constexpr size_t WS_LTOK = 982 * MiB;
constexpr size_t WS_LGATE = 986 * MiB;
constexpr size_t WS_ASG = 990 * MiB;
constexpr size_t WS_PAR = 991 * MiB;
constexpr int P_CDW = 0, P_CDWB = 15872, P_CLNG = 16384, P_CLNB = 16896, P_CPWB = 17408, P_QNG = 17920, P_KNG = 18304, P_BR = 18688, P_MIXB = 19456, P_BGU = 20480, P_BDN = 151552, P_END = 217088;
static_assert((size_t)P_END * 4 <= 1 * MiB, "param area");
constexpr size_t WS_ACT = 992 * MiB;
constexpr size_t WS_YB = 1264 * MiB;
constexpr size_t WS_HB8 = 1536 * MiB;
constexpr size_t WS_XB = 1568 * MiB;
constexpr size_t WS_END = 1632 * MiB;
static_assert((size_t)MOE_ROWS * 1024 * 2 <= 272 * MiB, "act buffer");

constexpr int CW_BAR = 4096;
constexpr int CW_GCNT = 16384;

constexpr int LDS_BYTES = 163840;
constexpr int LDS_CTL = 162816;
constexpr int LDS_TOKT = 131072, LDS_BIAST = 131072 + 28 * 512;

__device__ __forceinline__ unsigned f2bf(float f) { unsigned u = __builtin_bit_cast(unsigned, f); return (u + 0x7fffu + ((u >> 16) & 1u)) >> 16; }
typedef __bf16 bf16x2_hw __attribute__((ext_vector_type(2)));
__device__ __forceinline__ unsigned pk2(float lo, float hi) { typedef float f2_ __attribute__((ext_vector_type(2))); const f2_ v = {lo, hi}; return __builtin_bit_cast(unsigned, __builtin_convertvector(v, bf16x2_hw)); }
__device__ __forceinline__ float bf2f(unsigned b) { return __builtin_bit_cast(float, b << 16); }
__device__ __forceinline__ float bflo(unsigned w) { return __builtin_bit_cast(float, w << 16); }
__device__ __forceinline__ float bfhi(unsigned w) { return __builtin_bit_cast(float, w & 0xffff0000u); }
__device__ __forceinline__ float wave_sum(float v) {
#pragma unroll
    for (int o = 1; o < 64; o <<= 1) v += __shfl_xor(v, o);
    return v;
}
__device__ __forceinline__ float grp16_sum(float v) {
#pragma unroll
    for (int o = 1; o < 16; o <<= 1) v += __shfl_xor(v, o);
    return v;
}
__device__ __forceinline__ unsigned pk4_fp8(float a, float b, float c, float d) { unsigned w = 0; w = __builtin_amdgcn_cvt_pk_fp8_f32(a, b, w, false); w = __builtin_amdgcn_cvt_pk_fp8_f32(c, d, w, true); return w; }
__device__ __forceinline__ float sigmoidf_(float x) { return 1.0f / (1.0f + __expf(-x)); }

struct Ctx {
    const float* x; float* out; unsigned char* ws; LAS unsigned char* lds;
    int tid, lane, wave, G, bid;
};
#define WSP(T_, off) ((T_*)(C.ws + (off)))
__device__ __forceinline__ Ctx phase_enter(const Ctx& C0) {
    Ctx C = C0; int t = threadIdx.x; asm volatile("" : "+v"(t)); C.tid = t; C.lane = t & 63; C.wave = __builtin_amdgcn_readfirstlane(t >> 6);
    unsigned long long w = (unsigned long long)C0.ws, o = (unsigned long long)C0.out, x = (unsigned long long)C0.x;
    asm volatile("" : "+s"(w), "+s"(o), "+s"(x));
    C.ws = (unsigned char*)(__attribute__((address_space(1))) unsigned char*)w; C.out = (float*)(__attribute__((address_space(1))) float*)o; C.x = (const float*)(const __attribute__((address_space(1))) float*)x; return C; }

__device__ __forceinline__ int kimg_off(int r, int c) { return (c >> 1) * 2048 + (c & 1) * 1024 + (r >> 5) * 512 + (r & 31) * 16; }
__device__ __forceinline__ int v_st(int k, int c) { const int kk = (k & ~0xC) | ((k & 4) << 1) | ((k & 8) >> 1); return ((kk >> 3) * 4 + (c >> 5)) * 512 + ((kk & 7) * 32 + (c & 31)) * 2; }

template <class RowMap>
__device__ __forceinline__ void tconv_item(const float* W, int N, int k0, int n0, const float* kscale, bf16_t* WT, int ldk, RowMap rm, LAS float* scr, int lane) {
#pragma unroll 8
    for (int i = 0; i < 32; ++i) { const int kk = 2 * i + (lane >> 5); float v = W[(size_t)(k0 + kk) * N + n0 + (lane & 31)]; if (kscale) v *= kscale[k0 + kk]; scr[kk * 33 + (lane & 31)] = v; }
    asm volatile("s_waitcnt lgkmcnt(0)" ::: "memory");
    const int c = lane & 7;
#pragma unroll
    for (int j = 0; j < 4; ++j) { const int n = (lane >> 3) + 8 * j; const LAS float* s = scr + (8 * c) * 33 + n;
        u32x4 o; o.x = pk2(s[0 * 33], s[1 * 33]); o.y = pk2(s[2 * 33], s[3 * 33]); o.z = pk2(s[4 * 33], s[5 * 33]); o.w = pk2(s[6 * 33], s[7 * 33]);
        *(u32x4*)(WT + (size_t)rm(n0 + n) * ldk + k0 + 8 * c) = o; }
    asm volatile("s_waitcnt lgkmcnt(0)" ::: "memory");
}
template <class RowMap>
__device__ __forceinline__ void tconv128_item(const float* W, int N, int k0, int n0, const float* kscale, bf16_t* WT, int ldk, RowMap rm, LAS unsigned* scr, int lane) {
    const float* src = W + (size_t)k0 * N + n0 + 2 * lane;
#pragma unroll 8
    for (int kp = 0; kp < 32; ++kp) {
        const f32x2 r0 = *(const f32x2*)(src + (size_t)(2 * kp) * N), r1 = *(const f32x2*)(src + (size_t)(2 * kp + 1) * N);
        const float s0 = kscale ? kscale[k0 + 2 * kp] : 1.f, s1 = kscale ? kscale[k0 + 2 * kp + 1] : 1.f;
        scr[(2 * lane) * 33 + kp] = pk2(r0.x * s0, r1.x * s1); scr[(2 * lane + 1) * 33 + kp] = pk2(r0.y * s0, r1.y * s1); }
    asm volatile("s_waitcnt lgkmcnt(0)" ::: "memory");
    const int c = lane & 7;
#pragma unroll 4
    for (int j = 0; j < 16; ++j) { const int n = (lane >> 3) + 8 * j; const LAS unsigned* p = scr + n * 33 + 4 * c;
        *(u32x4*)(WT + (size_t)rm(n0 + n) * ldk + k0 + 8 * c) = (u32x4){p[0], p[1], p[2], p[3]}; }
    asm volatile("s_waitcnt lgkmcnt(0)" ::: "memory");
}
template <class RowMap>
__device__ __forceinline__ void tconv128_f8_item(const float* W, int N, int k0, int n0, const float* kscale, float wscale, unsigned char* WT, int ldk, RowMap rm, LAS unsigned* scr, int lane) {
    const float* src = W + (size_t)k0 * N + n0 + 2 * lane;
#pragma unroll 8
    for (int kq = 0; kq < 32; ++kq) {
        const f32x2 r0 = *(const f32x2*)(src + (size_t)(4 * kq) * N), r1 = *(const f32x2*)(src + (size_t)(4 * kq + 1) * N), r2 = *(const f32x2*)(src + (size_t)(4 * kq + 2) * N), r3 = *(const f32x2*)(src + (size_t)(4 * kq + 3) * N);
        float s0 = wscale, s1 = wscale, s2 = wscale, s3 = wscale;
        if (kscale) { s0 *= kscale[k0 + 4 * kq]; s1 *= kscale[k0 + 4 * kq + 1]; s2 *= kscale[k0 + 4 * kq + 2]; s3 *= kscale[k0 + 4 * kq + 3]; }
        scr[(2 * lane) * 33 + kq] = pk4_fp8(r0.x * s0, r1.x * s1, r2.x * s2, r3.x * s3); scr[(2 * lane + 1) * 33 + kq] = pk4_fp8(r0.y * s0, r1.y * s1, r2.y * s2, r3.y * s3); }
    asm volatile("s_waitcnt lgkmcnt(0)" ::: "memory");
    const int c = lane & 7;
#pragma unroll 4
    for (int j = 0; j < 16; ++j) { const int n = (lane >> 3) + 8 * j; const LAS unsigned* p = scr + n * 33 + 4 * c;
        *(u32x4*)(WT + (size_t)rm(n0 + n) * ldk + k0 + 16 * c) = (u32x4){p[0], p[1], p[2], p[3]}; }
    asm volatile("s_waitcnt lgkmcnt(0)" ::: "memory");
}
struct RmId { __device__ __forceinline__ int operator()(int n) const { return n; } };
struct RmGu { __device__ __forceinline__ int operator()(int n) const { const int j = n >> 1, half = n & 1; return ((j >> 7) << 8) + (half << 7) + (j & 127); } };

struct Args;
__device__ __forceinline__ void ph_prologue(const Ctx& C, const float* const* in_) {
#define PIN(i) (in_[i])
    LAS float* scr = (LAS float*)(C.lds + C.wave * 16384);
    const int gw = C.bid * NWAVE + C.wave, NGW = C.G * NWAVE;
    constexpr int I_IN = 16 * 38, I_O = 16 * 32;
    constexpr int N_IN_ = NLAYER * I_IN, N_O_ = NLAYER * I_O;
    for (int it = gw; it < N_IN_ + N_O_; it += NGW) {
        int r = it;
        if (r < N_IN_) { const int l = r / I_IN, q = r % I_IN, kb = q / 38, nb = q % 38;
            tconv_item(PIN(I_WIN) + (size_t)l * 1024 * DIN, DIN, kb * 64, nb * 32, PIN(I_ANG) + l * 1024, WSP(bf16_t, WS_WIN) + (size_t)l * DINP * 1024, 1024, RmId(), scr, C.lane); continue; }
        r -= N_IN_;
#if !OUTPROJ_FP8
        { const int l = r / I_O, q = r % I_O, kb = q / 32, nb = q % 32, k0 = kb * 64;
            const float* ks = (k0 < 256) ? (PIN(I_POG) + l * 256) : (k0 < 512) ? (PIN(I_COG) + l * 256 - 256) : (PIN(I_AOG) + l * 512 - 512);
            tconv_item(PIN(I_WO) + (size_t)l * 1024 * 1024, 1024, k0, nb * 32, ks, WSP(bf16_t, WS_WO) + (size_t)l * 1024 * 1024, 1024, RmId(), scr, C.lane); }
#endif
    }
    __syncthreads();
    { LAS unsigned* scr2 = (LAS unsigned*)(C.lds + C.wave * 16896);
#if OUTPROJ_FP8
      for (int it = gw; it < NLAYER * 64; it += NGW) { const int l = it >> 6, q = it & 63, kb = q >> 3, nb = q & 7, k0 = kb * 128;
          const float* ks = (k0 < 256) ? (PIN(I_POG) + l * 256) : (k0 < 512) ? (PIN(I_COG) + l * 256 - 256) : (PIN(I_AOG) + l * 512 - 512);
          tconv128_f8_item(PIN(I_WO) + (size_t)l * 1024 * 1024, 1024, k0, nb * 128, ks, 32.f, C.ws + WS_WO + (size_t)l * 1024 * 1024, 1024, RmId(), scr2, C.lane); }
#endif
#if MOE_FP8
      constexpr int I_GU = 8 * 16, I_DN = 8 * 8;
      constexpr int N_GU_ = NLAYER * NEXP * I_GU, N_DN_ = NLAYER * NEXP * I_DN;
      for (int it = gw; it < N_GU_ + N_DN_; it += NGW) {
        if (it < N_GU_) { const int le = it / I_GU, q = it % I_GU, kb = q / 16, nb = q % 16, l = le / NEXP;
            tconv128_f8_item(PIN(I_WGU) + (size_t)le * 1024 * 2048, 2048, kb * 128, nb * 128, PIN(I_FNG) + l * 1024, 32.f, C.ws + WS_WGU + (size_t)le * 2048 * 1024, 1024, RmGu(), scr2, C.lane);
        } else { const int r = it - N_GU_, le = r / I_DN, q = r % I_DN, kb = q / 8, nb = q % 8;
            tconv128_f8_item(PIN(I_WDN) + (size_t)le * 1024 * 1024, 1024, kb * 128, nb * 128, nullptr, 32.f, C.ws + WS_WD + (size_t)le * 1024 * 1024, 1024, RmId(), scr2, C.lane); }
      } }
#else
      constexpr int I_GU = 16 * 16, I_DN = 16 * 8;
      constexpr int N_GU_ = NLAYER * NEXP * I_GU, N_DN_ = NLAYER * NEXP * I_DN;
      for (int it = gw; it < N_GU_ + N_DN_; it += NGW) {
        if (it < N_GU_) { const int le = it / I_GU, q = it % I_GU, kb = q / 16, nb = q % 16, l = le / NEXP;
            tconv128_item(PIN(I_WGU) + (size_t)le * 1024 * 2048, 2048, kb * 64, nb * 128, PIN(I_FNG) + l * 1024, WSP(bf16_t, WS_WGU) + (size_t)le * 2048 * 1024, 1024, RmGu(), scr2, C.lane);
        } else { const int r = it - N_GU_, le = r / I_DN, q = r % I_DN, kb = q / 8, nb = q % 8;
            tconv128_item(PIN(I_WDN) + (size_t)le * 1024 * 1024, 1024, kb * 64, nb * 128, nullptr, WSP(bf16_t, WS_WD) + (size_t)le * 1024 * 1024, 1024, RmId(), scr2, C.lane); }
      } }
#endif
    const int gt = C.bid * NTHR + C.tid, NGT = C.G * NTHR;
    for (int i = gt; i < NLAYER * 512 * 512; i += NGT) {
        const int l = i / (512 * 512), n = (i / 512) % 512, k = i % 512; float v = 0.f;
        if (n < 256) { const int g = n >> 6, d = n & 63; if (k < 256 && (k >> 6) == g) v = PIN(I_POOLW)[((size_t)(l * 4 + g) * 64 + (k & 63)) * 64 + d] * PIN(I_POOLS)[l * 256 + n]; }
        else { if (k >= 256) v = PIN(I_CPW)[((size_t)l * 256 + (k - 256)) * 256 + (n - 256)]; }
        WSP(bf16_t, WS_WMIX)[i] = (bf16_t)f2bf(v);
    }
    for (int i = gt; i < NLAYER * 768 * 256; i += NGT) {
        const int l = i / (768 * 256), n = (i / 256) % 768, k = i % 256;
        WSP(bf16_t, WS_WQ)[i] = (bf16_t)f2bf(PIN(I_WUQ)[((size_t)l * 256 + k) * 768 + n] * PIN(I_QAG)[l * 256 + k]);
    }
    for (int i = gt; i < NLAYER * 1024 * 256; i += NGT) {
        const int l = i / (1024 * 256), n = (i / 256) % 1024, k = i % 256;
        WSP(bf16_t, WS_WKV)[i] = (bf16_t)(k < 128 ? f2bf(PIN(I_WUKV)[((size_t)l * 128 + k) * 1024 + n] * PIN(I_KVAG)[l * 128 + k]) : 0u);
    }
    for (int i = gt; i < NLAYER * 32 * 1024; i += NGT) {
        const int l = i / (32 * 1024), e = (i / 1024) % 32, k = i % 1024;
        const float wv = PIN(I_WR)[((size_t)l * 1024 + k) * 32 + e] * PIN(I_FNG)[l * 1024 + k];
        const unsigned hi = f2bf(wv); const float rem = wv - bf2f(hi);
        WSP(bf16_t, WS_WR)[((size_t)(l * 2 + 0) * 32 + e) * 1024 + k] = (bf16_t)hi; WSP(bf16_t, WS_WR)[((size_t)(l * 2 + 1) * 32 + e) * 1024 + k] = (bf16_t)f2bf(rem);
    }
    for (int i = gt; i < NLAYER * 64 * 1024; i += NGT) {
        const int l = i / (64 * 1024), r = (i / 1024) % 64, k = i % 1024;
        WSP(bf16_t, WS_WIN)[((size_t)l * DINP + DIN + r) * 1024 + k] = 0;
    }
    { float* P = WSP(float, WS_PAR);
      for (int i = gt; i < 2 * 31 * 256; i += NGT) P[P_CDW + i] = PIN(I_CDW)[i];
      for (int i = gt; i < 512; i += NGT) { P[P_CDWB + i] = PIN(I_CDWB)[i]; P[P_CLNG + i] = PIN(I_CLNG)[i]; P[P_CLNB + i] = PIN(I_CLNB)[i]; P[P_CPWB + i] = PIN(I_CPWB)[i]; }
      for (int i = gt; i < 384; i += NGT) { P[P_QNG + i] = PIN(I_QNG)[i]; P[P_KNG + i] = PIN(I_KNG)[i]; }
      for (int i = gt; i < 64; i += NGT) P[P_BR + i] = PIN(I_BR)[i];
      for (int i = gt; i < 1024; i += NGT) { const int l_ = i >> 9, n_ = i & 511; P[P_MIXB + i] = (n_ >= 256) ? PIN(I_CPWB)[l_ * 256 + n_ - 256] : 0.f; }
      for (int i = gt; i < 2 * 32 * 2048; i += NGT) P[P_BGU + i] = PIN(I_BGU)[i];
      for (int i = gt; i < 2 * 32 * 1024; i += NGT) P[P_BDN + i] = PIN(I_BDN)[i]; }
    const float invf = (float)exp(-9.210340371976184 * (double)(gt & 31) / 32.0);
    for (int i = gt; i < T * 32; i += NGT) {
        const int t = i >> 5;
        const float ang = (float)((const int*)PIN(I_POS))[t] * invf;
        double r = (double)ang; r = r - 6.283185307179586476925 * rint(r * 0.15915494309189533577);
        const float rf = (float)r;
        WSP(f32x2, WS_COS)[i] = (f32x2){cosf(rf), sinf(rf)};
    }
    f32x4 vn[4], vn2[4];
    if (gw < T) { const f32x4* xr = (const f32x4*)(PIN(I_X) + (size_t)gw * DM) + C.lane;
#pragma unroll
        for (int j = 0; j < 4; ++j) { vn[j] = xr[64 * j]; vn2[j] = vn[j]; } }
    if (gw + NGW < T) { const f32x4* xr = (const f32x4*)(PIN(I_X) + (size_t)(gw + NGW) * DM) + C.lane;
#pragma unroll
        for (int j = 0; j < 4; ++j) vn2[j] = xr[64 * j]; }
    for (int m = gw; m < T; m += NGW) {
        f32x4 v[4]; float s = 0.f;
#pragma unroll
        for (int j = 0; j < 4; ++j) { v[j] = vn[j]; vn[j] = vn2[j]; s += (v[j].x * v[j].x + v[j].y * v[j].y) + (v[j].z * v[j].z + v[j].w * v[j].w); }
        if (m + 2 * NGW < T) { const f32x4* xr = (const f32x4*)(PIN(I_X) + (size_t)(m + 2 * NGW) * DM) + C.lane;
#pragma unroll
            for (int j = 0; j < 4; ++j) vn2[j] = xr[64 * j]; }
        const float rs = rsqrtf(wave_sum(s) * (1.f / DM) + EPS);
        u32x2* o = (u32x2*)(WSP(bf16_t, WS_XB) + (size_t)m * DM) + C.lane;
#pragma unroll
        for (int j = 0; j < 4; ++j) o[64 * j] = (u32x2){pk2(v[j].x, v[j].y), pk2(v[j].z, v[j].w)};
        if (C.lane == 0) WSP(float, WS_RS)[m] = rs;
    }
}
#undef PIN

template <int NBT, class RowPtr, class Epi>
__device__ __forceinline__ void sg_tile(const Ctx& C, RowPtr rowptr, const bf16_t* Bt0, const bf16_t* Bt1, int K, Epi epi) {
    constexpr int LDR = 40;
    LAS bf16_t* SA = (LAS bf16_t*)C.lds; LAS bf16_t* SB = SA + 128 * LDR;
    const int tid = C.tid, lane = C.lane, wid = C.wave, wr = wid >> 1, wc = wid & 1, fr = lane & 15, fq = lane >> 4;
    const int sr = tid >> 2, sc = (tid & 3) * 8;
    const bf16_t* ap = rowptr(sr) + sc;
    const bf16_t* bp0 = Bt0 + (size_t)sr * K + sc; const bf16_t* bp1 = (NBT == 2) ? (Bt1 + (size_t)sr * K + sc) : bp0;
    f32x4 acc[NBT][2][4];
#pragma unroll
    for (int b = 0; b < NBT; ++b)
#pragma unroll
        for (int m = 0; m < 2; ++m)
#pragma unroll
            for (int n = 0; n < 4; ++n) acc[b][m][n] = (f32x4){0.f, 0.f, 0.f, 0.f};
    for (int kt = 0; kt < K / 32; ++kt) {
        const bf16x8 av = *(const bf16x8*)(ap + kt * 32); const bf16x8 bv0 = *(const bf16x8*)(bp0 + kt * 32); bf16x8 bv1 = bv0; if (NBT == 2) bv1 = *(const bf16x8*)(bp1 + kt * 32);
        __syncthreads();
        *(LAS bf16x8*)(SA + sr * LDR + sc) = av; *(LAS bf16x8*)(SB + sr * LDR + sc) = bv0; if (NBT == 2) *(LAS bf16x8*)(SB + (128 + sr) * LDR + sc) = bv1;
        __syncthreads();
        bf16x8 a[2], b[NBT][4];
#pragma unroll
        for (int m = 0; m < 2; ++m) a[m] = *(const LAS bf16x8*)(SA + (wr * 32 + m * 16 + fr) * LDR + fq * 8);
#pragma unroll
        for (int bt = 0; bt < NBT; ++bt)
#pragma unroll
            for (int n = 0; n < 4; ++n) b[bt][n] = *(const LAS bf16x8*)(SB + (bt * 128 + wc * 64 + n * 16 + fr) * LDR + fq * 8);
#pragma unroll
        for (int bt = 0; bt < NBT; ++bt)
#pragma unroll
            for (int m = 0; m < 2; ++m)
#pragma unroll
                for (int n = 0; n < 4; ++n) acc[bt][m][n] = __builtin_amdgcn_mfma_f32_16x16x32_bf16(a[m], b[bt][n], acc[bt][m][n], 0, 0, 0);
    }
#pragma unroll
    for (int m = 0; m < 2; ++m)
#pragma unroll
        for (int n = 0; n < 4; ++n)
#pragma unroll
            for (int j = 0; j < 4; ++j) {
                const int r = wr * 32 + m * 16 + fq * 4 + j, c = wc * 64 + n * 16 + fr;
                if (NBT == 2) epi(r, c, acc[0][m][n][j], acc[NBT - 1][m][n][j]); else epi(r, c, acc[0][m][n][j], 0.f);
            }
    __syncthreads();
}


namespace g8 {
constexpr int BM = 256, BK = 64, HALF = 128, HTB = HALF * BK * 2, STAGE_BYTES = 8 * HTB;
__device__ __forceinline__ int lds_byte(int r, int c) { const int st = (r >> 4) * 2 + (c >> 5), rr = r & 15, cc = c & 31, ob = rr * 64 + cc * 2; return st * 1024 + (ob ^ (((ob >> 9) & 1) << 5)); }
__device__ __forceinline__ void stage_rc(int b, int& R, int& Cc) { const int st = b / 1024, sb = b % 1024, swz = sb ^ (((sb >> 9) & 1) << 5); R = (st >> 1) * 16 + swz / 64; Cc = (st & 1) * 32 + (swz % 64) / 2; }
__device__ __forceinline__ int perm32(int rho) { const int n = rho >> 4, i = rho & 15; return 8 * (i >> 2) + 4 * n + (i & 3); }
__device__ __forceinline__ int h8(int x) { return (int)((0x64753120u >> (4 * x)) & 7u); }
template <bool F8> __device__ __forceinline__ void stage_map(int b, int& R, int& Cc) {
    if constexpr (F8) { const int q = b >> 4; R = q >> 3; Cc = ((q & 7) ^ h8((R >> 1) & 7)) * 8; } else stage_rc(b, R, Cc); }
struct GUnit { const unsigned char* A; const unsigned char* B; int row0, col0, e, aux; };
__device__ __forceinline__ void tile_of(int L, int nM, int nN, int& pm, int& pn) {
    const int nwg = nM * nN; int wgid = L; { const int q = nwg / 8, r = nwg % 8, xcd = wgid % 8, off = wgid / 8; wgid = (xcd < r ? xcd * (q + 1) : r * (q + 1) + (xcd - r) * q) + off; }
    const int nig = 8 * nN, gid = wgid / nig, fm = gid * 8, gsz = (nM - fm) < 8 ? (nM - fm) : 8;
    pm = fm + ((wgid % nig) % gsz); pn = (wgid % nig) / gsz;
}
typedef int v8i_t __attribute__((ext_vector_type(8)));
typedef int v4i_t __attribute__((ext_vector_type(4)));
__device__ __forceinline__ v8i_t cat8(bf16x8 lo, bf16x8 hi) { return __builtin_shufflevector(__builtin_bit_cast(v4i_t, lo), __builtin_bit_cast(v4i_t, hi), 0, 1, 2, 3, 4, 5, 6, 7); }
__device__ __forceinline__ void mfma_f8(f32x4& acc, v8i_t a, v8i_t b) { asm("s_nop 1\n\tv_mfma_f32_16x16x128_f8f6f4 %0, %1, %2, %0" : "+v"(acc) : "v"(a), "v"(b)); }
template <class Epi, class Sched, bool ALIGN_EPI, bool SP2, bool F8 = false, int PM = 0>
__device__ __forceinline__ void gemm_phase(LAS unsigned char* lds, const int K, const Sched& S, const Epi& E) {
    constexpr int ES = F8 ? 1 : 2;
    int tid = threadIdx.x; asm volatile("" : "+v"(tid));
    const int wid = __builtin_amdgcn_readfirstlane(tid >> 6), lane = tid & 63, wr = wid >> 2, wc = wid & 3, fr = lane & 15, fq = lane >> 4;
    const int nt = (PM == 2) ? 4 : K * ES / 128;
    unsigned voffB[2];
#pragma unroll
    for (int i = 0; i < 2; ++i) { int R, Cc; stage_map<F8>(tid * 16 + i * 8192, R, Cc); const int Rb = (Epi::PERM == 1) ? ((R & ~31) + perm32(R & 31)) : (Epi::PERM == 2) ? (64 * (R >> 5) + 16 * ((R >> 2) & 3) + 4 * ((R >> 4) & 1) + (R & 3)) : R;
        voffB[i] = (unsigned)(Rb * K * ES + Cc * 2); }
#define PG8_LOAD_IDS(U) do { int tz_ = threadIdx.x; asm volatile("" : "+v"(tz_)); int R0_, C0_, R1_, C1_; stage_map<F8>(tz_ * 16, R0_, C0_); stage_map<F8>(tz_ * 16 + 8192, R1_, C1_); \
        id00 = S.rowid(U, R0_); id01 = S.rowid(U, R1_); id10 = S.rowid(U, HALF + R0_); id11 = S.rowid(U, HALF + R1_); } while (0)
#define PG8_IDS_TO_VA() do { int tz_ = threadIdx.x; asm volatile("" : "+v"(tz_)); int R0_, C0_, R1_, C1_; stage_map<F8>(tz_ * 16, R0_, C0_); stage_map<F8>(tz_ * 16 + 8192, R1_, C1_); \
        va00 = S.idoff(id00) + (unsigned)C0_ * 2u; va01 = S.idoff(id01) + (unsigned)C1_ * 2u; va10 = S.idoff(id10) + (unsigned)C0_ * 2u; va11 = S.idoff(id11) + (unsigned)C1_ * 2u; } while (0)
    const size_t kstep = (size_t)(BK * 2);
    const size_t hstepB = (size_t)(Epi::PERM == 2 ? 8 : HALF) * K * ES;
    const unsigned ldsw = (unsigned)wid * 1024u;
    const int aoff = F8 ? ((wr * 64 + fr) * 128 + 16 * ((2 * fq) ^ h8((fr >> 1) & 7))) : lds_byte(wr * 64 + fr, fq * 8), boff = F8 ? ((wc * 32 + fr) * 128 + 16 * ((2 * fq) ^ h8((fr >> 1) & 7))) : lds_byte(wc * 32 + fr, fq * 8);
    const int aoff1 = F8 ? (aoff ^ 16) : (aoff + 1024), boff1 = F8 ? (boff ^ 16) : (boff + 1024);
#define PG8_SA(b, h) (((b) * 2 + (h)) * HTB)
#define PG8_SB(b, h) ((4 + (b) * 2 + (h)) * HTB)
#define PG8_STAGE2(bufoff, gbase, v0, v1) do { \
        __builtin_amdgcn_global_load_lds((const unsigned*)((const unsigned char*)(gbase) + (v0)), (LAS unsigned*)(lds + (bufoff) + ldsw), 16, 0, 0); \
        __builtin_amdgcn_global_load_lds((const unsigned*)((const unsigned char*)(gbase) + (v1)), (LAS unsigned*)(lds + (bufoff) + ldsw + 8192), 16, 0, 0); } while (0)
#define PG8_STAGE_B(bufoff, gbase) PG8_STAGE2(bufoff, gbase, voffB[0], voffB[1])
#define PG8_LDA(dst, b, h) do { _Pragma("unroll") for (int m = 0; m < 4; ++m) _Pragma("unroll") for (int k = 0; k < 2; ++k) dst[m][k] = *(const LAS bf16x8*)(lds + PG8_SA(b, h) + (k ? aoff1 : aoff) + m * 2048); } while (0)
#define PG8_LDB(dst, b, h) do { _Pragma("unroll") for (int n = 0; n < 2; ++n) _Pragma("unroll") for (int k = 0; k < 2; ++k) dst[n][k] = *(const LAS bf16x8*)(lds + PG8_SB(b, h) + (k ? boff1 : boff) + n * 2048); } while (0)
#define PG8_MMA(ai, bj, At, Bt) do { __builtin_amdgcn_s_setprio(1); if constexpr (F8) { _Pragma("unroll") for (int m = 0; m < 4; ++m) _Pragma("unroll") for (int n = 0; n < 2; ++n) \
        mfma_f8(acc[ai][bj][m][n], cat8(Bt[n][0], Bt[n][1]), cat8(At[m][0], At[m][1])); } else { \
        _Pragma("unroll") for (int m = 0; m < 4; ++m) _Pragma("unroll") for (int n = 0; n < 2; ++n) _Pragma("unroll") for (int k = 0; k < 2; ++k) \
        acc[ai][bj][m][n] = __builtin_amdgcn_mfma_f32_16x16x32_bf16(Bt[n][k], At[m][k], acc[ai][bj][m][n], 0, 0, 0); } __builtin_amdgcn_s_setprio(0); } while (0)
#define PG8_WAIT_V(n) asm volatile("s_waitcnt vmcnt(" #n ")" ::: "memory")
#define PG8_WAIT_L(n) asm volatile("s_waitcnt lgkmcnt(" #n ")" ::: "memory")
#define PG8_BAR __builtin_amdgcn_s_barrier()
#define PG8_SCHED __builtin_amdgcn_sched_barrier(0)
    GUnit cur, nxt; int ui = 0;
    if (!S.next(0, cur)) return;
    f32x4 acc[2][2][4][2];
#pragma unroll
    for (int a = 0; a < 2; ++a)
#pragma unroll
        for (int b = 0; b < 2; ++b)
#pragma unroll
            for (int m = 0; m < 4; ++m)
#pragma unroll
                for (int n = 0; n < 2; ++n) acc[a][b][m][n] = (f32x4){0.f, 0.f, 0.f, 0.f};
    bf16x8 At[4][2], B0[2][2], B1[2][2];
    const unsigned char* cA = cur.A; const unsigned char* cB = cur.B;
    unsigned va00, va01, va10, va11; int id00, id01, id10, id11; PG8_LOAD_IDS(cur); PG8_IDS_TO_VA();
    if constexpr (SP2) {
        PG8_STAGE_B(PG8_SB(0, 0), cB); PG8_STAGE_B(PG8_SB(0, 1), cB + hstepB); PG8_STAGE2(PG8_SA(0, 0), cA, va00, va01); PG8_STAGE2(PG8_SA(0, 1), cA, va10, va11);
        if (wr == 1) PG8_BAR;
        PG8_WAIT_V(2); PG8_BAR;
        PG8_STAGE_B(PG8_SB(1, 0), cB + kstep); PG8_STAGE2(PG8_SA(1, 0), cA + kstep, va00, va01); PG8_STAGE_B(PG8_SB(1, 1), cB + hstepB + kstep);
        PG8_WAIT_V(6); PG8_BAR;
    } else {
        PG8_STAGE_B(PG8_SB(0, 0), cB); PG8_STAGE2(PG8_SA(0, 0), cA, va00, va01); PG8_STAGE_B(PG8_SB(0, 1), cB + hstepB); PG8_STAGE2(PG8_SA(0, 1), cA, va10, va11);
        if (wr == 1) PG8_BAR;
        PG8_WAIT_V(4); PG8_BAR;
        PG8_STAGE_B(PG8_SB(1, 0), cB + kstep); PG8_STAGE2(PG8_SA(1, 0), cA + kstep, va00, va01); PG8_STAGE_B(PG8_SB(1, 1), cB + hstepB + kstep);
        PG8_WAIT_V(6); PG8_BAR;
    }
    for (;;) {
        const bool has_next = S.next(ui + 1, nxt);
        const unsigned char* nA = has_next ? nxt.A : cA; const unsigned char* nB = has_next ? nxt.B : cB;
        if (has_next) PG8_LOAD_IDS(nxt);
        for (int t = 0; t < nt; t += 2) {
            const bool last = (t == nt - 2);
            const unsigned char* a1 = cA + (size_t)(t + 1) * kstep;
            PG8_STAGE2(PG8_SA(1, 1), a1, va10, va11);
            if (last && has_next) PG8_IDS_TO_VA();
            const unsigned char* a2 = last ? nA : cA + (size_t)(t + 2) * kstep; const unsigned char* b2 = last ? nB : cB + (size_t)(t + 2) * kstep;
            const unsigned char* a3 = a2 + kstep; const unsigned char* b3 = b2 + kstep;
            if constexpr (SP2) {
            PG8_LDB(B0, 0, 0); PG8_LDB(B1, 0, 1); PG8_SCHED; PG8_LDA(At, 0, 0);
            PG8_WAIT_V(8); PG8_WAIT_L(0); PG8_BAR; PG8_MMA(0, 0, At, B0); PG8_MMA(0, 1, At, B1); PG8_BAR; PG8_SCHED;
            PG8_LDA(At, 0, 1); PG8_STAGE_B(PG8_SB(0, 0), b2); PG8_STAGE_B(PG8_SB(0, 1), b2 + hstepB); PG8_STAGE2(PG8_SA(0, 0), a2, va00, va01);
            PG8_WAIT_V(8); PG8_WAIT_L(0); PG8_BAR; PG8_MMA(1, 0, At, B0); PG8_MMA(1, 1, At, B1); PG8_BAR; PG8_SCHED;
            PG8_LDB(B0, 1, 0); PG8_LDB(B1, 1, 1); PG8_SCHED; PG8_LDA(At, 1, 0); PG8_STAGE2(PG8_SA(0, 1), a2, va10, va11);
            PG8_WAIT_V(8); PG8_WAIT_L(0); PG8_BAR; PG8_MMA(0, 0, At, B0); PG8_MMA(0, 1, At, B1); PG8_BAR; PG8_SCHED;
            PG8_LDA(At, 1, 1); PG8_STAGE_B(PG8_SB(1, 0), b3); PG8_STAGE_B(PG8_SB(1, 1), b3 + hstepB); PG8_STAGE2(PG8_SA(1, 0), a3, va00, va01);
            PG8_WAIT_V(8); PG8_WAIT_L(0); PG8_BAR; PG8_MMA(1, 0, At, B0); PG8_MMA(1, 1, At, B1); PG8_BAR; PG8_SCHED;
            } else {
            PG8_LDB(B0, 0, 0); PG8_SCHED; PG8_LDA(At, 0, 0);
            PG8_WAIT_L(8); PG8_BAR; PG8_WAIT_L(0); PG8_MMA(0, 0, At, B0); PG8_BAR; PG8_SCHED;
            PG8_LDB(B1, 0, 1); PG8_STAGE_B(PG8_SB(0, 0), b2);
            PG8_BAR; PG8_WAIT_L(0); PG8_MMA(0, 1, At, B1); PG8_BAR;
            PG8_LDA(At, 0, 1); PG8_STAGE2(PG8_SA(0, 0), a2, va00, va01);
            PG8_BAR; PG8_WAIT_L(0); PG8_MMA(1, 0, At, B0); PG8_BAR; PG8_SCHED;
            PG8_STAGE_B(PG8_SB(0, 1), b2 + hstepB);
            PG8_WAIT_V(6); PG8_BAR; PG8_MMA(1, 1, At, B1); PG8_BAR;
            PG8_LDB(B0, 1, 0); PG8_SCHED; PG8_LDA(At, 1, 0); PG8_STAGE2(PG8_SA(0, 1), a2, va10, va11);
            PG8_WAIT_L(8); PG8_BAR; PG8_WAIT_L(0); PG8_MMA(0, 0, At, B0); PG8_BAR; PG8_SCHED;
            PG8_LDB(B1, 1, 1); PG8_STAGE_B(PG8_SB(1, 0), b3);
            PG8_BAR; PG8_WAIT_L(0); PG8_MMA(0, 1, At, B1); PG8_BAR;
            PG8_LDA(At, 1, 1); PG8_STAGE2(PG8_SA(1, 0), a3, va00, va01);
            PG8_BAR; PG8_WAIT_L(0); PG8_MMA(1, 0, At, B0); PG8_BAR; PG8_SCHED;
            PG8_STAGE_B(PG8_SB(1, 1), b3 + hstepB);
            PG8_WAIT_V(6); PG8_BAR; PG8_MMA(1, 1, At, B1); PG8_BAR;
            }
        }
        if constexpr (ALIGN_EPI) { if (wr == 0) PG8_BAR; }
        if constexpr (F8) { PG8_SCHED; asm volatile("s_nop 15" ::: "memory"); PG8_SCHED; }
        if constexpr (PM != 1) E(acc, cur, wr, wc, fr, fq);
        if (!has_next) break;
#pragma unroll
        for (int a = 0; a < 2; ++a)
#pragma unroll
            for (int b = 0; b < 2; ++b)
#pragma unroll
                for (int m = 0; m < 4; ++m)
#pragma unroll
                    for (int n = 0; n < 2; ++n) acc[a][b][m][n] = (f32x4){0.f, 0.f, 0.f, 0.f};
        cur = nxt; cA = nA; cB = nB; ++ui;
        if constexpr (ALIGN_EPI) { if (wr == 1) PG8_BAR; }
    }
    PG8_WAIT_V(0);
    if constexpr (!ALIGN_EPI) { if (wr == 0) PG8_BAR; }
    PG8_BAR;
#undef PG8_SA
#undef PG8_SB
#undef PG8_STAGE2
#undef PG8_STAGE_B
#undef PG8_LOAD_IDS
#undef PG8_IDS_TO_VA
#undef PG8_LDA
#undef PG8_LDB
#undef PG8_MMA
#undef PG8_WAIT_V
#undef PG8_WAIT_L
#undef PG8_BAR
#undef PG8_SCHED
}
typedef f32x4 AccT[2][2][4][2];
struct EpiBf16 {
    static constexpr int PERM = 1;
    bf16_t* O; int ldc; const float* bias;
    __device__ __forceinline__ void operator()(const AccT& acc, const GUnit& u, int wr, int wc, int fr, int fq) const {
        const int row0 = u.row0 + wr * 64 + fr, col0 = u.col0 + wc * 32 + 8 * fq;
        f32x4 bv[2][2];
#pragma unroll
        for (int bj = 0; bj < 2; ++bj)
#pragma unroll
            for (int n = 0; n < 2; ++n) bv[bj][n] = bias ? *(const f32x4*)(bias + col0 + bj * HALF + 4 * n) : (f32x4){0.f, 0.f, 0.f, 0.f};
#pragma unroll
        for (int ai = 0; ai < 2; ++ai)
#pragma unroll
            for (int m = 0; m < 4; ++m) { bf16_t* rowp = O + (size_t)(row0 + ai * HALF + m * 16) * ldc + col0;
#pragma unroll
                for (int bj = 0; bj < 2; ++bj) { const f32x4 v0 = acc[ai][bj][m][0] + bv[bj][0], v1 = acc[ai][bj][m][1] + bv[bj][1];
                    *(u32x4*)(rowp + bj * HALF) = (u32x4){pk2(v0[0], v0[1]), pk2(v0[2], v0[3]), pk2(v1[0], v1[1]), pk2(v1[2], v1[3])}; } }
    }
};
struct EpiBf16Rs {
    static constexpr int PERM = 1;
    bf16_t* O; int ldc; const float* rs;
    __device__ __forceinline__ void operator()(const AccT& acc, const GUnit& u, int wr, int wc, int fr, int fq) const {
        const int row0 = u.row0 + wr * 64 + fr, col0 = u.col0 + wc * 32 + 8 * fq;
#pragma unroll
        for (int ai = 0; ai < 2; ++ai)
#pragma unroll
            for (int m = 0; m < 4; ++m) { const int row = row0 + ai * HALF + m * 16; const float sc = rs[row]; bf16_t* rowp = O + (size_t)row * ldc + col0;
#pragma unroll
                for (int bj = 0; bj < 2; ++bj) { const f32x4 v0 = acc[ai][bj][m][0] * sc, v1 = acc[ai][bj][m][1] * sc;
                    *(u32x4*)(rowp + bj * HALF) = (u32x4){pk2(v0[0], v0[1]), pk2(v0[2], v0[3]), pk2(v1[0], v1[1]), pk2(v1[2], v1[3])}; } }
    }
};
struct EpiResF32 {
    static constexpr int PERM = 0;
    const float* xin; float* out; int ldc; float ascale;
    __device__ __forceinline__ void operator()(const AccT& acc, const GUnit& u, int wr, int wc, int fr, int fq) const {
        const int row0 = u.row0 + wr * 64 + fr, col0 = u.col0 + wc * 32 + 4 * fq;
#pragma unroll
        for (int ai = 0; ai < 2; ++ai)
#pragma unroll
            for (int m = 0; m < 4; ++m) { const size_t off = (size_t)(row0 + ai * HALF + m * 16) * ldc + col0;
#pragma unroll
                for (int bj = 0; bj < 2; ++bj)
#pragma unroll
                    for (int n = 0; n < 2; ++n) { const f32x4 b = *(const f32x4*)(xin + off + bj * HALF + n * 16); *(f32x4*)(out + off + bj * HALF + n * 16) = b + acc[ai][bj][m][n] * ascale; }
                asm volatile("" ::: "memory"); }
    }
};
struct EpiResBf16 {
    static constexpr int PERM = 1;
    const float* xin32; const bf16_t* xin16; bf16_t* out;
    __device__ __forceinline__ void operator()(const AccT& acc, const GUnit& u, int wr, int wc, int fr, int fq) const {
        const int row0 = u.row0 + wr * 64 + fr, col0 = u.col0 + wc * 32 + 8 * fq;
#pragma unroll
        for (int ai = 0; ai < 2; ++ai)
#pragma unroll
            for (int m = 0; m < 4; ++m) { const size_t off = (size_t)(row0 + ai * HALF + m * 16) * 1024 + col0;
#pragma unroll
                for (int bj = 0; bj < 2; ++bj) { f32x4 v0 = acc[ai][bj][m][0], v1 = acc[ai][bj][m][1];
                    if (xin32) { v0 += *(const f32x4*)(xin32 + off + bj * HALF); v1 += *(const f32x4*)(xin32 + off + bj * HALF + 4); }
                    else { const u32x4 w = *(const u32x4*)(xin16 + off + bj * HALF); v0 += (f32x4){bflo(w.x), bfhi(w.x), bflo(w.y), bfhi(w.y)}; v1 += (f32x4){bflo(w.z), bfhi(w.z), bflo(w.w), bfhi(w.w)}; }
                    *(u32x4*)(out + off + bj * HALF) = (u32x4){pk2(v0[0], v0[1]), pk2(v0[2], v0[3]), pk2(v1[0], v1[1]), pk2(v1[2], v1[3])}; }
                asm volatile("" ::: "memory"); }
    }
};
struct EpiGlu {
    static constexpr int PERM = 1;
    bf16_t* act; const float* bgu_l;
    __device__ __forceinline__ void operator()(const AccT& acc, const GUnit& u, int wr, int wc, int fr, int fq) const {
        const int row0 = u.row0 + wr * 64 + fr, j0 = (u.col0 >> 1) + wc * 32 + 8 * fq;
        const float* bg = bgu_l + (size_t)u.e * 2048 + 2 * j0;
        f32x4 b0 = *(const f32x4*)(bg), b1 = *(const f32x4*)(bg + 4), b2 = *(const f32x4*)(bg + 8), b3 = *(const f32x4*)(bg + 12);
        const float bgl[8] = {b0[0], b0[2], b1[0], b1[2], b2[0], b2[2], b3[0], b3[2]}, bll[8] = {b0[1], b0[3], b1[1], b1[3], b2[1], b2[3], b3[1], b3[3]};
#pragma unroll
        for (int ai = 0; ai < 2; ++ai)
#pragma unroll
            for (int m = 0; m < 4; ++m) { float r[8];
#pragma unroll
                for (int n = 0; n < 2; ++n)
#pragma unroll
                    for (int i = 0; i < 4; ++i) { const float vg = acc[ai][0][m][n][i] + bgl[4 * n + i], vl = acc[ai][1][m][n][i] + bll[4 * n + i];
                        const float xg = fminf(vg, 7.f), xl = fminf(fmaxf(vl, -7.f), 7.f);
                        r[4 * n + i] = xg * (xl + 1.f) * __builtin_amdgcn_rcpf(1.f + __builtin_amdgcn_exp2f(-2.4554669595930156f * xg)); }
                *(u32x4*)(act + (size_t)(row0 + ai * HALF + m * 16) * 1024 + j0) = (u32x4){pk2(r[0], r[1]), pk2(r[2], r[3]), pk2(r[4], r[5]), pk2(r[6], r[7])}; }
    }
};
constexpr float W8_SCALE = 32.f, W8_INV = 1.f / 32.f;
struct EpiGlu8 {
    static constexpr int PERM = 1;
    unsigned char* act; const float* bgu_l; LAS const float* btab; int nbt;
    __device__ __forceinline__ void operator()(const AccT& acc, const GUnit& u, int wr, int wc, int fr, int fq) const {
        const int row0 = u.row0 + wr * 64 + fr, j0 = (u.col0 >> 1) + wc * 32 + 8 * fq;
        f32x4 b0, b1, b2, b3;
        const int ui_ = u.aux >> 16;
        if (ui_ < nbt) { const LAS float* bl = btab + ui_ * 256 + 2 * (wc * 32 + 8 * fq); b0 = *(const LAS f32x4*)(bl); b1 = *(const LAS f32x4*)(bl + 4); b2 = *(const LAS f32x4*)(bl + 8); b3 = *(const LAS f32x4*)(bl + 12); }
        else { const float* bg = bgu_l + (size_t)u.e * 2048 + 2 * j0; b0 = *(const f32x4*)(bg); b1 = *(const f32x4*)(bg + 4); b2 = *(const f32x4*)(bg + 8); b3 = *(const f32x4*)(bg + 12); }
        const f32x2 bgp[4] = {(f32x2){b0[0], b0[2]}, (f32x2){b1[0], b1[2]}, (f32x2){b2[0], b2[2]}, (f32x2){b3[0], b3[2]}};
        const f32x2 blp[4] = {(f32x2){b0[1] + 1.f, b0[3] + 1.f}, (f32x2){b1[1] + 1.f, b1[3] + 1.f}, (f32x2){b2[1] + 1.f, b2[3] + 1.f}, (f32x2){b3[1] + 1.f, b3[3] + 1.f}};
#pragma unroll
        for (int ai = 0; ai < 2; ++ai)
#pragma unroll
            for (int m = 0; m < 4; ++m) { f32x2 r[4];
#pragma unroll
                for (int n = 0; n < 2; ++n)
#pragma unroll
                    for (int hp = 0; hp < 2; ++hp) { const f32x2 ag = (f32x2){acc[ai][0][m][n][2 * hp], acc[ai][0][m][n][2 * hp + 1]}, al = (f32x2){acc[ai][1][m][n][2 * hp], acc[ai][1][m][n][2 * hp + 1]};
                        f32x2 vg = ag * W8_INV + bgp[2 * n + hp], vl = al * W8_INV + blp[2 * n + hp];
                        vg.x = fminf(vg.x, 7.f); vg.y = fminf(vg.y, 7.f); vl.x = __builtin_amdgcn_fmed3f(vl.x, -6.f, 8.f); vl.y = __builtin_amdgcn_fmed3f(vl.y, -6.f, 8.f);
                        const f32x2 t = vg * -2.4554669595930156f; f32x2 d; d.x = __builtin_amdgcn_exp2f(t.x); d.y = __builtin_amdgcn_exp2f(t.y); d = d + 1.f;
                        f32x2 rc; rc.x = __builtin_amdgcn_rcpf(d.x); rc.y = __builtin_amdgcn_rcpf(d.y);
                        r[2 * n + hp] = (vg * vl) * rc; }
                *(u32x2*)(act + (size_t)(row0 + ai * HALF + m * 16) * 1024 + j0) = (u32x2){pk4_fp8(r[0].x, r[0].y, r[1].x, r[1].y), pk4_fp8(r[2].x, r[2].y, r[3].x, r[3].y)}; }
    }
};
struct EpiDown {
    static constexpr int PERM = 1;
    bf16_t* yb; const float* bdn_l; const float* lgate; LAS const int* cnt; float ascale;
    __device__ __forceinline__ void operator()(const AccT& acc, const GUnit& u, int wr, int wc, int fr, int fq) const {
        const int rl0 = wr * 64 + fr, col0 = u.col0 + wc * 32 + 8 * fq; const int n_valid = __builtin_amdgcn_readfirstlane(cnt[u.e]);
        const float* bd = bdn_l + (size_t)u.e * 1024 + col0;
        f32x4 bv[2][2];
#pragma unroll
        for (int bj = 0; bj < 2; ++bj)
#pragma unroll
            for (int n = 0; n < 2; ++n) bv[bj][n] = *(const f32x4*)(bd + bj * HALF + 4 * n);
#pragma unroll
        for (int ai = 0; ai < 2; ++ai)
#pragma unroll
            for (int m = 0; m < 4; ++m) { const int rl = rl0 + ai * HALF + m * 16, li = u.aux + rl; const float g = (li < n_valid) ? lgate[(size_t)u.e * T + li] : 0.f;
                bf16_t* rowp = yb + (size_t)(u.row0 + rl) * 1024 + col0;
#pragma unroll
                for (int bj = 0; bj < 2; ++bj) { const f32x4 v0 = (acc[ai][bj][m][0] * ascale + bv[bj][0]) * g, v1 = (acc[ai][bj][m][1] * ascale + bv[bj][1]) * g;
                    *(u32x4*)(rowp + bj * HALF) = (u32x4){pk2(v0[0], v0[1]), pk2(v0[2], v0[3]), pk2(v1[0], v1[1]), pk2(v1[2], v1[3])}; } }
    }
};
constexpr float YB_SCALE = 8.f;
struct EpiDown8 {
    static constexpr int PERM = 2;
    unsigned char* yb; const float* bdn_l; LAS const float* btab; int nbt;
    __device__ __forceinline__ void operator()(const AccT& acc, const GUnit& u, int wr, int wc, int fr, int fq) const {
        const int rl0 = wr * 64 + fr, col0 = u.col0 + wc * 64 + 16 * fq;
        const float* bd = bdn_l + (size_t)u.e * 1024 + col0;
        f32x4 bv[2][2]; const int ui_ = u.aux >> 16;
        if (ui_ < nbt) { const LAS float* bl = btab + ui_ * 256 + wc * 64 + 16 * fq;
#pragma unroll
            for (int bj = 0; bj < 2; ++bj)
#pragma unroll
                for (int n = 0; n < 2; ++n) bv[bj][n] = *(const LAS f32x4*)(bl + 8 * bj + 4 * n) * YB_SCALE; }
        else {
#pragma unroll
        for (int bj = 0; bj < 2; ++bj)
#pragma unroll
            for (int n = 0; n < 2; ++n) bv[bj][n] = *(const f32x4*)(bd + 8 * bj + 4 * n) * YB_SCALE; }
#pragma unroll
        for (int ai = 0; ai < 2; ++ai)
#pragma unroll
            for (int m = 0; m < 4; ++m) { const int rl = rl0 + ai * HALF + m * 16;
                u32x4 o;
#pragma unroll
                for (int bj = 0; bj < 2; ++bj)
#pragma unroll
                    for (int n = 0; n < 2; ++n) { const f32x4 v = acc[ai][bj][m][n] * (W8_INV * YB_SCALE) + bv[bj][n]; o[2 * bj + n] = pk4_fp8(v[0], v[1], v[2], v[3]); }
                *(u32x4*)(yb + (size_t)(u.row0 + rl) * 1024 + col0) = o; }
    }
};
struct DenseSched {
    const unsigned char* A; const unsigned char* Bt; int lda, K, nM, nN, G, c, es;
    __device__ __forceinline__ bool next(int i, GUnit& u) const { const int L = i * G + c; if (L >= nM * nN) return false; int pm, pn; tile_of(L, nM, nN, pm, pn);
        u.A = A + (size_t)pm * 256 * lda * es; u.B = Bt + (size_t)pn * 256 * K * es; u.row0 = pm * 256; u.col0 = pn * 256; u.e = 0; u.aux = 0; return true; }
    __device__ __forceinline__ int rowid(const GUnit&, int R) const { return R; }
    __device__ __forceinline__ unsigned idoff(int id) const { return (unsigned)(id * lda * es); }
};
template <bool GATHER, int RB> struct MoeSched {
    const unsigned char* A; const unsigned char* Wt; const int* ltok; LAS const int* ctl; int nN, G, c;
    LAS const unsigned short* tokt; int ntab; int fix;
    __device__ __forceinline__ bool locate(int i, int& pm, int& pn, int& e, int& rb) const { const int nM = __builtin_amdgcn_readfirstlane(ctl[32 + NEXP]); const int L = i * G + c; if (L >= nM * nN) return false; tile_of(L, nM, nN, pm, pn);
        e = 0;
        for (int k = 1; k < NEXP; ++k) e += (__builtin_amdgcn_readfirstlane(ctl[32 + k]) <= pm) ? 1 : 0;
        rb = __builtin_amdgcn_readfirstlane(ctl[32 + e]); return true; }
    __device__ __forceinline__ bool next(int i, GUnit& u) const { int pm, pn, e, rb; if (!locate(i, pm, pn, e, rb)) return false;
        u.A = GATHER ? A : A + (size_t)((fix & 2) ? 0 : pm) * 256 * RB; u.B = Wt + ((size_t)((fix & 1) ? 0 : e) * nN + ((fix & 1) ? 0 : pn)) * 256 * RB;   u.row0 = pm * 256; u.col0 = pn * 256; u.e = e; u.aux = (i << 16) | (pm - rb); return true; }
    __device__ __forceinline__ int rowid(const GUnit& u, int R) const {
        if (GATHER) return (int)tokt[(u.aux >> 16) * 256 + R];
        return R; }
    __device__ __forceinline__ unsigned idoff(int id) const { return (unsigned)id * (unsigned)RB; }
};
}

__device__ __forceinline__ void moe_tables(const Ctx& C, int l) {
    LAS int* ctl = (LAS int*)(C.lds + LDS_CTL);
    __syncthreads();
    if (C.tid < NEXP) ctl[C.tid] = (int)__hip_atomic_load(WSP(unsigned, WS_CTL) + CW_GCNT + (l * NEXP + C.tid) * 64, __ATOMIC_RELAXED, __HIP_MEMORY_SCOPE_AGENT);
    __syncthreads();
    if (C.tid == 0) { int a = 0; for (int e = 0; e < NEXP; ++e) { ctl[32 + e] = a; a += (ctl[e] + 255) >> 8; } ctl[32 + NEXP] = a; }
    __syncthreads();
}
__device__ __forceinline__ int moe_find_expert(const Ctx& C, int rt) {
    LAS int* ctl = (LAS int*)(C.lds + LDS_CTL);
    int e = 0;
    for (int k = 1; k < NEXP; ++k) e += (ctl[32 + k] <= rt) ? 1 : 0;
    return e;
}

__device__ __forceinline__ void ph_inproj(const Ctx& C, int l) {
    const bf16_t* hb = WSP(bf16_t, WS_HB); const bf16_t* W = WSP(bf16_t, WS_WIN) + (size_t)l * DINP * 1024; bf16_t* z = WSP(bf16_t, WS_Z);
    for (int u = C.bid; u < 256 * 10; u += C.G) { const int rt = u / 10, ct = u % 10;
        sg_tile<1>(C, [&](int r) { return hb + (size_t)(rt * 128 + r) * 1024; }, W + (size_t)ct * 128 * 1024, nullptr, 1024,
                   [&](int r, int c, float v, float) { z[(size_t)(rt * 128 + r) * DINP + ct * 128 + c] = (bf16_t)f2bf(v); });
    }
}
template <int SKIP = 0> __device__ __forceinline__ void ph_mix1(const Ctx& C, int l) {
    const bf16_t* z = WSP(bf16_t, WS_Z); bf16_t* A2 = WSP(bf16_t, WS_A2);
    LAS float* vs = (LAS float*)C.lds;
    LAS float* dw = (LAS float*)(C.lds + 62 * 256 * 4);
    const int tid = C.tid, c = tid & 255, half = tid >> 8;
    float wj[31];
#pragma unroll
    for (int j = 0; j < 31; ++j) wj[j] = WSP(float, WS_PAR)[P_CDW + (l * 31 + j) * 256 + c];
    const float cb = WSP(float, WS_PAR)[P_CDWB + l * 256 + c];
    u32x4 ga[4], gg[4];
#define MIX1_LOAD(TILE) do { const int tok0_ = (TILE) * 32, s0_ = tok0_ % SEQ; _Pragma("unroll") for (int p = 0; p < 4; ++p) { const int row = p * 16 + (tid >> 5), ch8 = (tid & 31) * 8; const int srow = s0_ - 30 + row; \
              if (row < 62 && srow >= 0) { const bf16_t* zr = z + (size_t)(tok0_ - 30 + row) * DINP; ga[p] = *(const u32x4*)(zr + 256 + ch8); gg[p] = *(const u32x4*)(zr + 512 + ch8); } \
              else { ga[p] = (u32x4){0u, 0u, 0u, 0u}; gg[p] = (u32x4){0u, 0u, 0u, 0u}; } } } while (0)
    if (C.bid < T / 32 && !(SKIP & 4)) MIX1_LOAD(C.bid);
    for (int tile = C.bid; tile < T / 32; tile += C.G) {
        const int tok0 = tile * 32, s0 = tok0 % SEQ;
        if (!(SKIP & 4)) {
#pragma unroll
          for (int p = 0; p < 4; ++p) { const int row = p * 16 + (tid >> 5), ch8 = (tid & 31) * 8;
              if (row < 62) { const u32x4 a = ga[p], g = gg[p]; float v[8];
                  v[0] = bflo(a.x) * sigmoidf_(bflo(g.x)); v[1] = bfhi(a.x) * sigmoidf_(bfhi(g.x)); v[2] = bflo(a.y) * sigmoidf_(bflo(g.y)); v[3] = bfhi(a.y) * sigmoidf_(bfhi(g.y));
                  v[4] = bflo(a.z) * sigmoidf_(bflo(g.z)); v[5] = bfhi(a.z) * sigmoidf_(bfhi(g.z)); v[6] = bflo(a.w) * sigmoidf_(bflo(g.w)); v[7] = bfhi(a.w) * sigmoidf_(bfhi(g.w));
                  *(LAS f32x4*)(vs + row * 256 + ch8) = (f32x4){v[0], v[1], v[2], v[3]}; *(LAS f32x4*)(vs + row * 256 + ch8 + 4) = (f32x4){v[4], v[5], v[6], v[7]}; } }
          if (tile + C.G < T / 32) MIX1_LOAD(tile + C.G); }
        __syncthreads();
        if (!(SKIP & 2)) { float vv[46];
#pragma unroll
            for (int r = 0; r < 46; ++r) vv[r] = vs[(half * 16 + r) * 256 + c];
#pragma unroll
            for (int i = 0; i < 16; ++i) { float acc = cb;
#pragma unroll
                for (int j = 0; j < 31; ++j) acc += vv[i + j] * wj[j];
                dw[(half * 16 + i) * 256 + c] = acc; } }
        __syncthreads();
        if (!(SKIP & 8)) for (int q = 0; q < 4; ++q) { const int tl = C.wave * 4 + q, ch = C.lane * 4;
            const f32x4 x = *(const LAS f32x4*)(dw + tl * 256 + ch);
            const float mean = wave_sum((x.x + x.y) + (x.z + x.w)) * (1.f / 256.f);
            const f32x4 d = x - mean;
            const float var = wave_sum((d.x * d.x + d.y * d.y) + (d.z * d.z + d.w * d.w)) * (1.f / 256.f);
            const float rstd = rsqrtf(var + EPS);
            const f32x4 g = *(const f32x4*)(WSP(float, WS_PAR) + P_CLNG + l * 256 + ch), b = *(const f32x4*)(WSP(float, WS_PAR) + P_CLNB + l * 256 + ch);
            f32x4 y = d * rstd * g + b;
            y.x *= sigmoidf_(y.x); y.y *= sigmoidf_(y.y); y.z *= sigmoidf_(y.z); y.w *= sigmoidf_(y.w);
            *(u32x2*)(A2 + (size_t)(tok0 + tl) * 512 + 256 + ch) = (u32x2){pk2(y.x, y.y), pk2(y.z, y.w)}; }
        if (!(SKIP & 1)) { const int cp = tid & 127, tg = tid >> 7, g = cp >> 5, tf = s0 + tg * 8; const bf16_t* zc = z + (size_t)(tok0 - s0) * DINP + 2 * cp;
          float u0[23], u1[23];
#pragma unroll
          for (int d = 0; d < 23; ++d) { const int sq = tf - 15 + d; const unsigned wv = (sq >= 0) ? *(const unsigned*)(zc + (size_t)sq * DINP) : 0u; u0[d] = bflo(wv); u1[d] = bfhi(wv); }
          bf16_t* ao = A2 + (size_t)(tok0 - s0 + tf) * 512 + 2 * cp;
#define POOL_W(W) do { _Pragma("unroll") for (int i = 0; i < 8; ++i) { float sa = 0.f, sb = 0.f; _Pragma("unroll") for (int d = 0; d < (W); ++d) { sa += u0[15 + i - d]; sb += u1[15 + i - d]; } \
              const int sq = tf + i; const int cnt = (sq + 1 < (W)) ? (sq + 1) : (W); const float rc = __builtin_amdgcn_rcpf((float)cnt); \
              *(unsigned*)(ao + (size_t)i * 512) = pk2(sa * rc - u0[15 + i], sb * rc - u1[15 + i]); } } while (0)
          if (g == 0) POOL_W(2); else if (g == 1) POOL_W(4); else if (g == 2) POOL_W(8); else POOL_W(16);
#undef POOL_W
        }
        __syncthreads();
    }
#undef MIX1_LOAD
}
__device__ __forceinline__ void ph_smallgemm(const Ctx& C, int l) {
    const bf16_t* z = WSP(bf16_t, WS_Z); const bf16_t* A2 = WSP(bf16_t, WS_A2);
    const bf16_t* Wm = WSP(bf16_t, WS_WMIX) + (size_t)l * 512 * 512; const bf16_t* Wq = WSP(bf16_t, WS_WQ) + (size_t)l * 768 * 256; const bf16_t* Wkv = WSP(bf16_t, WS_WKV) + (size_t)l * 1024 * 256;
    bf16_t* ymix = WSP(bf16_t, WS_YMIX); bf16_t* qraw = WSP(bf16_t, WS_QRAW); bf16_t* kvraw = WSP(bf16_t, WS_KVRAW);
    const float* pwb = WSP(float, WS_PAR) + P_CPWB + l * 256;
    for (int u = C.bid; u < 256 * (4 + 6 + 8); u += C.G) { const int rt = u / 18, q = u % 18;
        if (q < 4) { const int ct = q;
            sg_tile<1>(C, [&](int r) { return A2 + (size_t)(rt * 128 + r) * 512; }, Wm + (size_t)ct * 128 * 512, nullptr, 512,
                       [&](int r, int c, float v, float) { const int col = ct * 128 + c; if (col >= 256) v += pwb[col - 256]; ymix[(size_t)(rt * 128 + r) * 512 + col] = (bf16_t)f2bf(v); });
        } else if (q < 10) { const int ct = q - 4;
            sg_tile<1>(C, [&](int r) { return z + (size_t)(rt * 128 + r) * DINP + 768; }, Wq + (size_t)ct * 128 * 256, nullptr, 256,
                       [&](int r, int c, float v, float) { qraw[(size_t)(rt * 128 + r) * 768 + ct * 128 + c] = (bf16_t)f2bf(v); });
        } else { const int ct = q - 10;
            sg_tile<1>(C, [&](int r) { return z + (size_t)(rt * 128 + r) * DINP + 1024; }, Wkv + (size_t)ct * 128 * 256, nullptr, 256,
                       [&](int r, int c, float v, float) { kvraw[(size_t)(rt * 128 + r) * 1024 + ct * 128 + c] = (bf16_t)f2bf(v); });
        }
    }
}
struct QkIn { u32x2 cq; unsigned ckv; f32x2 cs0, cs1; u32x4 qa; unsigned qp1, qp2; u32x4 ka; unsigned kp1, kp2; u32x4 vv; };
__device__ __forceinline__ QkIn qk_load(const Ctx& C, int t, int lane) {
    const bf16_t* zr = WSP(bf16_t, WS_Z) + (size_t)t * DINP; const int h = lane >> 4, l16 = lane & 15;
    const bf16_t* qr = WSP(bf16_t, WS_QRAW) + (size_t)t * 768 + 192 * h; const bf16_t* kr = WSP(bf16_t, WS_KVRAW) + (size_t)t * 1024 + 256 * h; const f32x2* cs = WSP(f32x2, WS_COS) + (size_t)t * 32 + 2 * l16;
    QkIn r; r.cq = *(const u32x2*)(zr + 768 + 4 * lane); r.ckv = *(const unsigned*)(zr + 1024 + 2 * lane); r.cs0 = cs[0]; r.cs1 = cs[1];
    r.qa = *(const u32x4*)(qr + 8 * l16); r.qp1 = *(const unsigned*)(qr + 128 + 2 * l16); r.qp2 = *(const unsigned*)(qr + 160 + 2 * l16);
    r.ka = *(const u32x4*)(kr + 8 * l16); r.kp1 = *(const unsigned*)(zr + 1152 + 2 * l16); r.kp2 = *(const unsigned*)(zr + 1184 + 2 * l16); r.vv = ATT_PV8 ? (u32x4){0u, 0u, 0u, 0u} : *(const u32x4*)(kr + 128 + 8 * l16);
    return r;
}
template <int SKIP = 0> __device__ __forceinline__ void ph_qkfin(const Ctx& C, int l) {
    bf16_t* Qb = WSP(bf16_t, WS_Q);
    const int lane = C.lane, h = lane >> 4, l16 = lane & 15;
    const float* qg = WSP(float, WS_PAR) + P_QNG + l * 192; const float* kg = WSP(float, WS_PAR) + P_KNG + l * 192;
    float gq[12], gk[12];
#pragma unroll
    for (int i = 0; i < 8; ++i) { gq[i] = qg[8 * l16 + i]; gk[i] = kg[8 * l16 + i]; }
#pragma unroll
    for (int i = 0; i < 2; ++i) { gq[8 + i] = qg[128 + 2 * l16 + i]; gq[10 + i] = qg[160 + 2 * l16 + i]; gk[8 + i] = kg[128 + 2 * l16 + i]; gk[10 + i] = kg[160 + 2 * l16 + i]; }
    const int stride = C.G * NWAVE; int t = C.bid * NWAVE + C.wave;
    if (t >= T) return;
    QkIn cur = qk_load(C, t, lane), cur2 = cur;
    if (t + stride < T) cur2 = qk_load(C, t + stride, lane);
    for (; t < T; t += stride) {
        const QkIn in = cur; cur = cur2;
        if (t + 2 * stride < T) cur2 = qk_load(C, t + 2 * stride, lane);
        float rsq, rskv;
        { const float x0 = bflo(in.cq.x), x1 = bfhi(in.cq.x), x2 = bflo(in.cq.y), x3 = bfhi(in.cq.y);
          rsq = rsqrtf(wave_sum((x0 * x0 + x1 * x1) + (x2 * x2 + x3 * x3)) * (1.f / 256.f) + EPS); }
        { const float x0 = bflo(in.ckv), x1 = bfhi(in.ckv);
          rskv = rsqrtf(wave_sum(x0 * x0 + x1 * x1) * (1.f / 128.f) + EPS); }
        const f32x2 cs0 = in.cs0, cs1 = in.cs1;
        { const u32x4 a = in.qa; const unsigned p1 = in.qp1, p2 = in.qp2;
          float v[12] = {bflo(a.x), bfhi(a.x), bflo(a.y), bfhi(a.y), bflo(a.z), bfhi(a.z), bflo(a.w), bfhi(a.w), bflo(p1), bfhi(p1), bflo(p2), bfhi(p2)};
          float ss = 0.f;
#pragma unroll
          for (int i = 0; i < 12; ++i) { v[i] *= rsq; ss += v[i] * v[i]; }
          const float rh = rsqrtf(grp16_sum(ss) * (1.f / 192.f) + EPS);
#pragma unroll
          for (int i = 0; i < 12; ++i) v[i] *= rh * gq[i];
          const float o10 = v[8] * cs0.x - v[10] * cs0.y, o20 = v[10] * cs0.x + v[8] * cs0.y, o11 = v[9] * cs1.x - v[11] * cs1.y, o21 = v[11] * cs1.x + v[9] * cs1.y;
#if ATT_QK8
          unsigned char* qo = (unsigned char*)Qb + (size_t)t * 768 + 192 * h;
          if (!(SKIP & 4)) { *(u32x2*)(qo + 8 * l16) = (u32x2){pk4_fp8(v[0], v[1], v[2], v[3]), pk4_fp8(v[4], v[5], v[6], v[7])};
              *(unsigned*)(qo + 128 + 4 * l16) = pk4_fp8(o10, o11, o20, o21); } }
#else
          bf16_t* qo = Qb + (size_t)t * 768 + 192 * h;
          if (!(SKIP & 4)) { *(u32x4*)(qo + 8 * l16) = (u32x4){pk2(v[0], v[1]), pk2(v[2], v[3]), pk2(v[4], v[5]), pk2(v[6], v[7])};
              *(u32x2*)(qo + 128 + 4 * l16) = (u32x2){pk2(o10, o11), pk2(o20, o21)}; } }
#endif
        { const u32x4 a = in.ka; const unsigned p1 = in.kp1, p2 = in.kp2;
          float v[12] = {bflo(a.x) * rskv, bfhi(a.x) * rskv, bflo(a.y) * rskv, bfhi(a.y) * rskv, bflo(a.z) * rskv, bfhi(a.z) * rskv, bflo(a.w) * rskv, bfhi(a.w) * rskv, bflo(p1), bfhi(p1), bflo(p2), bfhi(p2)};
          float ss = 0.f;
#pragma unroll
          for (int i = 0; i < 12; ++i) ss += v[i] * v[i];
          const float rh = rsqrtf(grp16_sum(ss) * (1.f / 192.f) + EPS);
#pragma unroll
          for (int i = 0; i < 12; ++i) v[i] *= rh * gk[i];
          const float o10 = v[8] * cs0.x - v[10] * cs0.y, o20 = v[10] * cs0.x + v[8] * cs0.y, o11 = v[9] * cs1.x - v[11] * cs1.y, o21 = v[11] * cs1.x + v[9] * cs1.y;
#if ATT_QK8
          unsigned char* ko = C.ws + WS_KIMG + (size_t)t * 768 + 192 * h;
          if (!(SKIP & 1)) { *(u32x2*)(ko + 8 * l16) = (u32x2){pk4_fp8(v[0], v[1], v[2], v[3]), pk4_fp8(v[4], v[5], v[6], v[7])};
              *(unsigned*)(ko + 128 + 4 * l16) = pk4_fp8(o10, o11, o20, o21); }
#else
          bf16_t* ko = WSP(bf16_t, WS_KIMG) + (size_t)t * 768 + 192 * h;
          if (!(SKIP & 1)) { *(u32x4*)(ko + 8 * l16) = (u32x4){pk2(v[0], v[1]), pk2(v[2], v[3]), pk2(v[4], v[5]), pk2(v[6], v[7])};
              *(u32x2*)(ko + 128 + 4 * l16) = (u32x2){pk2(o10, o11), pk2(o20, o21)}; }
#endif
          const u32x4 vv = in.vv;
          if (!(SKIP & 2) && !ATT_PV8) *(u32x4*)(WSP(bf16_t, WS_VIMG) + (size_t)t * 512 + 128 * h + 8 * l16) = (u32x4){pk2(bflo(vv.x) * rskv, bfhi(vv.x) * rskv), pk2(bflo(vv.y) * rskv, bfhi(vv.y) * rskv), pk2(bflo(vv.z) * rskv, bfhi(vv.z) * rskv), pk2(bflo(vv.w) * rskv, bfhi(vv.w) * rskv)}; }
    }
}
#if ATT_PV8
__device__ __forceinline__ void ph_vtbuild(const Ctx& C, int l) {
    const bf16_t* z = WSP(bf16_t, WS_Z); const bf16_t* kv = WSP(bf16_t, WS_KVRAW); unsigned char* vt = C.ws + WS_VIMG;
    LAS unsigned* img = (LAS unsigned*)C.lds;
    LAS float* rsl = (LAS float*)(C.lds + 512 * 68);
    const int tid = C.tid, lane = C.lane, w = C.wave;
    __syncthreads();
    for (int it = C.bid; it < T / 64; it += C.G) { const int tok0 = it * 64;
        { const int tt = tid >> 3, part = tid & 7; const u32x4* cp = (const u32x4*)(z + (size_t)(tok0 + tt) * DINP + 1024 + 16 * part); const u32x4 a = cp[0], b = cp[1];
          float ss = bflo(a.x) * bflo(a.x) + bfhi(a.x) * bfhi(a.x) + bflo(a.y) * bflo(a.y) + bfhi(a.y) * bfhi(a.y) + bflo(a.z) * bflo(a.z) + bfhi(a.z) * bfhi(a.z) + bflo(a.w) * bflo(a.w) + bfhi(a.w) * bfhi(a.w)
                   + bflo(b.x) * bflo(b.x) + bfhi(b.x) * bfhi(b.x) + bflo(b.y) * bflo(b.y) + bfhi(b.y) * bfhi(b.y) + bflo(b.z) * bflo(b.z) + bfhi(b.z) * bfhi(b.z) + bflo(b.w) * bflo(b.w) + bfhi(b.w) * bfhi(b.w);
          ss += __shfl_xor(ss, 1); ss += __shfl_xor(ss, 2); ss += __shfl_xor(ss, 4);
          if (part == 0) rsl[tt] = rsqrtf(ss * (1.f / 128.f) + EPS); }
        unsigned u[8][4];
#pragma unroll
        for (int i = 0; i < 8; ++i) { const int pr = w + 8 * i, q = pr >> 2, hh = pr & 3;
#pragma unroll
            for (int k = 0; k < 4; ++k) u[i][k] = *(const unsigned*)(kv + (size_t)(tok0 + 4 * q + k) * 1024 + 256 * hh + 128 + 2 * lane); }
        __syncthreads();
#pragma unroll
        for (int i = 0; i < 8; ++i) { const int pr = w + 8 * i, q = pr >> 2, hh = pr & 3; const f32x4 rs = *(const LAS f32x4*)(rsl + 4 * q);
            img[(hh * 128 + 2 * lane) * 17 + q] = pk4_fp8(bflo(u[i][0]) * rs.x, bflo(u[i][1]) * rs.y, bflo(u[i][2]) * rs.z, bflo(u[i][3]) * rs.w);
            img[(hh * 128 + 2 * lane + 1) * 17 + q] = pk4_fp8(bfhi(u[i][0]) * rs.x, bfhi(u[i][1]) * rs.y, bfhi(u[i][2]) * rs.z, bfhi(u[i][3]) * rs.w); }
        __syncthreads();
#pragma unroll
        for (int k = 0; k < 4; ++k) { const int c = tid + 512 * k, row = c >> 2, pt = c & 3; const LAS unsigned* sp = img + row * 17 + 4 * pt;
            *(u32x4*)(vt + (size_t)it * 32768 + (size_t)c * 16) = (u32x4){sp[0], sp[1], sp[2], sp[3]}; }
        __syncthreads();
    }
}
#endif
typedef float f32x16 __attribute__((ext_vector_type(16)));
typedef short s16x4 __attribute__((ext_vector_type(4)));
constexpr int AT_KB = ATT_QK8 ? 12288 : 24576, AT_VB = ATT_PV8 ? 8192 : 16384, AT_NS = 3;
constexpr int AT_K = 0, AT_V = AT_NS * AT_KB, AT_WS = AT_V + AT_NS * AT_VB;
constexpr float AT_SCALE = 0.07216878364870323f;
constexpr float AT_THR = 8.f;
#define SBAR() __builtin_amdgcn_sched_barrier(0)
__device__ __forceinline__ int crow(int r, int hi) { return (r & 3) + 8 * (r >> 2) + 4 * hi; }
__device__ __forceinline__ unsigned cvtpk(float lo, float hi) { unsigned r; asm volatile("v_cvt_pk_bf16_f32 %0, %1, %2" : "=v"(r) : "v"(lo), "v"(hi)); return r; }
__device__ __forceinline__ void glds16(const void* sbase, unsigned voff, unsigned lds_dst) { unsigned keep;
    asm volatile("s_mov_b32 %0, m0\n\ts_mov_b32 m0, %3\n\ts_nop 0\n\tglobal_load_lds_dwordx4 %1, %2\n\ts_mov_b32 m0, %0" : "=&s"(keep) : "v"(voff), "s"(sbase), "s"(lds_dst) : "memory"); }
__device__ __forceinline__ const unsigned char* uniform_ptr(const unsigned char* p) { const unsigned long long v = (unsigned long long)p;
    const unsigned lo = __builtin_amdgcn_readfirstlane((unsigned)v), hi = __builtin_amdgcn_readfirstlane((unsigned)(v >> 32)); return (const unsigned char*)(((unsigned long long)hi << 32) | lo); }
__device__ __forceinline__ void at_partialSM(f32x16& p0, f32x16& p1, float& m_reg, float& mn, float& alpha) {
    constexpr float Cc = AT_SCALE * 1.4426950408889634f;
    float pmax = p0[0];
#pragma unroll
    for (int r = 1; r < 16; ++r) pmax = fmaxf(pmax, p0[r]);
#pragma unroll
    for (int r = 0; r < 16; ++r) pmax = fmaxf(pmax, p1[r]);
    { auto rr = __builtin_amdgcn_permlane32_swap(__float_as_uint(pmax), __float_as_uint(pmax), false, false);
      pmax = fmaxf(__uint_as_float(rr[0]), __uint_as_float(rr[1])); }
    if (__builtin_expect(__all(pmax - m_reg <= AT_THR / AT_SCALE), 1)) { mn = m_reg; alpha = 1.f; }
    else { mn = fmaxf(m_reg, pmax); alpha = __builtin_amdgcn_exp2f((m_reg - mn) * Cc); m_reg = mn; }
    const float mnC = -mn * Cc + (ATT_PV8 ? 4.f : 0.f);
#pragma unroll
    for (int r = 0; r < 16; ++r) p0[r] = fmaf(p0[r], Cc, mnC);
#pragma unroll
    for (int r = 0; r < 16; ++r) p1[r] = fmaf(p1[r], Cc, mnC);
#pragma unroll
    for (int r = 0; r < 16; ++r) p0[r] = __builtin_amdgcn_exp2f(p0[r]);
}
__device__ __forceinline__ void at_finishSM(f32x16& p0, f32x16& p1, float alpha, float& l_reg, bf16x8& pa0, bf16x8& pa1, bf16x8& pa2, bf16x8& pa3) {
#pragma unroll
    for (int r = 0; r < 16; ++r) p1[r] = __builtin_amdgcn_exp2f(p1[r]);
    float ps = 0.f;
#pragma unroll
    for (int r = 0; r < 16; ++r) ps += p0[r];
#pragma unroll
    for (int r = 0; r < 16; ++r) ps += p1[r];
    { auto rr = __builtin_amdgcn_permlane32_swap(__float_as_uint(ps), __float_as_uint(ps), false, false);
      ps = __uint_as_float(rr[0]) + __uint_as_float(rr[1]); }
    l_reg = l_reg * alpha + ps;
#define PK4(P, BASE, OUT) do { unsigned a0 = cvtpk(P[BASE + 0], P[BASE + 1]), a1 = cvtpk(P[BASE + 2], P[BASE + 3]);   \
    unsigned b0 = cvtpk(P[BASE + 4], P[BASE + 5]), b1 = cvtpk(P[BASE + 6], P[BASE + 7]);                              \
    auto r0 = __builtin_amdgcn_permlane32_swap(a0, b0, false, false); auto r1 = __builtin_amdgcn_permlane32_swap(a1, b1, false, false); \
    u32x4 w = {r0[0], r1[0], r0[1], r1[1]}; OUT = __builtin_bit_cast(bf16x8, w); } while (0)
    PK4(p0, 0, pa0); PK4(p0, 8, pa1); PK4(p1, 0, pa2); PK4(p1, 8, pa3);
#undef PK4
}
__device__ __forceinline__ void at_qkt(f32x16& p0, f32x16& p1, const LAS char* ks, const int (&kro)[4], const bf16x8* qr) {
    p0 = f32x16{}; p1 = f32x16{};
#pragma unroll
    for (int d0 = 0; d0 < 12; ++d0) {
        const bf16x8 b0 = *(const LAS bf16x8*)(ks + kro[d0 & 3] + 128 * (d0 >> 2));
        const bf16x8 b1 = *(const LAS bf16x8*)(ks + kro[d0 & 3] + 128 * (d0 >> 2) + 12288);
        p0 = __builtin_amdgcn_mfma_f32_32x32x16_bf16(b0, qr[d0], p0, 0, 0, 0);
        p1 = __builtin_amdgcn_mfma_f32_32x32x16_bf16(b1, qr[d0], p1, 0, 0, 0); }
}
#if ATT_QK8
typedef int at_v8i __attribute__((ext_vector_type(8)));
__device__ __forceinline__ at_v8i at_cat8(u32x4 lo, u32x4 hi) { return (at_v8i){(int)lo.x, (int)lo.y, (int)lo.z, (int)lo.w, (int)hi.x, (int)hi.y, (int)hi.z, (int)hi.w}; }
__device__ __forceinline__ void at_qkt8(f32x16& p0, f32x16& p1, const LAS char* ks, int kb0, int kb1, const at_v8i* qf) {
    p0 = f32x16{}; p1 = f32x16{};
#pragma unroll
    for (int s = 0; s < 3; ++s) {
        const u32x4 a0 = *(const LAS u32x4*)(ks + kb0 + 64 * s), a1 = *(const LAS u32x4*)(ks + kb1 + 64 * s);
        const u32x4 b0 = *(const LAS u32x4*)(ks + kb0 + 64 * s + 6144), b1 = *(const LAS u32x4*)(ks + kb1 + 64 * s + 6144);
        p0 = __builtin_amdgcn_mfma_scale_f32_32x32x64_f8f6f4(at_cat8(a0, a1), qf[s], p0, 0, 0, 0, 0, 0, 0);
        p1 = __builtin_amdgcn_mfma_scale_f32_32x32x64_f8f6f4(at_cat8(b0, b1), qf[s], p1, 0, 0, 0, 0, 0, 0); }
}
#endif
#if ATT_PV8
__device__ __forceinline__ unsigned pk4_bf8(float a, float b, float c, float d) { unsigned w = 0; w = __builtin_amdgcn_cvt_pk_bf8_f32(a, b, w, false); w = __builtin_amdgcn_cvt_pk_bf8_f32(c, d, w, true); return w; }
__device__ __forceinline__ void at_packP8(const f32x16& p0, const f32x16& p1, at_v8i& PA) {
#pragma unroll
    for (int g = 0; g < 4; ++g) { const unsigned a = pk4_bf8(p0[4 * g], p0[4 * g + 1], p0[4 * g + 2], p0[4 * g + 3]), b = pk4_bf8(p1[4 * g], p1[4 * g + 1], p1[4 * g + 2], p1[4 * g + 3]);
        auto r = __builtin_amdgcn_permlane32_swap(a, b, false, false); PA[2 * g] = (int)r[0]; PA[2 * g + 1] = (int)r[1]; }
}
__device__ __forceinline__ void at_finishSM8(f32x16& p0, f32x16& p1, float alpha, float& l_reg, at_v8i& PA) {
#pragma unroll
    for (int r = 0; r < 16; ++r) p1[r] = __builtin_amdgcn_exp2f(p1[r]);
    float ps = 0.f;
#pragma unroll
    for (int r = 0; r < 16; ++r) ps += p0[r];
#pragma unroll
    for (int r = 0; r < 16; ++r) ps += p1[r];
    { auto rr = __builtin_amdgcn_permlane32_swap(__float_as_uint(ps), __float_as_uint(ps), false, false);
      ps = __uint_as_float(rr[0]) + __uint_as_float(rr[1]); }
    l_reg = l_reg * alpha + ps;
    at_packP8(p0, p1, PA);
}
__device__ __forceinline__ void pv8(f32x16* o, const LAS char* vs, int vk0, int vk1, const at_v8i& PA) {
#pragma unroll
    for (int d0 = 0; d0 < 4; ++d0) { const u32x4 a = *(const LAS u32x4*)(vs + vk0 + 2048 * d0), b = *(const LAS u32x4*)(vs + vk1 + 2048 * d0);
        o[d0] = __builtin_amdgcn_mfma_scale_f32_32x32x64_f8f6f4(PA, at_cat8(a, b), o[d0], 1, 0, 0, 0, 0, 0); }
}
#endif
__device__ __forceinline__ int v_rd_base(int lane) { return ((lane & 3) << 3) | (((lane >> 2) & 3) << 6) | (((lane >> 4) & 1) << 5) | (((lane >> 5) & 1) << 8); }
constexpr int v_rd_off(int d0, int ks, int half) { return d0 * 512 + ks * 4096 + half * 2048; }
template <int OFF> __device__ __forceinline__ s16x4 tr_read(int vb) { s16x4 r; asm volatile("ds_read_b64_tr_b16 %0, %1 offset:%2" : "=&v"(r) : "v"(vb), "i"(OFF) : "memory"); return r; }
template <int D0> __device__ __forceinline__ void pv_one(f32x16& od, int vb, bf16x8 pa0, bf16x8 pa1, bf16x8 pa2, bf16x8 pa3) {
    const s16x4 l0 = tr_read<v_rd_off(D0, 0, 0)>(vb), h0 = tr_read<v_rd_off(D0, 0, 1)>(vb), l1 = tr_read<v_rd_off(D0, 1, 0)>(vb), h1 = tr_read<v_rd_off(D0, 1, 1)>(vb);
    const s16x4 l2 = tr_read<v_rd_off(D0, 2, 0)>(vb), h2 = tr_read<v_rd_off(D0, 2, 1)>(vb), l3 = tr_read<v_rd_off(D0, 3, 0)>(vb), h3 = tr_read<v_rd_off(D0, 3, 1)>(vb);
    asm volatile("s_waitcnt lgkmcnt(0)" ::: "memory"); SBAR();
#define PKV(L, H) (bf16x8){L[0], L[1], L[2], L[3], H[0], H[1], H[2], H[3]}
    od = __builtin_amdgcn_mfma_f32_32x32x16_bf16(pa0, PKV(l0, h0), od, 0, 0, 0);
    od = __builtin_amdgcn_mfma_f32_32x32x16_bf16(pa1, PKV(l1, h1), od, 0, 0, 0);
    od = __builtin_amdgcn_mfma_f32_32x32x16_bf16(pa2, PKV(l2, h2), od, 0, 0, 0);
    od = __builtin_amdgcn_mfma_f32_32x32x16_bf16(pa3, PKV(l3, h3), od, 0, 0, 0);
#undef PKV
}
#if PV_PIPE
__device__ __forceinline__ void pv_d0(f32x16* o, int vb, bf16x8 pa0, bf16x8 pa1, bf16x8 pa2, bf16x8 pa3) {
#define TRSET(D0, N) const s16x4 N##0 = tr_read<v_rd_off(D0, 0, 0)>(vb), N##1 = tr_read<v_rd_off(D0, 0, 1)>(vb), N##2 = tr_read<v_rd_off(D0, 1, 0)>(vb), N##3 = tr_read<v_rd_off(D0, 1, 1)>(vb), \
                                   N##4 = tr_read<v_rd_off(D0, 2, 0)>(vb), N##5 = tr_read<v_rd_off(D0, 2, 1)>(vb), N##6 = tr_read<v_rd_off(D0, 3, 0)>(vb), N##7 = tr_read<v_rd_off(D0, 3, 1)>(vb)
#define PKV(L, H) (bf16x8){L[0], L[1], L[2], L[3], H[0], H[1], H[2], H[3]}
#define PVM(OD, N) do { OD = __builtin_amdgcn_mfma_f32_32x32x16_bf16(pa0, PKV(N##0, N##1), OD, 0, 0, 0); OD = __builtin_amdgcn_mfma_f32_32x32x16_bf16(pa1, PKV(N##2, N##3), OD, 0, 0, 0); \
                        OD = __builtin_amdgcn_mfma_f32_32x32x16_bf16(pa2, PKV(N##4, N##5), OD, 0, 0, 0); OD = __builtin_amdgcn_mfma_f32_32x32x16_bf16(pa3, PKV(N##6, N##7), OD, 0, 0, 0); } while (0)
    TRSET(0, a); TRSET(1, b);
    asm volatile("s_waitcnt lgkmcnt(8)" ::: "memory"); SBAR(); PVM(o[0], a);
    TRSET(2, c);
    asm volatile("s_waitcnt lgkmcnt(8)" ::: "memory"); SBAR(); PVM(o[1], b);
    TRSET(3, d);
    asm volatile("s_waitcnt lgkmcnt(8)" ::: "memory"); SBAR(); PVM(o[2], c);
    asm volatile("s_waitcnt lgkmcnt(0)" ::: "memory"); SBAR(); PVM(o[3], d);
#undef TRSET
#undef PKV
#undef PVM
}
#else
__device__ __forceinline__ void pv_d0(f32x16* o, int vb, bf16x8 pa0, bf16x8 pa1, bf16x8 pa2, bf16x8 pa3) {
    pv_one<0>(o[0], vb, pa0, pa1, pa2, pa3); pv_one<1>(o[1], vb, pa0, pa1, pa2, pa3); pv_one<2>(o[2], vb, pa0, pa1, pa2, pa3); pv_one<3>(o[3], vb, pa0, pa1, pa2, pa3);
}
#endif
#define AT_WAITBAR(N) asm volatile("s_waitcnt vmcnt(" #N ") lgkmcnt(0)\n\ts_barrier" ::: "memory")
#define AT_WAITBAR_N(N) AT_WAITBAR(N)

__device__ __forceinline__ void attn_unit(const Ctx& C, int b, int h, int qb) {
    const bf16_t* Qb = WSP(bf16_t, WS_Q); float* ya = WSP(float, WS_YATT);
    const int lane = C.lane, wid = C.wave, r32 = lane & 31, hi = lane >> 5;
    const int rowbase = b * SEQ, q0 = qb * 256;
    const unsigned lds0 = (unsigned)(uintptr_t)C.lds;
    LAS float* wsf = (LAS float*)(C.lds + AT_WS) + wid * 64; LAS float* li_l = wsf; LAS float* al_l = wsf + 32;
    const unsigned char* kimg = uniform_ptr(C.ws + WS_KIMG + ((size_t)rowbase * 768 + h * 192) * (ATT_QK8 ? 1 : 2));
#if ATT_PV8
    const unsigned char* vimg = uniform_ptr(C.ws + WS_VIMG + ((size_t)(rowbase / 64) * 4 + h) * 8192);
#else
    const unsigned char* vimg = uniform_ptr(C.ws + WS_VIMG + ((size_t)rowbase * 512 + h * 128) * 2);
#endif
#if ATT_QK8
    unsigned kvoff[2];
#pragma unroll
    for (int i = 0; i < 2; ++i) { const int q = 64 * (wid + 8 * i) + lane, row = q / 12, cp = q % 12, c = (cp & ~3) | ((cp & 3) ^ ((row >> 2) & 3)); kvoff[i] = (unsigned)(row * 768 + c * 16); }
#else
    unsigned kvoff[3];
#pragma unroll
    for (int i = 0; i < 3; ++i) { const int q = 64 * (wid + 8 * i) + lane, row = q / 24, cp = q % 24, c = (cp & ~7) | ((cp & 7) ^ ((row >> 1) & 7)); kvoff[i] = (unsigned)(row * 1536 + c * 16); }
#endif
#if ATT_PV8
    unsigned vvoff[1];
    { const int q = 64 * wid + lane, row = q >> 2, cp = q & 3; vvoff[0] = (unsigned)(row * 64 + ((cp ^ ((row >> 2) & 3)) * 16)); }
#else
    unsigned vvoff[2];
#pragma unroll
    for (int j = 0; j < 2; ++j) { const int P = wid + 8 * j, sub = 2 * P + (lane >> 5), kk = (sub >> 2) * 8 + ((lane & 31) >> 2), k = (kk & ~0xC) | ((kk & 4) << 1) | ((kk & 8) >> 1), col = (sub & 3) * 32 + (lane & 3) * 8;
        vvoff[j] = (unsigned)(k * 1024 + col * 2); }
#endif
    const unsigned kdst = lds0 + AT_K + wid * 1024, vdst = lds0 + AT_V + wid * 1024;
#if ATT_PV8
#define AT_DMA(t, slot) do { const unsigned char* ks_ = kimg + (size_t)(t) * (64 * 768); const unsigned char* vs_ = vimg + (size_t)(t) * 32768; \
        const unsigned kd_ = (unsigned)__builtin_amdgcn_readfirstlane(kdst + (slot) * AT_KB), vd_ = (unsigned)__builtin_amdgcn_readfirstlane(vdst + (slot) * AT_VB); \
        glds16(vs_, vvoff[0], vd_); glds16(ks_, kvoff[0], kd_); if (wid < 4) glds16(ks_, kvoff[1], kd_ + 8192); } while (0)
#define AT_NDMA 2
#elif ATT_QK8
#define AT_DMA(t, slot) do { const unsigned char* ks_ = kimg + (size_t)(t) * (64 * 768); const unsigned char* vs_ = vimg + (size_t)(t) * (64 * 1024); \
        const unsigned kd_ = (unsigned)__builtin_amdgcn_readfirstlane(kdst + (slot) * AT_KB), vd_ = (unsigned)__builtin_amdgcn_readfirstlane(vdst + (slot) * AT_VB); \
        glds16(vs_, vvoff[0], vd_); glds16(vs_, vvoff[1], vd_ + 8192); glds16(ks_, kvoff[0], kd_); if (wid < 4) glds16(ks_, kvoff[1], kd_ + 8192); } while (0)
#define AT_NDMA 3
#else
#define AT_DMA(t, slot) do { const unsigned char* ks_ = kimg + (size_t)(t) * (64 * 1536); const unsigned char* vs_ = vimg + (size_t)(t) * (64 * 1024); \
        const unsigned kd_ = (unsigned)__builtin_amdgcn_readfirstlane(kdst + (slot) * AT_KB), vd_ = (unsigned)__builtin_amdgcn_readfirstlane(vdst + (slot) * AT_VB); \
        glds16(ks_, kvoff[0], kd_); glds16(ks_, kvoff[1], kd_ + 8192); glds16(ks_, kvoff[2], kd_ + 16384); glds16(vs_, vvoff[0], vd_); glds16(vs_, vvoff[1], vd_ + 8192); } while (0)
#define AT_NDMA 5
#endif
    const int NT = 4 * qb + 4, jlim = 4 * qb + (wid >> 1);
#if ATT_QK8
    at_v8i qf[3];
    { const unsigned char* Qw = (const unsigned char*)Qb + (size_t)(rowbase + q0 + wid * 32 + r32) * 768 + h * 192 + hi * 32;
#pragma unroll
      for (int s = 0; s < 3; ++s) qf[s] = at_cat8(*(const u32x4*)(Qw + 64 * s), *(const u32x4*)(Qw + 64 * s + 16)); }
    const int kb0 = r32 * 192 + 16 * ((2 * hi) ^ ((r32 >> 2) & 3)), kb1 = kb0 ^ 16;
#define AT_QKT(C0, C1, KS) at_qkt8(C0, C1, KS, kb0, kb1, qf)
#else
    bf16x8 qr[12];
    { const bf16_t* Qw = Qb + (size_t)(rowbase + q0 + wid * 32 + r32) * 768 + h * 192 + hi * 8;
#pragma unroll
      for (int d0 = 0; d0 < 12; ++d0) qr[d0] = *(const bf16x8*)(Qw + d0 * 16); }
#define AT_QKT(C0, C1, KS) at_qkt(C0, C1, KS, kro, qr)
#endif
    AT_DMA(0, 0); AT_DMA(1, 1);
    const LAS char* kp0 = (const LAS char*)C.lds + AT_K;
#if !ATT_QK8
    int kro[4];
#pragma unroll
    for (int j = 0; j < 4; ++j) kro[j] = r32 * 384 + 16 * ((2 * j + hi) ^ ((r32 >> 1) & 7));
#endif
    float m_reg = -1e30f, l_reg = 0.f; f32x16 o[4] = {};
    f32x16 pA0, pA1, pB0, pB1; float mnA, mnB, alA, alB;
#if ATT_PV8
    const LAS char* vp0 = (const LAS char*)C.lds + AT_V; const int vk0 = r32 * 64 + 16 * ((2 * hi) ^ ((r32 >> 2) & 3)), vk1 = vk0 ^ 16;
    at_v8i PA;
#define AT_FIN(P0, P1, ALP) at_finishSM8(P0, P1, ALP, l_reg, PA)
#define AT_PV(SLOT) pv8(o, vp0 + (SLOT) * AT_VB, vk0, vk1, PA)
#else
    const int vb0 = (int)(lds0 + AT_V) + v_rd_base(lane);
    bf16x8 pa0, pa1, pa2, pa3;
#define AT_FIN(P0, P1, ALP) at_finishSM(P0, P1, ALP, l_reg, pa0, pa1, pa2, pa3)
#define AT_PV(SLOT) pv_d0(o, vb0 + (SLOT) * AT_VB, pa0, pa1, pa2, pa3)
#endif
#define AT_RESC(a) do { if (__any((a) < 1.f)) { if (hi == 0) al_l[r32] = (a); asm volatile("s_waitcnt lgkmcnt(0)" ::: "memory"); \
        _Pragma("unroll") for (int d = 0; d < 4; ++d) _Pragma("unroll") for (int r = 0; r < 16; ++r) o[d][r] *= al_l[crow(r, hi)]; } } while (0)
#define AT_MASKED(P0, P1) do { _Pragma("unroll") for (int r = 0; r < 16; ++r) { P0[r] = -1e30f; P1[r] = -1e30f; } } while (0)
#define AT_STEP(C0, C1, MNC, ALC, P0, P1, ALP, j) do { const int sj_ = (j) % 3, sp_ = ((j) + 2) % 3; \
        SBAR(); if ((j) <= jlim) AT_QKT(C0, C1, kp0 + sj_ * AT_KB); else AT_MASKED(C0, C1); \
        AT_FIN(P0, P1, ALP); SBAR(); \
        if ((j) - 1 <= jlim) AT_PV(sp_); \
        at_partialSM(C0, C1, m_reg, MNC, ALC); \
        AT_WAITBAR(0); \
        if ((j) + 2 < NT) AT_DMA((j) + 2, sp_); \
        AT_RESC(ALC); } while (0)
    AT_WAITBAR_N(AT_NDMA);
    AT_QKT(pA0, pA1, kp0); at_partialSM(pA0, pA1, m_reg, mnA, alA);
    AT_DMA(2, 2);
    AT_WAITBAR_N(AT_NDMA);
    AT_RESC(alA);
    for (int j = 1; j + 1 < NT; j += 2) {
        AT_STEP(pB0, pB1, mnB, alB, pA0, pA1, alA, j);
        AT_STEP(pA0, pA1, mnA, alA, pB0, pB1, alB, j + 1);
    }
    AT_STEP(pB0, pB1, mnB, alB, pA0, pA1, alA, NT - 1);
    AT_FIN(pB0, pB1, alB); SBAR();
    if (NT - 1 <= jlim) AT_PV((NT - 1) % 3);
    if (hi == 0) li_l[r32] = l_reg;
    asm volatile("s_waitcnt lgkmcnt(0)" ::: "memory");
    float rli[16];
#pragma unroll
    for (int r = 0; r < 16; ++r) rli[r] = __builtin_amdgcn_rcpf(li_l[crow(r, hi)]);
    float* Ow = ya + (size_t)(rowbase + q0 + wid * 32) * 512 + h * 128;
#pragma unroll
    for (int r = 0; r < 16; ++r) { const int orow = crow(r, hi);
#pragma unroll
        for (int d0 = 0; d0 < 4; ++d0) Ow[(size_t)orow * 512 + d0 * 32 + r32] = o[d0][r] * rli[r]; }
    AT_WAITBAR(0);
#undef AT_FIN
#undef AT_PV
#undef AT_DMA
#undef AT_NDMA
#undef AT_QKT
#undef AT_RESC
#undef AT_MASKED
#undef AT_STEP
}
__device__ __forceinline__ void ph_attn(const Ctx& C, int l) {
    const int vcu = (C.G % 8 == 0) ? (C.bid % 8) * (C.G / 8) + C.bid / 8 : C.bid;
    for (int p = vcu; p < 256; p += C.G) { const int bh = p >> 3, s = p & 7;
        for (int u = 0; u < 2; ++u) attn_unit(C, bh >> 2, bh & 3, u ? s : 15 - s); }
}
__device__ __forceinline__ void ph_mixnorm(const Ctx& C, int l) {
    const bf16_t* ymix = WSP(bf16_t, WS_YMIX); const float* ya = WSP(float, WS_YATT); bf16_t* mix = WSP(bf16_t, WS_MIX);
    const int lane = C.lane, stride = C.G * NWAVE; int t = C.bid * NWAVE + C.wave;
    if (t >= T) return;
    u32x2 pn = *(const u32x2*)(ymix + (size_t)t * 512 + 4 * lane), qn = *(const u32x2*)(ymix + (size_t)t * 512 + 256 + 4 * lane);
    f32x4 a0n = *(const f32x4*)(ya + (size_t)t * 512 + 8 * lane), a1n = *(const f32x4*)(ya + (size_t)t * 512 + 8 * lane + 4);
    u32x2 pn2 = pn, qn2 = qn; f32x4 a0n2 = a0n, a1n2 = a1n;
    if (t + stride < T) { const int tn = t + stride;
        pn2 = *(const u32x2*)(ymix + (size_t)tn * 512 + 4 * lane); qn2 = *(const u32x2*)(ymix + (size_t)tn * 512 + 256 + 4 * lane);
        a0n2 = *(const f32x4*)(ya + (size_t)tn * 512 + 8 * lane); a1n2 = *(const f32x4*)(ya + (size_t)tn * 512 + 8 * lane + 4); }
    for (; t < T; t += stride) {
        const u32x2 p = pn, q = qn; const f32x4 a0 = a0n, a1 = a1n;
        pn = pn2; qn = qn2; a0n = a0n2; a1n = a1n2;
        if (t + 2 * stride < T) { const int tn = t + 2 * stride;
            pn2 = *(const u32x2*)(ymix + (size_t)tn * 512 + 4 * lane); qn2 = *(const u32x2*)(ymix + (size_t)tn * 512 + 256 + 4 * lane);
            a0n2 = *(const f32x4*)(ya + (size_t)tn * 512 + 8 * lane); a1n2 = *(const f32x4*)(ya + (size_t)tn * 512 + 8 * lane + 4); }
        const float p0 = bflo(p.x), p1 = bfhi(p.x), p2 = bflo(p.y), p3 = bfhi(p.y), q0 = bflo(q.x), q1 = bfhi(q.x), q2 = bflo(q.y), q3 = bfhi(q.y);
        const float rp = rsqrtf(wave_sum((p0 * p0 + p1 * p1) + (p2 * p2 + p3 * p3)) * (1.f / 256.f) + EPS);
        const float rq = rsqrtf(wave_sum((q0 * q0 + q1 * q1) + (q2 * q2 + q3 * q3)) * (1.f / 256.f) + EPS);
        const float ra = rsqrtf(wave_sum((a0.x * a0.x + a0.y * a0.y) + (a0.z * a0.z + a0.w * a0.w) + (a1.x * a1.x + a1.y * a1.y) + (a1.z * a1.z + a1.w * a1.w)) * (1.f / 512.f) + EPS);
#if OUTPROJ_FP8
        unsigned char* mr8 = C.ws + WS_MIX + (size_t)t * 1024;
        *(unsigned*)(mr8 + 4 * lane) = pk4_fp8(p0 * rp, p1 * rp, p2 * rp, p3 * rp);
        *(unsigned*)(mr8 + 256 + 4 * lane) = pk4_fp8(q0 * rq, q1 * rq, q2 * rq, q3 * rq);
        *(u32x2*)(mr8 + 512 + 8 * lane) = (u32x2){pk4_fp8(a0.x * ra, a0.y * ra, a0.z * ra, a0.w * ra), pk4_fp8(a1.x * ra, a1.y * ra, a1.z * ra, a1.w * ra)};
#else
        bf16_t* mr = mix + (size_t)t * 1024;
        *(u32x2*)(mr + 4 * lane) = (u32x2){pk2(p0 * rp, p1 * rp), pk2(p2 * rp, p3 * rp)};
        *(u32x2*)(mr + 256 + 4 * lane) = (u32x2){pk2(q0 * rq, q1 * rq), pk2(q2 * rq, q3 * rq)};
        *(u32x4*)(mr + 512 + 8 * lane) = (u32x4){pk2(a0.x * ra, a0.y * ra), pk2(a0.z * ra, a0.w * ra), pk2(a1.x * ra, a1.y * ra), pk2(a1.z * ra, a1.w * ra)};
#endif
    }
}
__device__ __forceinline__ void ph_outproj(const Ctx& C, int l) {
    const bf16_t* mix = WSP(bf16_t, WS_MIX); const bf16_t* W = WSP(bf16_t, WS_WO) + (size_t)l * 1024 * 1024;
    const float* xin = (l == 0) ? C.x : C.out; float* xo = C.out;
    for (int u = C.bid; u < 256 * 8; u += C.G) { const int rt = u / 8, ct = u % 8;
        sg_tile<1>(C, [&](int r) { return mix + (size_t)(rt * 128 + r) * 1024; }, W + (size_t)ct * 128 * 1024, nullptr, 1024,
                   [&](int r, int c, float v, float) { const size_t o = (size_t)(rt * 128 + r) * 1024 + ct * 128 + c; xo[o] = xin[o] + v; });
    }
}
typedef float f32x16_r __attribute__((ext_vector_type(16)));
__device__ __forceinline__ void ph_route(const Ctx& C, int l, int dummy = 0) {
    const bf16_t* x = WSP(bf16_t, WS_XB); const bf16_t* Wh = WSP(bf16_t, WS_WR) + (size_t)(l * 2) * 32 * 1024; const bf16_t* Wl = Wh + 32 * 1024;
    int* ltok = dummy ? WSP(int, WS_YB) : WSP(int, WS_LTOK); float* lgate = dummy ? WSP(float, WS_YB + 8 * MiB) : WSP(float, WS_LGATE); unsigned* asg = dummy ? WSP(unsigned, WS_YB + 16 * MiB) : WSP(unsigned, WS_ASG);
    unsigned* gcnt = WSP(unsigned, WS_CTL) + CW_GCNT + l * NEXP * 64 + (dummy ? 8192 : 0);
    constexpr int XROW = 2064;
    LAS unsigned char* xt = C.lds;
    LAS float* red = (LAS float*)(C.lds + 66048);
    LAS float* lg = (LAS float*)(C.lds + 98816);
    LAS float* rsv = (LAS float*)(C.lds + 102912);
    LAS float* tmpv = (LAS float*)(C.lds + 103040) + C.wave * 4;
    LAS int* sel_e = (LAS int*)(C.lds + 103424);
    LAS float* sel_g = (LAS float*)(C.lds + 105472);
    LAS int* ctl = (LAS int*)(C.lds + LDS_CTL);
    const int lane = C.lane, w = C.wave, tid = C.tid, r32 = lane & 31, hi = lane >> 5;
    bf16x8 ah[8], al[8];
#pragma unroll
    for (int ks = 0; ks < 8; ++ks) { ah[ks] = *(const bf16x8*)(Wh + (size_t)r32 * 1024 + 128 * w + 16 * ks + 8 * hi); al[ks] = *(const bf16x8*)(Wl + (size_t)r32 * 1024 + 128 * w + 16 * ks + 8 * hi); }
    const float* bias = WSP(float, WS_PAR) + P_BR + l * 32;
    for (int chunk = C.bid; chunk < T / 128; chunk += C.G) {
        const int tok0 = chunk * 128;
        if (tid < 32) ctl[96 + tid] = 0;
        u32x4 q[4][2];
#pragma unroll
        for (int i = 0; i < 4; ++i) { const u32x4* xr = (const u32x4*)(x + (size_t)(tok0 + 4 * w + i) * DM + 16 * lane); q[i][0] = xr[0]; q[i][1] = xr[1]; }
        for (int tile = 0; tile < 4; ++tile) {
#pragma unroll
            for (int i = 0; i < 4; ++i) { const int t = tok0 + 32 * tile + 4 * w + i; const u32x4 a = q[i][0], b = q[i][1];
                float v[16] = {bflo(a.x), bfhi(a.x), bflo(a.y), bfhi(a.y), bflo(a.z), bfhi(a.z), bflo(a.w), bfhi(a.w), bflo(b.x), bfhi(b.x), bflo(b.y), bfhi(b.y), bflo(b.z), bfhi(b.z), bflo(b.w), bfhi(b.w)};
                float ss = 0.f;
#pragma unroll
                for (int j = 0; j < 16; ++j) ss += v[j] * v[j];
                const float rs = rsqrtf(wave_sum(ss) * (1.f / DM) + EPS);
                *(u32x4*)(C.ws + WS_HB8 + (size_t)t * 1024 + 16 * lane) = (u32x4){pk4_fp8(v[0] * rs, v[1] * rs, v[2] * rs, v[3] * rs), pk4_fp8(v[4] * rs, v[5] * rs, v[6] * rs, v[7] * rs),
                                                                                 pk4_fp8(v[8] * rs, v[9] * rs, v[10] * rs, v[11] * rs), pk4_fp8(v[12] * rs, v[13] * rs, v[14] * rs, v[15] * rs)};
                LAS u32x4* dst = (LAS u32x4*)(xt + (4 * w + i) * XROW + 32 * lane); dst[0] = a; dst[1] = b;
                if (lane == 0) rsv[4 * w + i] = rs; }
            if (tile < 3) {
#pragma unroll
                for (int i = 0; i < 4; ++i) { const u32x4* xr = (const u32x4*)(x + (size_t)(tok0 + 32 * (tile + 1) + 4 * w + i) * DM + 16 * lane); q[i][0] = xr[0]; q[i][1] = xr[1]; } }
            __syncthreads();
            { f32x16_r d = {};
#pragma unroll
              for (int ks = 0; ks < 8; ++ks) { const bf16x8 bx = *(const LAS bf16x8*)(xt + r32 * XROW + (128 * w + 16 * ks + 8 * hi) * 2);
                  d = __builtin_amdgcn_mfma_f32_32x32x16_bf16(ah[ks], bx, d, 0, 0, 0); d = __builtin_amdgcn_mfma_f32_32x32x16_bf16(al[ks], bx, d, 0, 0, 0); }
#pragma unroll
              for (int r = 0; r < 16; ++r) red[(w * 16 + r) * 64 + lane] = d[r]; }
            __syncthreads();
            { const int tk = tid & 31, hi_ = (tid >> 5) & 1, r0 = tid >> 6; const float rs = rsv[tk];
#pragma unroll
              for (int rr = 0; rr < 2; ++rr) { const int r = r0 + 8 * rr; float sm = 0.f;
#pragma unroll
                  for (int ww = 0; ww < 8; ++ww) sm += red[(ww * 16 + r) * 64 + tk + 32 * hi_];
                  const int e = (r & 3) + 8 * (r >> 2) + 4 * hi_; lg[tk * 32 + e] = sm * rs + bias[e]; } }
            __syncthreads();
#pragma unroll
            for (int i = 0; i < 4; ++i) { const int tk = 4 * w + i, e = lane & 31; const float mine = lg[tk * 32 + e]; int rank = 0;
#pragma unroll
                for (int c4 = 0; c4 < 8; ++c4) { const f32x4 qv = *(const LAS f32x4*)(lg + tk * 32 + 4 * c4);
                    rank += (qv.x > mine || (qv.x == mine && 4 * c4 + 0 < e)) ? 1 : 0; rank += (qv.y > mine || (qv.y == mine && 4 * c4 + 1 < e)) ? 1 : 0;
                    rank += (qv.z > mine || (qv.z == mine && 4 * c4 + 2 < e)) ? 1 : 0; rank += (qv.w > mine || (qv.w == mine && 4 * c4 + 3 < e)) ? 1 : 0; }
                if (lane < 32 && rank < 4) tmpv[rank] = mine;
                asm volatile("s_waitcnt lgkmcnt(0)" ::: "memory");
                const f32x4 tv = *(const LAS f32x4*)tmpv;
                const float inv = 1.f / (1.f + __expf(tv.y - tv.x) + __expf(tv.z - tv.x) + __expf(tv.w - tv.x));
                if (lane < 32 && rank < 4) { const int tl = 32 * tile + tk; sel_e[tl * 4 + rank] = e; sel_g[tl * 4 + rank] = __expf(mine - tv.x) * inv; }
                asm volatile("s_waitcnt lgkmcnt(0)" ::: "memory"); }
        }
        __syncthreads();
        const int e = sel_e[tid]; const float gt = sel_g[tid];
        const int rank = __hip_atomic_fetch_add(&ctl[96 + e], 1, __ATOMIC_RELAXED, __HIP_MEMORY_SCOPE_WORKGROUP);
        __syncthreads();
        if (tid < 32) ctl[128 + tid] = (int)__hip_atomic_fetch_add(gcnt + tid * 64, (unsigned)ctl[96 + tid], __ATOMIC_RELAXED, __HIP_MEMORY_SCOPE_AGENT);
        __syncthreads();
        const int slot = ctl[128 + e] + rank, tok = tok0 + (tid >> 2);
        ltok[(size_t)e * T + slot] = tok; lgate[(size_t)tok * 4 + (tid & 3)] = gt; asg[(size_t)tok * 4 + (tid & 3)] = ((unsigned)e << 24) | (unsigned)slot;
        __syncthreads();
    }
}
__device__ __forceinline__ void ph_gateup(const Ctx& C, int l) {
    moe_tables(C, l);
    LAS int* ctl = (LAS int*)(C.lds + LDS_CTL);
    const bf16_t* hb = WSP(bf16_t, WS_HB); const int* ltok = WSP(int, WS_LTOK); bf16_t* act = WSP(bf16_t, WS_ACT);
    const int nrt = ctl[32 + NEXP];
    for (int u = C.bid; u < nrt * 2 * 8; u += C.G) { const int rt128 = u >> 3, pn = u & 7, rt = rt128 >> 1, sub = rt128 & 1;
        const int e = moe_find_expert(C, rt), cnt = ctl[e], lrow0 = (rt - ctl[32 + e]) * 256 + sub * 128;
        const bf16_t* W = WSP(bf16_t, WS_WGU) + ((size_t)(l * NEXP + e) * 2048 + pn * 256) * 1024;
        const float* bg = WSP(float, WS_PAR) + P_BGU + (size_t)(l * NEXP + e) * 2048;
        const size_t arow0 = (size_t)rt * 256 + sub * 128;
        sg_tile<2>(C, [&](int r) { const int li = lrow0 + r; const int tok = (li < cnt) ? ltok[(size_t)e * T + li] : 0; return hb + (size_t)tok * 1024; }, W, W + (size_t)128 * 1024, 1024,
                   [&](int r, int c, float vg, float vl) { const int j = pn * 128 + c; vg += bg[2 * j]; vl += bg[2 * j + 1];
                       const float xg = fminf(vg, 7.f), xl = fminf(fmaxf(vl, -7.f), 7.f);
                       act[(arow0 + r) * 1024 + j] = (bf16_t)f2bf(xg * sigmoidf_(1.702f * xg) * (xl + 1.f)); });
    }
}
__device__ __forceinline__ void ph_down(const Ctx& C, int l) {
    moe_tables(C, l);
    LAS int* ctl = (LAS int*)(C.lds + LDS_CTL);
    const bf16_t* act = WSP(bf16_t, WS_ACT); const float* lgate = WSP(float, WS_LGATE); bf16_t* yb = WSP(bf16_t, WS_YB);
    const int nrt = ctl[32 + NEXP];
    for (int u = C.bid; u < nrt * 2 * 8; u += C.G) { const int rt128 = u >> 3, ct = u & 7, rt = rt128 >> 1, sub = rt128 & 1;
        const int e = moe_find_expert(C, rt), cnt = ctl[e], lrow0 = (rt - ctl[32 + e]) * 256 + sub * 128;
        const bf16_t* W = WSP(bf16_t, WS_WD) + ((size_t)(l * NEXP + e) * 1024 + ct * 128) * 1024;
        const float* bd = WSP(float, WS_PAR) + P_BDN + (size_t)(l * NEXP + e) * 1024;
        const size_t arow0 = (size_t)rt * 256 + sub * 128;
        sg_tile<1>(C, [&](int r) { return act + (arow0 + r) * 1024; }, W, nullptr, 1024,
                   [&](int r, int c, float v, float) { const int li = lrow0 + r; const float g = (li < cnt) ? lgate[(size_t)e * T + li] : 0.f;
                       yb[(arow0 + r) * 1024 + ct * 128 + c] = (bf16_t)f2bf((v + bd[ct * 128 + c]) * g); });
    }
}
static_assert(MOE_FP8 == 1, "the combine phase reads the expert outputs as fp8 x16 (the MOE_FP8 path)");
struct CmbIn { u32x4 x0, x1; u32x4 y[4]; f32x4 g; };
__device__ __forceinline__ CmbIn cmb_load(const Ctx& C, int t, u32x4 a4, int lane) {
    LAS int* ctl = (LAS int*)(C.lds + LDS_CTL); CmbIn r;
    const u32x4* xr = (const u32x4*)(WSP(bf16_t, WS_XB) + (size_t)t * DM + 16 * lane); r.x0 = xr[0]; r.x1 = xr[1]; r.g = *(const f32x4*)(WSP(float, WS_LGATE) + (size_t)t * 4);
#pragma unroll
    for (int k = 0; k < 4; ++k) { const unsigned a = a4[k]; const int e = a >> 24, slot = a & 0xffffff; const size_t row = (size_t)ctl[32 + e] * 256 + slot;
        r.y[k] = *(const u32x4*)(C.ws + WS_YB + row * 1024 + 16 * lane); }
    return r;
}
__device__ __forceinline__ void ph_combine(const Ctx& C, int l, float ysc = 1.f) {
    moe_tables(C, l);
    const unsigned* asg = WSP(unsigned, WS_ASG); bf16_t* xb = WSP(bf16_t, WS_XB);
    const int lane = C.lane; const bool last_layer = (l == NLAYER - 1) && ysc == 1.f;
    const int stride = C.G * NWAVE; int t = C.bid * NWAVE + C.wave;
    if (t >= T) return;
    u32x4 a_nx = *(const u32x4*)(asg + (size_t)t * 4);
    CmbIn nx = cmb_load(C, t, a_nx, lane), nx2 = nx;
    if (t + stride < T) { a_nx = *(const u32x4*)(asg + (size_t)(t + stride) * 4); nx2 = cmb_load(C, t + stride, a_nx, lane); }
    if (t + 2 * stride < T) a_nx = *(const u32x4*)(asg + (size_t)(t + 2 * stride) * 4);
    for (; t < T; t += stride) {
        const CmbIn in = nx; nx = nx2;
        if (t + 2 * stride < T) { nx2 = cmb_load(C, t + 2 * stride, a_nx, lane); if (t + 3 * stride < T) a_nx = *(const u32x4*)(asg + (size_t)(t + 3 * stride) * 4); }
        f32x4 v[4];
        v[0] = (f32x4){bflo(in.x0.x), bfhi(in.x0.x), bflo(in.x0.y), bfhi(in.x0.y)}; v[1] = (f32x4){bflo(in.x0.z), bfhi(in.x0.z), bflo(in.x0.w), bfhi(in.x0.w)};
        v[2] = (f32x4){bflo(in.x1.x), bfhi(in.x1.x), bflo(in.x1.y), bfhi(in.x1.y)}; v[3] = (f32x4){bflo(in.x1.z), bfhi(in.x1.z), bflo(in.x1.w), bfhi(in.x1.w)};
#pragma unroll
        for (int k = 0; k < 4; ++k) { const float sc = ysc * (1.f / g8::YB_SCALE) * in.g[k];
#pragma unroll
            for (int j = 0; j < 4; ++j) { const f32x2 lo = __builtin_amdgcn_cvt_pk_f32_fp8((int)in.y[k][j], false), hi = __builtin_amdgcn_cvt_pk_f32_fp8((int)in.y[k][j], true);
                v[j].x += sc * lo.x; v[j].y += sc * lo.y; v[j].z += sc * hi.x; v[j].w += sc * hi.y; } }
        if (last_layer) { f32x4* o = (f32x4*)(C.out + (size_t)t * DM + 16 * lane);
#pragma unroll
            for (int j = 0; j < 4; ++j) o[j] = v[j];
            continue; }
        float s = 0.f;
#pragma unroll
        for (int j = 0; j < 4; ++j) s += (v[j].x * v[j].x + v[j].y * v[j].y) + (v[j].z * v[j].z + v[j].w * v[j].w);
        u32x4* xr = (u32x4*)(xb + (size_t)t * DM + 16 * lane);
        xr[0] = (u32x4){pk2(v[0].x, v[0].y), pk2(v[0].z, v[0].w), pk2(v[1].x, v[1].y), pk2(v[1].z, v[1].w)};
        xr[1] = (u32x4){pk2(v[2].x, v[2].y), pk2(v[2].z, v[2].w), pk2(v[3].x, v[3].y), pk2(v[3].z, v[3].w)};
        const float rs = rsqrtf(wave_sum(s) * (1.f / DM) + EPS);
        if (lane == 0) WSP(float, WS_RS)[t] = rs;
    }
}

#ifndef FAST_INPROJ
#define FAST_INPROJ 1
#endif
#ifndef FAST_SMALL
#define FAST_SMALL 1
#endif
#ifndef FAST_OUTPROJ
#define FAST_OUTPROJ 1
#endif
#ifndef FAST_GATEUP
#define FAST_GATEUP 1
#endif
#ifndef FAST_DOWN
#define FAST_DOWN 1
#endif
#ifndef G8_SP2
#define G8_SP2 true
#endif
#ifndef G8_ALIGN
#define G8_ALIGN true
#endif
__device__ __forceinline__ void ph_inproj_f(const Ctx& C, int l) {
    const g8::DenseSched S{C.ws + WS_XB, C.ws + WS_WIN + (size_t)l * DINP * 1024 * 2, 1024, 1024, T / 256, DINP / 256, C.G, C.bid, 2};
    const g8::EpiBf16Rs E{WSP(bf16_t, WS_Z), DINP, WSP(float, WS_RS)};
    g8::gemm_phase<g8::EpiBf16Rs, g8::DenseSched, G8_ALIGN, G8_SP2>(C.lds, 1024, S, E);
}
__device__ __forceinline__ void ph_mixgemm_f(const Ctx& C, int l) {
    const g8::DenseSched S{C.ws + WS_A2, C.ws + WS_WMIX + (size_t)l * 512 * 512 * 2, 512, 512, T / 256, 2, C.G, C.bid, 2};
    const g8::EpiBf16 E{WSP(bf16_t, WS_YMIX), 512, WSP(float, WS_PAR) + P_MIXB + l * 512};
    g8::gemm_phase<g8::EpiBf16, g8::DenseSched, G8_ALIGN, G8_SP2>(C.lds, 512, S, E);
}
__device__ __forceinline__ void ph_qkvgemm_f(const Ctx& C, int l) {
    { const g8::DenseSched S{C.ws + WS_Z + 768 * 2, C.ws + WS_WQ + (size_t)l * 768 * 256 * 2, DINP, 256, T / 256, 3, C.G, C.bid, 2};
      const g8::EpiBf16 E{WSP(bf16_t, WS_QRAW), 768, nullptr};
      g8::gemm_phase<g8::EpiBf16, g8::DenseSched, G8_ALIGN, G8_SP2>(C.lds, 256, S, E); }
    { const g8::DenseSched S{C.ws + WS_Z + 1024 * 2, C.ws + WS_WKV + (size_t)l * 1024 * 256 * 2, DINP, 256, T / 256, 4, C.G, C.bid, 2};
      const g8::EpiBf16 E{WSP(bf16_t, WS_KVRAW), 1024, nullptr};
      g8::gemm_phase<g8::EpiBf16, g8::DenseSched, G8_ALIGN, G8_SP2>(C.lds, 256, S, E); }
}
__device__ __forceinline__ void ph_smallgemm_f(const Ctx& C, int l) { ph_mixgemm_f(C, l); ph_qkvgemm_f(C, l); }
__device__ __forceinline__ void ph_outproj_f(const Ctx& C, int l) {
#if OUTPROJ_FP8
    const g8::DenseSched S{C.ws + WS_MIX, C.ws + WS_WO + (size_t)l * 1024 * 1024, 1024, 1024, T / 256, 4, C.G, C.bid, 1};
    const g8::EpiResF32 E{(l == 0) ? C.x : C.out, C.out, 1024, 1.f / 32.f};
    g8::gemm_phase<g8::EpiResF32, g8::DenseSched, G8_ALIGN, G8_SP2, true>(C.lds, 1024, S, E);
#else
    const g8::DenseSched S{C.ws + WS_MIX, C.ws + WS_WO + (size_t)l * 1024 * 1024 * 2, 1024, 1024, T / 256, 4, C.G, C.bid, 2};
    const g8::EpiResBf16 E{nullptr, WSP(bf16_t, WS_XB), WSP(bf16_t, WS_XB)};
    g8::gemm_phase<g8::EpiResBf16, g8::DenseSched, G8_ALIGN, G8_SP2>(C.lds, 1024, S, E);
#endif
}
template <int PM = 0> __device__ __forceinline__ void ph_gateup_f(const Ctx& C, int l) {
    moe_tables(C, l);
    LAS const int* ctl = (LAS const int*)(C.lds + LDS_CTL);
    LAS unsigned short* tokt = (LAS unsigned short*)(C.lds + LDS_TOKT); LAS float* btab = (LAS float*)(C.lds + LDS_BIAST); constexpr int NTAB = 28, NBT = 17;
    g8::MoeSched<true, 1024> S{C.ws + WS_HB8, C.ws + WS_WGU + (size_t)l * NEXP * 2048 * 1024, WSP(int, WS_LTOK), ctl, 8, C.G, C.bid, tokt, 0, 0};
    const float* bgu_l = WSP(float, WS_PAR) + P_BGU + (size_t)l * NEXP * 2048;
    int nu = 0;
    for (int i = 0; i < NTAB; ++i) { int pm, pn, e, rb; if (!S.locate(i, pm, pn, e, rb)) break; nu = i + 1;
        if (C.tid < 256) { const int li = (pm - rb) * 256 + C.tid, nv = ctl[e]; tokt[i * 256 + C.tid] = (unsigned short)S.ltok[(size_t)e * T + (li < nv ? li : nv - 1)]; }
        else if (i < NBT) btab[i * 256 + (C.tid - 256)] = bgu_l[(size_t)e * 2048 + pn * 256 + (C.tid - 256)]; }
    S.ntab = nu;
    __syncthreads();
    const g8::EpiGlu8 E{C.ws + (PM ? 1600 * MiB : WS_ACT), bgu_l, btab, nu < NBT ? nu : NBT};
    if constexpr (PM == 3) { const g8::MoeSched<false, 1024> S2{C.ws + WS_HB8, C.ws + WS_WGU + (size_t)l * NEXP * 2048 * 1024, WSP(int, WS_LTOK), ctl, 8, C.G, C.bid, nullptr, 0, PROBE_FIX};
        g8::gemm_phase<g8::EpiGlu8, g8::MoeSched<false, 1024>, G8_ALIGN, G8_SP2, true, 1>(C.lds, 1024, S2, E); }
    else g8::gemm_phase<g8::EpiGlu8, g8::MoeSched<true, 1024>, G8_ALIGN, G8_SP2, true, PM>(C.lds, 1024, S, E);
}
template <int PM = 0> __device__ __forceinline__ void ph_down_f(const Ctx& C, int l) {
    moe_tables(C, l);
    LAS const int* ctl = (LAS const int*)(C.lds + LDS_CTL);
    LAS float* btab = (LAS float*)(C.lds + LDS_BIAST); constexpr int NBT = 17;
    const g8::MoeSched<false, 1024> S{C.ws + WS_ACT, C.ws + WS_WD + (size_t)l * NEXP * 1024 * 1024, WSP(int, WS_LTOK), ctl, 4, C.G, C.bid, nullptr, 0, PM ? PROBE_FIX : 0};
    const float* bdn_l = WSP(float, WS_PAR) + P_BDN + (size_t)l * NEXP * 1024;
    int nu = 0;
    for (int i = 0; i < NBT; ++i) { int pm, pn, e, rb; if (!S.locate(i, pm, pn, e, rb)) break; nu = i + 1;
        if (C.tid < 256) btab[i * 256 + C.tid] = bdn_l[(size_t)e * 1024 + pn * 256 + C.tid]; }
    __syncthreads();
    const g8::EpiDown8 E{C.ws + (PM ? 1600 * MiB : WS_YB), bdn_l, btab, nu};
    g8::gemm_phase<g8::EpiDown8, g8::MoeSched<false, 1024>, G8_ALIGN, G8_SP2, true, PM>(C.lds, 1024, S, E);
}

#define XB_TMO      128
#define XB_XCNT(j)  (256  + 64 * (j))
#define XB_XSUB(j)  (1280 + 64 * (j))
#define XB_XGEN(j)  (2304 + 64 * (j))
#define XB_TOP      3328
#define XB_TOPGEN   3392
#define XCD_BAR_WORDS 3456
#define XB_SPIN_CAP (1u << 24)

__device__ __forceinline__ unsigned xb_ld(unsigned* p)              { return __hip_atomic_load(p, __ATOMIC_RELAXED, __HIP_MEMORY_SCOPE_AGENT); }
__device__ __forceinline__ unsigned xb_add(unsigned* p, unsigned v) { return __hip_atomic_fetch_add(p, v, __ATOMIC_RELAXED, __HIP_MEMORY_SCOPE_AGENT); }
__device__ __forceinline__ unsigned xb_xcc_id() { return (unsigned)__builtin_amdgcn_s_getreg((3 << 11) | 20) & 0xFu; }
#define XB_SPIN(cond, bar) do { unsigned _sp = 0; while (cond) { __builtin_amdgcn_s_sleep(1); \
    if ((++_sp & 255u) == 0u) { if (xb_ld(&(bar)[XB_TMO])) break; if (_sp > XB_SPIN_CAP) { atomicAdd(&(bar)[XB_TMO], 1u); break; } } } } while (0)

struct XcdBarrier {
    unsigned* bar; unsigned x;
    volatile LAS unsigned* st;
};

__device__ __forceinline__ XcdBarrier xcd_barrier_post(unsigned* bar, volatile LAS unsigned* st) {
    XcdBarrier b; b.bar = bar; b.x = xb_xcc_id(); b.st = st;
    if (threadIdx.x == 0) (void)xb_add(&bar[XB_XCNT(b.x)], 1u);
    return b;
}
__device__ __forceinline__ void xcd_barrier_complete(unsigned* bar, unsigned x, unsigned& nloc, unsigned& nx) {
    const unsigned G = gridDim.x * gridDim.y * gridDim.z;
    unsigned sum, cnt, mine, sp = 0u;
    for (;;) {
        sum = 0u; cnt = 0u; mine = 0u;
#pragma unroll
        for (unsigned j = 0; j < 16; ++j) { const unsigned c = xb_ld(&bar[XB_XCNT(j)]); sum += c; cnt += (c > 0u) ? 1u : 0u; mine = (j == x) ? c : mine; }
        if (sum == G) break;
        __builtin_amdgcn_s_sleep(1);
        if ((++sp & 255u) == 0u) { if (xb_ld(&bar[XB_TMO])) break; if (sp > XB_SPIN_CAP) { atomicAdd(&bar[XB_TMO], 1u); break; } }
    }
    nloc = mine > 0u ? mine : 1u; nx = cnt > 0u ? cnt : 1u;
}

__device__ __forceinline__ void xcd_barrier(const XcdBarrier& b) {
    asm volatile("s_waitcnt vmcnt(0)" ::: "memory");
    __syncthreads();
    if (threadIdx.x == 0) {
        unsigned* bar = b.bar;
        __builtin_amdgcn_s_waitcnt(0);
        unsigned nloc = b.st[0], nx = b.st[1];
        if (nloc == 0u) { xcd_barrier_complete(bar, b.x, nloc, nx); b.st[0] = nloc; b.st[1] = nx; }
        const unsigned old = xb_add(&bar[XB_XSUB(b.x)], 1u);
        const unsigned gen = old / nloc;
        if (old + 1u == (gen + 1u) * nloc) {
            __builtin_amdgcn_fence(__ATOMIC_RELEASE, "agent");
            asm volatile("s_waitcnt vmcnt(0)" ::: "memory");
            const unsigned og = xb_add(&bar[XB_TOP], 1u);
            const unsigned tg = og / nx;
            if (og + 1u == (tg + 1u) * nx) xb_add(&bar[XB_TOPGEN], 1u);
            else XB_SPIN(xb_ld(&bar[XB_TOPGEN]) == tg, bar);
            __builtin_amdgcn_fence(__ATOMIC_ACQUIRE, "agent");
            xb_add(&bar[XB_XGEN(b.x)], 1u);
            asm volatile("s_waitcnt vmcnt(0)" ::: "memory");
        } else {
            XB_SPIN(xb_ld(&bar[XB_XGEN(b.x)]) == gen, bar);
            __builtin_amdgcn_fence(__ATOMIC_ACQUIRE, "agent");
            asm volatile("s_waitcnt vmcnt(0)" ::: "memory");
        }
    }
    __syncthreads();
}

constexpr int NPH = 11;
struct Args { const float* in[N_IN]; float* out; unsigned char* ws; int ph_lo, ph_hi; };
__global__ void __launch_bounds__(NTHR, 2) fwd(Args args) {
    extern __shared__ __attribute__((aligned(16))) unsigned char lds_raw[];
    Ctx C;
    C.x = args.in[I_X]; C.out = args.out; C.ws = args.ws; C.lds = (LAS unsigned char*)lds_raw;
    C.tid = threadIdx.x; C.lane = C.tid & 63; C.wave = __builtin_amdgcn_readfirstlane(C.tid >> 6); C.G = gridDim.x; C.bid = blockIdx.x;
    const int lo = args.ph_lo, hi = args.ph_hi;
    if (C.tid < 4) ((LAS unsigned*)(C.lds + LDS_CTL))[160 + C.tid] = 0u;
    __syncthreads();
    XcdBarrier bar = xcd_barrier_post(WSP(unsigned, WS_CTL) + CW_BAR, (volatile LAS unsigned*)(C.lds + LDS_CTL) + 160);
#define IN(k) (lo <= (k) && (k) < hi)
#ifndef PROBE_DUP
#define PROBE_DUP 0
#endif
#ifndef PROBE_PM
#define PROBE_PM 0
#endif
#ifndef PROBE_BAR2
#define PROBE_BAR2 0
#endif
#define DUPN(bit) (((PROBE_DUP) >> (bit)) & 1 ? 2 : 1)
#define SEAM(k) do { if (IN(k) && IN((k) + 1)) { XcdBarrier b2_ = bar; unsigned long long p_ = (unsigned long long)b2_.bar; asm volatile("" : "+s"(p_)); b2_.bar = (unsigned*)p_; xcd_barrier(b2_); if (PROBE_BAR2) xcd_barrier(b2_); } } while (0)
    if (IN(0)) for (int r_ = 0; r_ < DUPN(0); ++r_) { const Ctx L = phase_enter(C); ph_prologue(L, args.in); }
    SEAM(0);
    for (int l = 0; l < NLAYER; ++l) {
        const int p0 = 1 + l * NPH;
        if (IN(p0 + 0)) for (int r_ = 0; r_ < (DUPN(1)); ++r_) { const Ctx L = phase_enter(C);
#if FAST_INPROJ
            ph_inproj_f(L, l);
#else
            ph_inproj(L, l);
#endif
        }
        SEAM(p0 + 0);
        if (IN(p0 + 1)) { for (int r_ = 0; r_ < (DUPN(2)); ++r_) { const Ctx L = phase_enter(C); if (r_ == 0 && DUPN(2) == 2 && PROBE_PM) ph_mix1<PROBE_PM>(L, l); else ph_mix1<0>(L, l); }
            for (int r_ = 0; r_ < (DUPN(3)); ++r_) { const Ctx L = phase_enter(C); ph_qkvgemm_f(L, l); } }
        SEAM(p0 + 1);
        if (IN(p0 + 2)) { for (int r_ = 0; r_ < (DUPN(3)); ++r_) { const Ctx L = phase_enter(C); ph_mixgemm_f(L, l); }
            for (int r_ = 0; r_ < (DUPN(4)); ++r_) { const Ctx L = phase_enter(C); if (r_ == 0 && DUPN(4) == 2 && PROBE_PM) ph_qkfin<PROBE_PM>(L, l); else ph_qkfin<0>(L, l); }
#if ATT_PV8
            { const Ctx L = phase_enter(C); ph_vtbuild(L, l); }
#endif
        }
        if (IN(p0 + 2) && !IN(p0 + 3)) {   }
        SEAM(p0 + 3);
                if (IN(p0 + 4)) for (int r_ = 0; r_ < (DUPN(5)); ++r_) { const Ctx L = phase_enter(C); ph_attn(L, l); }
        SEAM(p0 + 4);
        if (IN(p0 + 5)) for (int r_ = 0; r_ < (DUPN(6)); ++r_) { const Ctx L = phase_enter(C); ph_mixnorm(L, l); }
        SEAM(p0 + 5);
        if (IN(p0 + 6)) for (int r_ = 0; r_ < (l == 0 ? DUPN(7) : 1); ++r_) { const Ctx L = phase_enter(C);
#if FAST_OUTPROJ
            ph_outproj_f(L, l);
#else
            ph_outproj(L, l);
#endif
        }
        SEAM(p0 + 6);
        if (IN(p0 + 7)) { if (DUPN(10) == 2) { const Ctx L = phase_enter(C); ph_route(L, l, 1); } const Ctx L = phase_enter(C); ph_route(L, l); }
        SEAM(p0 + 7);
        if (IN(p0 + 8)) for (int r_ = 0; r_ < (DUPN(8)); ++r_) { const Ctx L = phase_enter(C);
#if FAST_GATEUP
            if (r_ == 0 && DUPN(8) == 2 && PROBE_PM) ph_gateup_f<PROBE_PM>(L, l); else ph_gateup_f<0>(L, l);
#else
            ph_gateup(L, l);
#endif
        }
        SEAM(p0 + 8);
        if (IN(p0 + 9)) for (int r_ = 0; r_ < (DUPN(9)); ++r_) { const Ctx L = phase_enter(C);
#if FAST_DOWN
            if (r_ == 0 && DUPN(9) == 2 && PROBE_PM) ph_down_f<PROBE_PM>(L, l); else ph_down_f<0>(L, l);
#else
            ph_down(L, l);
#endif
        }
        SEAM(p0 + 9);
        if (IN(p0 + 10)) { if (DUPN(11) == 2) { { const Ctx L = phase_enter(C); ph_combine(L, l, 0.5f); } xcd_barrier(bar); { const Ctx L = phase_enter(C); ph_combine(L, l, 0.5f); } } else { const Ctx L = phase_enter(C); ph_combine(L, l); } }
        SEAM(p0 + 10);
    }
#undef SEAM
#undef IN
}

extern "C" void kernel_launch(void* const* d_in, const int* in_sizes, int n_in, void* d_out, int out_size, void* d_ws, size_t ws_size, hipStream_t stream) {
    static int grid = 0;
    if (grid == 0) {
        if (n_in != N_IN || in_sizes[0] != T * DM || out_size != T * DM || ws_size < WS_END) {
            fprintf(stderr, "kernel_launch: shape mismatch (n_in %d, in0 %d, out %d, ws %zu need %zu)\n", n_in, n_in > 0 ? in_sizes[0] : -1, out_size, ws_size, (size_t)WS_END); grid = -1; return; }
        int dev = 0, cus = 0;
        if (hipGetDevice(&dev) != hipSuccess || hipDeviceGetAttribute(&cus, hipDeviceAttributeMultiprocessorCount, dev) != hipSuccess) { grid = -1; return; }
        if (hipFuncSetAttribute((const void*)fwd, hipFuncAttributeMaxDynamicSharedMemorySize, LDS_BYTES) != hipSuccess) { fprintf(stderr, "kernel_launch: hipFuncSetAttribute failed\n"); grid = -1; return; }
        if (cus < 160) { fprintf(stderr, "kernel_launch: built for a >= 160-CU device (per-workgroup unit tables); %d CUs\n", cus); grid = -1; return; }
        grid = cus;
    }
    if (grid < 0) return;
    (void)hipMemsetAsync((char*)d_ws + WS_CTL, 0, CTL_ZERO_BYTES, stream);
    Args a{};
    for (int i = 0; i < N_IN; ++i) a.in[i] = (const float*)d_in[i];
    a.out = (float*)d_out; a.ws = (unsigned char*)d_ws;
    const int nphase = 1 + NLAYER * NPH;
#if defined(MK_PER_PHASE)
    for (int p = 0; p < nphase; ++p) { a.ph_lo = p; a.ph_hi = p + 1; hipLaunchKernelGGL(fwd, dim3(grid), dim3(NTHR), LDS_BYTES, stream, a); }
#else
    a.ph_lo = 0; a.ph_hi = nphase;
    hipLaunchKernelGGL(fwd, dim3(grid), dim3(NTHR), LDS_BYTES, stream, a);
#endif
}
```

```cpp
#include <hip/hip_runtime.h>
#include <cstdio>
#include <cstdint>

#ifndef OUTPROJ_FP8
#define OUTPROJ_FP8 0
#endif
#ifndef PROBE_FIX
#define PROBE_FIX 0
#endif
#ifndef MOE_FP8
#define MOE_FP8 1
#define PV_PIPE 1
#define ATT_PV8 1
#define ATT_QK8 1
#endif
#define LAS __attribute__((address_space(3)))
typedef unsigned short bf16_t;
typedef short bf16x8 __attribute__((ext_vector_type(8)));
typedef float f32x4 __attribute__((ext_vector_type(4)));
typedef float f32x2 __attribute__((ext_vector_type(2)));
typedef unsigned u32x4 __attribute__((ext_vector_type(4)));
typedef unsigned u32x2 __attribute__((ext_vector_type(2)));

constexpr int T = 32768, DM = 1024, SEQ = 4096, NBATCH = 8, NLAYER = 2;
constexpr int DIN = 1216, DINP = 1280;
constexpr int NEXP = 32, TOPK = 4, DFF = 1024;
constexpr int MOE_ROWS = T * TOPK + NEXP * 256;
constexpr float EPS = 1e-6f;
constexpr int NTHR = 512, NWAVE = 8;

enum { I_X = 0, I_POS, I_ANG, I_WIN, I_POOLW, I_POOLS, I_CDW, I_CDWB, I_CLNG, I_CLNB, I_CPW, I_CPWB, I_QAG, I_WUQ, I_KVAG, I_WUKV,
       I_QNG, I_KNG, I_POG, I_COG, I_AOG, I_WO, I_FNG, I_WR, I_BR, I_WGU, I_BGU, I_WDN, I_BDN, N_IN };

constexpr size_t MiB = 1u << 20;
constexpr size_t WS_CTL = 0, CTL_ZERO_BYTES = 1 * MiB;
constexpr size_t WS_COS = 1 * MiB;
constexpr size_t WS_WIN = 9 * MiB;
constexpr size_t WS_WMIX = 14 * MiB;
constexpr size_t WS_WQ = 15 * MiB;
constexpr size_t WS_WKV = 16 * MiB;
constexpr size_t WS_WO = 17 * MiB;
constexpr size_t WS_WR = 21 * MiB;
constexpr size_t WS_WGU = 22 * MiB;
constexpr size_t WS_WD = 278 * MiB;
constexpr size_t WS_HB = 406 * MiB;
constexpr size_t WS_RS = 406 * MiB;
constexpr size_t WS_Z = 470 * MiB;
constexpr size_t WS_A2 = 550 * MiB;
constexpr size_t WS_YMIX = 582 * MiB;
constexpr size_t WS_QRAW = 614 * MiB;
constexpr size_t WS_KVRAW = 662 * MiB;
constexpr size_t WS_Q = 726 * MiB;
constexpr size_t WS_KIMG = 774 * MiB;
constexpr size_t WS_VIMG = 822 * MiB;
constexpr size_t WS_YATT = 854 * MiB;
constexpr size_t WS_MIX = 918 * MiB;
constexpr size_t WS_LTOK = 982 * MiB;
constexpr size_t WS_LGATE = 986 * MiB;
constexpr size_t WS_ASG = 990 * MiB;
constexpr size_t WS_PAR = 991 * MiB;
constexpr int P_CDW = 0, P_CDWB = 15872, P_CLNG = 16384, P_CLNB = 16896, P_CPWB = 17408, P_QNG = 17920, P_KNG = 18304, P_BR = 18688, P_MIXB = 19456, P_BGU = 20480, P_BDN = 151552, P_END = 217088;
static_assert((size_t)P_END * 4 <= 1 * MiB, "param area");
constexpr size_t WS_ACT = 992 * MiB;
constexpr size_t WS_YB = 1264 * MiB;
constexpr size_t WS_HB8 = 1536 * MiB;
constexpr size_t WS_XB = 1568 * MiB;
constexpr size_t WS_END = 1632 * MiB;
static_assert((size_t)MOE_ROWS * 1024 * 2 <= 272 * MiB, "act buffer");

constexpr int CW_BAR = 4096;
constexpr int CW_GCNT = 16384;

constexpr int LDS_BYTES = 163840;
constexpr int LDS_CTL = 162816;
constexpr int LDS_TOKT = 131072, LDS_BIAST = 131072 + 28 * 512;

__device__ __forceinline__ unsigned f2bf(float f) { unsigned u = __builtin_bit_cast(unsigned, f); return (u + 0x7fffu + ((u >> 16) & 1u)) >> 16; }
typedef __bf16 bf16x2_hw __attribute__((ext_vector_type(2)));
__device__ __forceinline__ unsigned pk2(float lo, float hi) { typedef float f2_ __attribute__((ext_vector_type(2))); const f2_ v = {lo, hi}; return __builtin_bit_cast(unsigned, __builtin_convertvector(v, bf16x2_hw)); }
__device__ __forceinline__ float bf2f(unsigned b) { return __builtin_bit_cast(float, b << 16); }
__device__ __forceinline__ float bflo(unsigned w) { return __builtin_bit_cast(float, w << 16); }
__device__ __forceinline__ float bfhi(unsigned w) { return __builtin_bit_cast(float, w & 0xffff0000u); }
__device__ __forceinline__ float wave_sum(float v) {
#pragma unroll
    for (int o = 1; o < 64; o <<= 1) v += __shfl_xor(v, o);
    return v;
}
__device__ __forceinline__ float grp16_sum(float v) {
#pragma unroll
    for (int o = 1; o < 16; o <<= 1) v += __shfl_xor(v, o);
    return v;
}
__device__ __forceinline__ unsigned pk4_fp8(float a, float b, float c, float d) { unsigned w = 0; w = __builtin_amdgcn_cvt_pk_fp8_f32(a, b, w, false); w = __builtin_amdgcn_cvt_pk_fp8_f32(c, d, w, true); return w; }
__device__ __forceinline__ float sigmoidf_(float x) { return 1.0f / (1.0f + __expf(-x)); }

struct Ctx {
    const float* x; float* out; unsigned char* ws; LAS unsigned char* lds;
    int tid, lane, wave, G, bid;
};
#define WSP(T_, off) ((T_*)(C.ws + (off)))
__device__ __forceinline__ Ctx phase_enter(const Ctx& C0) {
    Ctx C = C0; int t = threadIdx.x; asm volatile("" : "+v"(t)); C.tid = t; C.lane = t & 63; C.wave = __builtin_amdgcn_readfirstlane(t >> 6);
    unsigned long long w = (unsigned long long)C0.ws, o = (unsigned long long)C0.out, x = (unsigned long long)C0.x;
    asm volatile("" : "+s"(w), "+s"(o), "+s"(x));
    C.ws = (unsigned char*)(__attribute__((address_space(1))) unsigned char*)w; C.out = (float*)(__attribute__((address_space(1))) float*)o; C.x = (const float*)(const __attribute__((address_space(1))) float*)x; return C; }

__device__ __forceinline__ int kimg_off(int r, int c) { return (c >> 1) * 2048 + (c & 1) * 1024 + (r >> 5) * 512 + (r & 31) * 16; }
__device__ __forceinline__ int v_st(int k, int c) { const int kk = (k & ~0xC) | ((k & 4) << 1) | ((k & 8) >> 1); return ((kk >> 3) * 4 + (c >> 5)) * 512 + ((kk & 7) * 32 + (c & 31)) * 2; }

template <class RowMap>
__device__ __forceinline__ void tconv_item(const float* W, int N, int k0, int n0, const float* kscale, bf16_t* WT, int ldk, RowMap rm, LAS float* scr, int lane) {
#pragma unroll 8
    for (int i = 0; i < 32; ++i) { const int kk = 2 * i + (lane >> 5); float v = W[(size_t)(k0 + kk) * N + n0 + (lane & 31)]; if (kscale) v *= kscale[k0 + kk]; scr[kk * 33 + (lane & 31)] = v; }
    asm volatile("s_waitcnt lgkmcnt(0)" ::: "memory");
    const int c = lane & 7;
#pragma unroll
    for (int j = 0; j < 4; ++j) { const int n = (lane >> 3) + 8 * j; const LAS float* s = scr + (8 * c) * 33 + n;
        u32x4 o; o.x = pk2(s[0 * 33], s[1 * 33]); o.y = pk2(s[2 * 33], s[3 * 33]); o.z = pk2(s[4 * 33], s[5 * 33]); o.w = pk2(s[6 * 33], s[7 * 33]);
        *(u32x4*)(WT + (size_t)rm(n0 + n) * ldk + k0 + 8 * c) = o; }
    asm volatile("s_waitcnt lgkmcnt(0)" ::: "memory");
}
template <class RowMap>
__device__ __forceinline__ void tconv128_item(const float* W, int N, int k0, int n0, const float* kscale, bf16_t* WT, int ldk, RowMap rm, LAS unsigned* scr, int lane) {
    const float* src = W + (size_t)k0 * N + n0 + 2 * lane;
#pragma unroll 8
    for (int kp = 0; kp < 32; ++kp) {
        const f32x2 r0 = *(const f32x2*)(src + (size_t)(2 * kp) * N), r1 = *(const f32x2*)(src + (size_t)(2 * kp + 1) * N);
        const float s0 = kscale ? kscale[k0 + 2 * kp] : 1.f, s1 = kscale ? kscale[k0 + 2 * kp + 1] : 1.f;
        scr[(2 * lane) * 33 + kp] = pk2(r0.x * s0, r1.x * s1); scr[(2 * lane + 1) * 33 + kp] = pk2(r0.y * s0, r1.y * s1); }
    asm volatile("s_waitcnt lgkmcnt(0)" ::: "memory");
    const int c = lane & 7;
#pragma unroll 4
    for (int j = 0; j < 16; ++j) { const int n = (lane >> 3) + 8 * j; const LAS unsigned* p = scr + n * 33 + 4 * c;
        *(u32x4*)(WT + (size_t)rm(n0 + n) * ldk + k0 + 8 * c) = (u32x4){p[0], p[1], p[2], p[3]}; }
    asm volatile("s_waitcnt lgkmcnt(0)" ::: "memory");
}
template <class RowMap>
__device__ __forceinline__ void tconv128_f8_item(const float* W, int N, int k0, int n0, const float* kscale, float wscale, unsigned char* WT, int ldk, RowMap rm, LAS unsigned* scr, int lane) {
    const float* src = W + (size_t)k0 * N + n0 + 2 * lane;
#pragma unroll 8
    for (int kq = 0; kq < 32; ++kq) {
        const f32x2 r0 = *(const f32x2*)(src + (size_t)(4 * kq) * N), r1 = *(const f32x2*)(src + (size_t)(4 * kq + 1) * N), r2 = *(const f32x2*)(src + (size_t)(4 * kq + 2) * N), r3 = *(const f32x2*)(src + (size_t)(4 * kq + 3) * N);
        float s0 = wscale, s1 = wscale, s2 = wscale, s3 = wscale;
        if (kscale) { s0 *= kscale[k0 + 4 * kq]; s1 *= kscale[k0 + 4 * kq + 1]; s2 *= kscale[k0 + 4 * kq + 2]; s3 *= kscale[k0 + 4 * kq + 3]; }
        scr[(2 * lane) * 33 + kq] = pk4_fp8(r0.x * s0, r1.x * s1, r2.x * s2, r3.x * s3); scr[(2 * lane + 1) * 33 + kq] = pk4_fp8(r0.y * s0, r1.y * s1, r2.y * s2, r3.y * s3); }
    asm volatile("s_waitcnt lgkmcnt(0)" ::: "memory");
    const int c = lane & 7;
#pragma unroll 4
    for (int j = 0; j < 16; ++j) { const int n = (lane >> 3) + 8 * j; const LAS unsigned* p = scr + n * 33 + 4 * c;
        *(u32x4*)(WT + (size_t)rm(n0 + n) * ldk + k0 + 16 * c) = (u32x4){p[0], p[1], p[2], p[3]}; }
    asm volatile("s_waitcnt lgkmcnt(0)" ::: "memory");
}
struct RmId { __device__ __forceinline__ int operator()(int n) const { return n; } };
struct RmGu { __device__ __forceinline__ int operator()(int n) const { const int j = n >> 1, half = n & 1; return ((j >> 7) << 8) + (half << 7) + (j & 127); } };

struct Args;
__device__ __forceinline__ void ph_prologue(const Ctx& C, const float* const* in_) {
#define PIN(i) (in_[i])
    LAS float* scr = (LAS float*)(C.lds + C.wave * 16384);
    const int gw = C.bid * NWAVE + C.wave, NGW = C.G * NWAVE;
    constexpr int I_IN = 16 * 38, I_O = 16 * 32;
    constexpr int N_IN_ = NLAYER * I_IN, N_O_ = NLAYER * I_O;
    for (int it = gw; it < N_IN_ + N_O_; it += NGW) {
        int r = it;
        if (r < N_IN_) { const int l = r / I_IN, q = r % I_IN, kb = q / 38, nb = q % 38;
            tconv_item(PIN(I_WIN) + (size_t)l * 1024 * DIN, DIN, kb * 64, nb * 32, PIN(I_ANG) + l * 1024, WSP(bf16_t, WS_WIN) + (size_t)l * DINP * 1024, 1024, RmId(), scr, C.lane); continue; }
        r -= N_IN_;
#if !OUTPROJ_FP8
        { const int l = r / I_O, q = r % I_O, kb = q / 32, nb = q % 32, k0 = kb * 64;
            const float* ks = (k0 < 256) ? (PIN(I_POG) + l * 256) : (k0 < 512) ? (PIN(I_COG) + l * 256 - 256) : (PIN(I_AOG) + l * 512 - 512);
            tconv_item(PIN(I_WO) + (size_t)l * 1024 * 1024, 1024, k0, nb * 32, ks, WSP(bf16_t, WS_WO) + (size_t)l * 1024 * 1024, 1024, RmId(), scr, C.lane); }
#endif
    }
    __syncthreads();
    { LAS unsigned* scr2 = (LAS unsigned*)(C.lds + C.wave * 16896);
#if OUTPROJ_FP8
      for (int it = gw; it < NLAYER * 64; it += NGW) { const int l = it >> 6, q = it & 63, kb = q >> 3, nb = q & 7, k0 = kb * 128;
          const float* ks = (k0 < 256) ? (PIN(I_POG) + l * 256) : (k0 < 512) ? (PIN(I_COG) + l * 256 - 256) : (PIN(I_AOG) + l * 512 - 512);
          tconv128_f8_item(PIN(I_WO) + (size_t)l * 1024 * 1024, 1024, k0, nb * 128, ks, 32.f, C.ws + WS_WO + (size_t)l * 1024 * 1024, 1024, RmId(), scr2, C.lane); }
#endif
#if MOE_FP8
      constexpr int I_GU = 8 * 16, I_DN = 8 * 8;
      constexpr int N_GU_ = NLAYER * NEXP * I_GU, N_DN_ = NLAYER * NEXP * I_DN;
      for (int it = gw; it < N_GU_ + N_DN_; it += NGW) {
        if (it < N_GU_) { const int le = it / I_GU, q = it % I_GU, kb = q / 16, nb = q % 16, l = le / NEXP;
            tconv128_f8_item(PIN(I_WGU) + (size_t)le * 1024 * 2048, 2048, kb * 128, nb * 128, PIN(I_FNG) + l * 1024, 32.f, C.ws + WS_WGU + (size_t)le * 2048 * 1024, 1024, RmGu(), scr2, C.lane);
        } else { const int r = it - N_GU_, le = r / I_DN, q = r % I_DN, kb = q / 8, nb = q % 8;
            tconv128_f8_item(PIN(I_WDN) + (size_t)le * 1024 * 1024, 1024, kb * 128, nb * 128, nullptr, 32.f, C.ws + WS_WD + (size_t)le * 1024 * 1024, 1024, RmId(), scr2, C.lane); }
      } }
#else
      constexpr int I_GU = 16 * 16, I_DN = 16 * 8;
      constexpr int N_GU_ = NLAYER * NEXP * I_GU, N_DN_ = NLAYER * NEXP * I_DN;
      for (int it = gw; it < N_GU_ + N_DN_; it += NGW) {
        if (it < N_GU_) { const int le = it / I_GU, q = it % I_GU, kb = q / 16, nb = q % 16, l = le / NEXP;
            tconv128_item(PIN(I_WGU) + (size_t)le * 1024 * 2048, 2048, kb * 64, nb * 128, PIN(I_FNG) + l * 1024, WSP(bf16_t, WS_WGU) + (size_t)le * 2048 * 1024, 1024, RmGu(), scr2, C.lane);
        } else { const int r = it - N_GU_, le = r / I_DN, q = r % I_DN, kb = q / 8, nb = q % 8;
            tconv128_item(PIN(I_WDN) + (size_t)le * 1024 * 1024, 1024, kb * 64, nb * 128, nullptr, WSP(bf16_t, WS_WD) + (size_t)le * 1024 * 1024, 1024, RmId(), scr2, C.lane); }
      } }
#endif
    const int gt = C.bid * NTHR + C.tid, NGT = C.G * NTHR;
    for (int i = gt; i < NLAYER * 512 * 512; i += NGT) {
        const int l = i / (512 * 512), n = (i / 512) % 512, k = i % 512; float v = 0.f;
        if (n < 256) { const int g = n >> 6, d = n & 63; if (k < 256 && (k >> 6) == g) v = PIN(I_POOLW)[((size_t)(l * 4 + g) * 64 + (k & 63)) * 64 + d] * PIN(I_POOLS)[l * 256 + n]; }
        else { if (k >= 256) v = PIN(I_CPW)[((size_t)l * 256 + (k - 256)) * 256 + (n - 256)]; }
        WSP(bf16_t, WS_WMIX)[i] = (bf16_t)f2bf(v);
    }
    for (int i = gt; i < NLAYER * 768 * 256; i += NGT) {
        const int l = i / (768 * 256), n = (i / 256) % 768, k = i % 256;
        WSP(bf16_t, WS_WQ)[i] = (bf16_t)f2bf(PIN(I_WUQ)[((size_t)l * 256 + k) * 768 + n] * PIN(I_QAG)[l * 256 + k]);
    }
    for (int i = gt; i < NLAYER * 1024 * 256; i += NGT) {
        const int l = i / (1024 * 256), n = (i / 256) % 1024, k = i % 256;
        WSP(bf16_t, WS_WKV)[i] = (bf16_t)(k < 128 ? f2bf(PIN(I_WUKV)[((size_t)l * 128 + k) * 1024 + n] * PIN(I_KVAG)[l * 128 + k]) : 0u);
    }
    for (int i = gt; i < NLAYER * 32 * 1024; i += NGT) {
        const int l = i / (32 * 1024), e = (i / 1024) % 32, k = i % 1024;
        const float wv = PIN(I_WR)[((size_t)l * 1024 + k) * 32 + e] * PIN(I_FNG)[l * 1024 + k];
        const unsigned hi = f2bf(wv); const float rem = wv - bf2f(hi);
        WSP(bf16_t, WS_WR)[((size_t)(l * 2 + 0) * 32 + e) * 1024 + k] = (bf16_t)hi; WSP(bf16_t, WS_WR)[((size_t)(l * 2 + 1) * 32 + e) * 1024 + k] = (bf16_t)f2bf(rem);
    }
    for (int i = gt; i < NLAYER * 64 * 1024; i += NGT) {
        const int l = i / (64 * 1024), r = (i / 1024) % 64, k = i % 1024;
        WSP(bf16_t, WS_WIN)[((size_t)l * DINP + DIN + r) * 1024 + k] = 0;
    }
    { float* P = WSP(float, WS_PAR);
      for (int i = gt; i < 2 * 31 * 256; i += NGT) P[P_CDW + i] = PIN(I_CDW)[i];
      for (int i = gt; i < 512; i += NGT) { P[P_CDWB + i] = PIN(I_CDWB)[i]; P[P_CLNG + i] = PIN(I_CLNG)[i]; P[P_CLNB + i] = PIN(I_CLNB)[i]; P[P_CPWB + i] = PIN(I_CPWB)[i]; }
      for (int i = gt; i < 384; i += NGT) { P[P_QNG + i] = PIN(I_QNG)[i]; P[P_KNG + i] = PIN(I_KNG)[i]; }
      for (int i = gt; i < 64; i += NGT) P[P_BR + i] = PIN(I_BR)[i];
      for (int i = gt; i < 1024; i += NGT) { const int l_ = i >> 9, n_ = i & 511; P[P_MIXB + i] = (n_ >= 256) ? PIN(I_CPWB)[l_ * 256 + n_ - 256] : 0.f; }
      for (int i = gt; i < 2 * 32 * 2048; i += NGT) P[P_BGU + i] = PIN(I_BGU)[i];
      for (int i = gt; i < 2 * 32 * 1024; i += NGT) P[P_BDN + i] = PIN(I_BDN)[i]; }
    const float invf = (float)exp(-9.210340371976184 * (double)(gt & 31) / 32.0);
    for (int i = gt; i < T * 32; i += NGT) {
        const int t = i >> 5;
        const float ang = (float)((const int*)PIN(I_POS))[t] * invf;
        double r = (double)ang; r = r - 6.283185307179586476925 * rint(r * 0.15915494309189533577);
        const float rf = (float)r;
        WSP(f32x2, WS_COS)[i] = (f32x2){cosf(rf), sinf(rf)};
    }
    f32x4 vn[4], vn2[4];
    if (gw < T) { const f32x4* xr = (const f32x4*)(PIN(I_X) + (size_t)gw * DM) + C.lane;
#pragma unroll
        for (int j = 0; j < 4; ++j) { vn[j] = xr[64 * j]; vn2[j] = vn[j]; } }
    if (gw + NGW < T) { const f32x4* xr = (const f32x4*)(PIN(I_X) + (size_t)(gw + NGW) * DM) + C.lane;
#pragma unroll
        for (int j = 0; j < 4; ++j) vn2[j] = xr[64 * j]; }
    for (int m = gw; m < T; m += NGW) {
        f32x4 v[4]; float s = 0.f;
#pragma unroll
        for (int j = 0; j < 4; ++j) { v[j] = vn[j]; vn[j] = vn2[j]; s += (v[j].x * v[j].x + v[j].y * v[j].y) + (v[j].z * v[j].z + v[j].w * v[j].w); }
        if (m + 2 * NGW < T) { const f32x4* xr = (const f32x4*)(PIN(I_X) + (size_t)(m + 2 * NGW) * DM) + C.lane;
#pragma unroll
            for (int j = 0; j < 4; ++j) vn2[j] = xr[64 * j]; }
        const float rs = rsqrtf(wave_sum(s) * (1.f / DM) + EPS);
        u32x2* o = (u32x2*)(WSP(bf16_t, WS_XB) + (size_t)m * DM) + C.lane;
#pragma unroll
        for (int j = 0; j < 4; ++j) o[64 * j] = (u32x2){pk2(v[j].x, v[j].y), pk2(v[j].z, v[j].w)};
        if (C.lane == 0) WSP(float, WS_RS)[m] = rs;
    }
}
#undef PIN

template <int NBT, class RowPtr, class Epi>
__device__ __forceinline__ void sg_tile(const Ctx& C, RowPtr rowptr, const bf16_t* Bt0, const bf16_t* Bt1, int K, Epi epi) {
    constexpr int LDR = 40;
    LAS bf16_t* SA = (LAS bf16_t*)C.lds; LAS bf16_t* SB = SA + 128 * LDR;
    const int tid = C.tid, lane = C.lane, wid = C.wave, wr = wid >> 1, wc = wid & 1, fr = lane & 15, fq = lane >> 4;
    const int sr = tid >> 2, sc = (tid & 3) * 8;
    const bf16_t* ap = rowptr(sr) + sc;
    const bf16_t* bp0 = Bt0 + (size_t)sr * K + sc; const bf16_t* bp1 = (NBT == 2) ? (Bt1 + (size_t)sr * K + sc) : bp0;
    f32x4 acc[NBT][2][4];
#pragma unroll
    for (int b = 0; b < NBT; ++b)
#pragma unroll
        for (int m = 0; m < 2; ++m)
#pragma unroll
            for (int n = 0; n < 4; ++n) acc[b][m][n] = (f32x4){0.f, 0.f, 0.f, 0.f};
    for (int kt = 0; kt < K / 32; ++kt) {
        const bf16x8 av = *(const bf16x8*)(ap + kt * 32); const bf16x8 bv0 = *(const bf16x8*)(bp0 + kt * 32); bf16x8 bv1 = bv0; if (NBT == 2) bv1 = *(const bf16x8*)(bp1 + kt * 32);
        __syncthreads();
        *(LAS bf16x8*)(SA + sr * LDR + sc) = av; *(LAS bf16x8*)(SB + sr * LDR + sc) = bv0; if (NBT == 2) *(LAS bf16x8*)(SB + (128 + sr) * LDR + sc) = bv1;
        __syncthreads();
        bf16x8 a[2], b[NBT][4];
#pragma unroll
        for (int m = 0; m < 2; ++m) a[m] = *(const LAS bf16x8*)(SA + (wr * 32 + m * 16 + fr) * LDR + fq * 8);
#pragma unroll
        for (int bt = 0; bt < NBT; ++bt)
#pragma unroll
            for (int n = 0; n < 4; ++n) b[bt][n] = *(const LAS bf16x8*)(SB + (bt * 128 + wc * 64 + n * 16 + fr) * LDR + fq * 8);
#pragma unroll
        for (int bt = 0; bt < NBT; ++bt)
#pragma unroll
            for (int m = 0; m < 2; ++m)
#pragma unroll
                for (int n = 0; n < 4; ++n) acc[bt][m][n] = __builtin_amdgcn_mfma_f32_16x16x32_bf16(a[m], b[bt][n], acc[bt][m][n], 0, 0, 0);
    }
#pragma unroll
    for (int m = 0; m < 2; ++m)
#pragma unroll
        for (int n = 0; n < 4; ++n)
#pragma unroll
            for (int j = 0; j < 4; ++j) {
                const int r = wr * 32 + m * 16 + fq * 4 + j, c = wc * 64 + n * 16 + fr;
                if (NBT == 2) epi(r, c, acc[0][m][n][j], acc[NBT - 1][m][n][j]); else epi(r, c, acc[0][m][n][j], 0.f);
            }
    __syncthreads();
}


namespace g8 {
constexpr int BM = 256, BK = 64, HALF = 128, HTB = HALF * BK * 2, STAGE_BYTES = 8 * HTB;
__device__ __forceinline__ int lds_byte(int r, int c) { const int st = (r >> 4) * 2 + (c >> 5), rr = r & 15, cc = c & 31, ob = rr * 64 + cc * 2; return st * 1024 + (ob ^ (((ob >> 9) & 1) << 5)); }
__device__ __forceinline__ void stage_rc(int b, int& R, int& Cc) { const int st = b / 1024, sb = b % 1024, swz = sb ^ (((sb >> 9) & 1) << 5); R = (st >> 1) * 16 + swz / 64; Cc = (st & 1) * 32 + (swz % 64) / 2; }
__device__ __forceinline__ int perm32(int rho) { const int n = rho >> 4, i = rho & 15; return 8 * (i >> 2) + 4 * n + (i & 3); }
__device__ __forceinline__ int h8(int x) { return (int)((0x64753120u >> (4 * x)) & 7u); }
template <bool F8> __device__ __forceinline__ void stage_map(int b, int& R, int& Cc) {
    if constexpr (F8) { const int q = b >> 4; R = q >> 3; Cc = ((q & 7) ^ h8((R >> 1) & 7)) * 8; } else stage_rc(b, R, Cc); }
struct GUnit { const unsigned char* A; const unsigned char* B; int row0, col0, e, aux; };
__device__ __forceinline__ void tile_of(int L, int nM, int nN, int& pm, int& pn) {
    const int nwg = nM * nN; int wgid = L; { const int q = nwg / 8, r = nwg % 8, xcd = wgid % 8, off = wgid / 8; wgid = (xcd < r ? xcd * (q + 1) : r * (q + 1) + (xcd - r) * q) + off; }
    const int nig = 8 * nN, gid = wgid / nig, fm = gid * 8, gsz = (nM - fm) < 8 ? (nM - fm) : 8;
    pm = fm + ((wgid % nig) % gsz); pn = (wgid % nig) / gsz;
}
typedef int v8i_t __attribute__((ext_vector_type(8)));
typedef int v4i_t __attribute__((ext_vector_type(4)));
__device__ __forceinline__ v8i_t cat8(bf16x8 lo, bf16x8 hi) { return __builtin_shufflevector(__builtin_bit_cast(v4i_t, lo), __builtin_bit_cast(v4i_t, hi), 0, 1, 2, 3, 4, 5, 6, 7); }
__device__ __forceinline__ void mfma_f8(f32x4& acc, v8i_t a, v8i_t b) { asm("s_nop 1\n\tv_mfma_f32_16x16x128_f8f6f4 %0, %1, %2, %0" : "+v"(acc) : "v"(a), "v"(b)); }
template <class Epi, class Sched, bool ALIGN_EPI, bool SP2, bool F8 = false, int PM = 0>
__device__ __forceinline__ void gemm_phase(LAS unsigned char* lds, const int K, const Sched& S, const Epi& E) {
    constexpr int ES = F8 ? 1 : 2;
    int tid = threadIdx.x; asm volatile("" : "+v"(tid));
    const int wid = __builtin_amdgcn_readfirstlane(tid >> 6), lane = tid & 63, wr = wid >> 2, wc = wid & 3, fr = lane & 15, fq = lane >> 4;
    const int nt = (PM == 2) ? 4 : K * ES / 128;
    unsigned voffB[2];
#pragma unroll
    for (int i = 0; i < 2; ++i) { int R, Cc; stage_map<F8>(tid * 16 + i * 8192, R, Cc); const int Rb = (Epi::PERM == 1) ? ((R & ~31) + perm32(R & 31)) : (Epi::PERM == 2) ? (64 * (R >> 5) + 16 * ((R >> 2) & 3) + 4 * ((R >> 4) & 1) + (R & 3)) : R;
        voffB[i] = (unsigned)(Rb * K * ES + Cc * 2); }
#define PG8_LOAD_IDS(U) do { int tz_ = threadIdx.x; asm volatile("" : "+v"(tz_)); int R0_, C0_, R1_, C1_; stage_map<F8>(tz_ * 16, R0_, C0_); stage_map<F8>(tz_ * 16 + 8192, R1_, C1_); \
        id00 = S.rowid(U, R0_); id01 = S.rowid(U, R1_); id10 = S.rowid(U, HALF + R0_); id11 = S.rowid(U, HALF + R1_); } while (0)
#define PG8_IDS_TO_VA() do { int tz_ = threadIdx.x; asm volatile("" : "+v"(tz_)); int R0_, C0_, R1_, C1_; stage_map<F8>(tz_ * 16, R0_, C0_); stage_map<F8>(tz_ * 16 + 8192, R1_, C1_); \
        va00 = S.idoff(id00) + (unsigned)C0_ * 2u; va01 = S.idoff(id01) + (unsigned)C1_ * 2u; va10 = S.idoff(id10) + (unsigned)C0_ * 2u; va11 = S.idoff(id11) + (unsigned)C1_ * 2u; } while (0)
    const size_t kstep = (size_t)(BK * 2);
    const size_t hstepB = (size_t)(Epi::PERM == 2 ? 8 : HALF) * K * ES;
    const unsigned ldsw = (unsigned)wid * 1024u;
    const int aoff = F8 ? ((wr * 64 + fr) * 128 + 16 * ((2 * fq) ^ h8((fr >> 1) & 7))) : lds_byte(wr * 64 + fr, fq * 8), boff = F8 ? ((wc * 32 + fr) * 128 + 16 * ((2 * fq) ^ h8((fr >> 1) & 7))) : lds_byte(wc * 32 + fr, fq * 8);
    const int aoff1 = F8 ? (aoff ^ 16) : (aoff + 1024), boff1 = F8 ? (boff ^ 16) : (boff + 1024);
#define PG8_SA(b, h) (((b) * 2 + (h)) * HTB)
#define PG8_SB(b, h) ((4 + (b) * 2 + (h)) * HTB)
#define PG8_STAGE2(bufoff, gbase, v0, v1) do { \
        __builtin_amdgcn_global_load_lds((const unsigned*)((const unsigned char*)(gbase) + (v0)), (LAS unsigned*)(lds + (bufoff) + ldsw), 16, 0, 0); \
        __builtin_amdgcn_global_load_lds((const unsigned*)((const unsigned char*)(gbase) + (v1)), (LAS unsigned*)(lds + (bufoff) + ldsw + 8192), 16, 0, 0); } while (0)
#define PG8_STAGE_B(bufoff, gbase) PG8_STAGE2(bufoff, gbase, voffB[0], voffB[1])
#define PG8_LDA(dst, b, h) do { _Pragma("unroll") for (int m = 0; m < 4; ++m) _Pragma("unroll") for (int k = 0; k < 2; ++k) dst[m][k] = *(const LAS bf16x8*)(lds + PG8_SA(b, h) + (k ? aoff1 : aoff) + m * 2048); } while (0)
#define PG8_LDB(dst, b, h) do { _Pragma("unroll") for (int n = 0; n < 2; ++n) _Pragma("unroll") for (int k = 0; k < 2; ++k) dst[n][k] = *(const LAS bf16x8*)(lds + PG8_SB(b, h) + (k ? boff1 : boff) + n * 2048); } while (0)
#define PG8_MMA(ai, bj, At, Bt) do { __builtin_amdgcn_s_setprio(1); if constexpr (F8) { _Pragma("unroll") for (int m = 0; m < 4; ++m) _Pragma("unroll") for (int n = 0; n < 2; ++n) \
        mfma_f8(acc[ai][bj][m][n], cat8(Bt[n][0], Bt[n][1]), cat8(At[m][0], At[m][1])); } else { \
        _Pragma("unroll") for (int m = 0; m < 4; ++m) _Pragma("unroll") for (int n = 0; n < 2; ++n) _Pragma("unroll") for (int k = 0; k < 2; ++k) \
        acc[ai][bj][m][n] = __builtin_amdgcn_mfma_f32_16x16x32_bf16(Bt[n][k], At[m][k], acc[ai][bj][m][n], 0, 0, 0); } __builtin_amdgcn_s_setprio(0); } while (0)
#define PG8_WAIT_V(n) asm volatile("s_waitcnt vmcnt(" #n ")" ::: "memory")
#define PG8_WAIT_L(n) asm volatile("s_waitcnt lgkmcnt(" #n ")" ::: "memory")
#define PG8_BAR __builtin_amdgcn_s_barrier()
#define PG8_SCHED __builtin_amdgcn_sched_barrier(0)
    GUnit cur, nxt; int ui = 0;
    if (!S.next(0, cur)) return;
    f32x4 acc[2][2][4][2];
#pragma unroll
    for (int a = 0; a < 2; ++a)
#pragma unroll
        for (int b = 0; b < 2; ++b)
#pragma unroll
            for (int m = 0; m < 4; ++m)
#pragma unroll
                for (int n = 0; n < 2; ++n) acc[a][b][m][n] = (f32x4){0.f, 0.f, 0.f, 0.f};
    bf16x8 At[4][2], B0[2][2], B1[2][2];
    const unsigned char* cA = cur.A; const unsigned char* cB = cur.B;
    unsigned va00, va01, va10, va11; int id00, id01, id10, id11; PG8_LOAD_IDS(cur); PG8_IDS_TO_VA();
    if constexpr (SP2) {
        PG8_STAGE_B(PG8_SB(0, 0), cB); PG8_STAGE_B(PG8_SB(0, 1), cB + hstepB); PG8_STAGE2(PG8_SA(0, 0), cA, va00, va01); PG8_STAGE2(PG8_SA(0, 1), cA, va10, va11);
        if (wr == 1) PG8_BAR;
        PG8_WAIT_V(2); PG8_BAR;
        PG8_STAGE_B(PG8_SB(1, 0), cB + kstep); PG8_STAGE2(PG8_SA(1, 0), cA + kstep, va00, va01); PG8_STAGE_B(PG8_SB(1, 1), cB + hstepB + kstep);
        PG8_WAIT_V(6); PG8_BAR;
    } else {
        PG8_STAGE_B(PG8_SB(0, 0), cB); PG8_STAGE2(PG8_SA(0, 0), cA, va00, va01); PG8_STAGE_B(PG8_SB(0, 1), cB + hstepB); PG8_STAGE2(PG8_SA(0, 1), cA, va10, va11);
        if (wr == 1) PG8_BAR;
        PG8_WAIT_V(4); PG8_BAR;
        PG8_STAGE_B(PG8_SB(1, 0), cB + kstep); PG8_STAGE2(PG8_SA(1, 0), cA + kstep, va00, va01); PG8_STAGE_B(PG8_SB(1, 1), cB + hstepB + kstep);
        PG8_WAIT_V(6); PG8_BAR;
    }
    for (;;) {
        const bool has_next = S.next(ui + 1, nxt);
        const unsigned char* nA = has_next ? nxt.A : cA; const unsigned char* nB = has_next ? nxt.B : cB;
        if (has_next) PG8_LOAD_IDS(nxt);
        for (int t = 0; t < nt; t += 2) {
            const bool last = (t == nt - 2);
            const unsigned char* a1 = cA + (size_t)(t + 1) * kstep;
            PG8_STAGE2(PG8_SA(1, 1), a1, va10, va11);
            if (last && has_next) PG8_IDS_TO_VA();
            const unsigned char* a2 = last ? nA : cA + (size_t)(t + 2) * kstep; const unsigned char* b2 = last ? nB : cB + (size_t)(t + 2) * kstep;
            const unsigned char* a3 = a2 + kstep; const unsigned char* b3 = b2 + kstep;
            if constexpr (SP2) {
            PG8_LDB(B0, 0, 0); PG8_LDB(B1, 0, 1); PG8_SCHED; PG8_LDA(At, 0, 0);
            PG8_WAIT_V(8); PG8_WAIT_L(0); PG8_BAR; PG8_MMA(0, 0, At, B0); PG8_MMA(0, 1, At, B1); PG8_BAR; PG8_SCHED;
            PG8_LDA(At, 0, 1); PG8_STAGE_B(PG8_SB(0, 0), b2); PG8_STAGE_B(PG8_SB(0, 1), b2 + hstepB); PG8_STAGE2(PG8_SA(0, 0), a2, va00, va01);
            PG8_WAIT_V(8); PG8_WAIT_L(0); PG8_BAR; PG8_MMA(1, 0, At, B0); PG8_MMA(1, 1, At, B1); PG8_BAR; PG8_SCHED;
            PG8_LDB(B0, 1, 0); PG8_LDB(B1, 1, 1); PG8_SCHED; PG8_LDA(At, 1, 0); PG8_STAGE2(PG8_SA(0, 1), a2, va10, va11);
            PG8_WAIT_V(8); PG8_WAIT_L(0); PG8_BAR; PG8_MMA(0, 0, At, B0); PG8_MMA(0, 1, At, B1); PG8_BAR; PG8_SCHED;
            PG8_LDA(At, 1, 1); PG8_STAGE_B(PG8_SB(1, 0), b3); PG8_STAGE_B(PG8_SB(1, 1), b3 + hstepB); PG8_STAGE2(PG8_SA(1, 0), a3, va00, va01);
            PG8_WAIT_V(8); PG8_WAIT_L(0); PG8_BAR; PG8_MMA(1, 0, At, B0); PG8_MMA(1, 1, At, B1); PG8_BAR; PG8_SCHED;
            } else {
            PG8_LDB(B0, 0, 0); PG8_SCHED; PG8_LDA(At, 0, 0);
            PG8_WAIT_L(8); PG8_BAR; PG8_WAIT_L(0); PG8_MMA(0, 0, At, B0); PG8_BAR; PG8_SCHED;
            PG8_LDB(B1, 0, 1); PG8_STAGE_B(PG8_SB(0, 0), b2);
            PG8_BAR; PG8_WAIT_L(0); PG8_MMA(0, 1, At, B1); PG8_BAR;
            PG8_LDA(At, 0, 1); PG8_STAGE2(PG8_SA(0, 0), a2, va00, va01);
            PG8_BAR; PG8_WAIT_L(0); PG8_MMA(1, 0, At, B0); PG8_BAR; PG8_SCHED;
            PG8_STAGE_B(PG8_SB(0, 1), b2 + hstepB);
            PG8_WAIT_V(6); PG8_BAR; PG8_MMA(1, 1, At, B1); PG8_BAR;
            PG8_LDB(B0, 1, 0); PG8_SCHED; PG8_LDA(At, 1, 0); PG8_STAGE2(PG8_SA(0, 1), a2, va10, va11);
            PG8_WAIT_L(8); PG8_BAR; PG8_WAIT_L(0); PG8_MMA(0, 0, At, B0); PG8_BAR; PG8_SCHED;
            PG8_LDB(B1, 1, 1); PG8_STAGE_B(PG8_SB(1, 0), b3);
            PG8_BAR; PG8_WAIT_L(0); PG8_MMA(0, 1, At, B1); PG8_BAR;
            PG8_LDA(At, 1, 1); PG8_STAGE2(PG8_SA(1, 0), a3, va00, va01);
            PG8_BAR; PG8_WAIT_L(0); PG8_MMA(1, 0, At, B0); PG8_BAR; PG8_SCHED;
            PG8_STAGE_B(PG8_SB(1, 1), b3 + hstepB);
            PG8_WAIT_V(6); PG8_BAR; PG8_MMA(1, 1, At, B1); PG8_BAR;
            }
        }
        if constexpr (ALIGN_EPI) { if (wr == 0) PG8_BAR; }
        if constexpr (F8) { PG8_SCHED; asm volatile("s_nop 15" ::: "memory"); PG8_SCHED; }
        if constexpr (PM != 1) E(acc, cur, wr, wc, fr, fq);
        if (!has_next) break;
#pragma unroll
        for (int a = 0; a < 2; ++a)
#pragma unroll
            for (int b = 0; b < 2; ++b)
#pragma unroll
                for (int m = 0; m < 4; ++m)
#pragma unroll
                    for (int n = 0; n < 2; ++n) acc[a][b][m][n] = (f32x4){0.f, 0.f, 0.f, 0.f};
        cur = nxt; cA = nA; cB = nB; ++ui;
        if constexpr (ALIGN_EPI) { if (wr == 1) PG8_BAR; }
    }
    PG8_WAIT_V(0);
    if constexpr (!ALIGN_EPI) { if (wr == 0) PG8_BAR; }
    PG8_BAR;
#undef PG8_SA
#undef PG8_SB
#undef PG8_STAGE2
#undef PG8_STAGE_B
#undef PG8_LOAD_IDS
#undef PG8_IDS_TO_VA
#undef PG8_LDA
#undef PG8_LDB
#undef PG8_MMA
#undef PG8_WAIT_V
#undef PG8_WAIT_L
#undef PG8_BAR
#undef PG8_SCHED
}
typedef f32x4 AccT[2][2][4][2];
struct EpiBf16 {
    static constexpr int PERM = 1;
    bf16_t* O; int ldc; const float* bias;
    __device__ __forceinline__ void operator()(const AccT& acc, const GUnit& u, int wr, int wc, int fr, int fq) const {
        const int row0 = u.row0 + wr * 64 + fr, col0 = u.col0 + wc * 32 + 8 * fq;
        f32x4 bv[2][2];
#pragma unroll
        for (int bj = 0; bj < 2; ++bj)
#pragma unroll
            for (int n = 0; n < 2; ++n) bv[bj][n] = bias ? *(const f32x4*)(bias + col0 + bj * HALF + 4 * n) : (f32x4){0.f, 0.f, 0.f, 0.f};
#pragma unroll
        for (int ai = 0; ai < 2; ++ai)
#pragma unroll
            for (int m = 0; m < 4; ++m) { bf16_t* rowp = O + (size_t)(row0 + ai * HALF + m * 16) * ldc + col0;
#pragma unroll
                for (int bj = 0; bj < 2; ++bj) { const f32x4 v0 = acc[ai][bj][m][0] + bv[bj][0], v1 = acc[ai][bj][m][1] + bv[bj][1];
                    *(u32x4*)(rowp + bj * HALF) = (u32x4){pk2(v0[0], v0[1]), pk2(v0[2], v0[3]), pk2(v1[0], v1[1]), pk2(v1[2], v1[3])}; } }
    }
};
struct EpiBf16Rs {
    static constexpr int PERM = 1;
    bf16_t* O; int ldc; const float* rs;
    __device__ __forceinline__ void operator()(const AccT& acc, const GUnit& u, int wr, int wc, int fr, int fq) const {
        const int row0 = u.row0 + wr * 64 + fr, col0 = u.col0 + wc * 32 + 8 * fq;
#pragma unroll
        for (int ai = 0; ai < 2; ++ai)
#pragma unroll
            for (int m = 0; m < 4; ++m) { const int row = row0 + ai * HALF + m * 16; const float sc = rs[row]; bf16_t* rowp = O + (size_t)row * ldc + col0;
#pragma unroll
                for (int bj = 0; bj < 2; ++bj) { const f32x4 v0 = acc[ai][bj][m][0] * sc, v1 = acc[ai][bj][m][1] * sc;
                    *(u32x4*)(rowp + bj * HALF) = (u32x4){pk2(v0[0], v0[1]), pk2(v0[2], v0[3]), pk2(v1[0], v1[1]), pk2(v1[2], v1[3])}; } }
    }
};
struct EpiResF32 {
    static constexpr int PERM = 0;
    const float* xin; float* out; int ldc; float ascale;
    __device__ __forceinline__ void operator()(const AccT& acc, const GUnit& u, int wr, int wc, int fr, int fq) const {
        const int row0 = u.row0 + wr * 64 + fr, col0 = u.col0 + wc * 32 + 4 * fq;
#pragma unroll
        for (int ai = 0; ai < 2; ++ai)
#pragma unroll
            for (int m = 0; m < 4; ++m) { const size_t off = (size_t)(row0 + ai * HALF + m * 16) * ldc + col0;
#pragma unroll
                for (int bj = 0; bj < 2; ++bj)
#pragma unroll
                    for (int n = 0; n < 2; ++n) { const f32x4 b = *(const f32x4*)(xin + off + bj * HALF + n * 16); *(f32x4*)(out + off + bj * HALF + n * 16) = b + acc[ai][bj][m][n] * ascale; }
                asm volatile("" ::: "memory"); }
    }
};
struct EpiResBf16 {
    static constexpr int PERM = 1;
    const float* xin32; const bf16_t* xin16; bf16_t* out;
    __device__ __forceinline__ void operator()(const AccT& acc, const GUnit& u, int wr, int wc, int fr, int fq) const {
        const int row0 = u.row0 + wr * 64 + fr, col0 = u.col0 + wc * 32 + 8 * fq;
#pragma unroll
        for (int ai = 0; ai < 2; ++ai)
#pragma unroll
            for (int m = 0; m < 4; ++m) { const size_t off = (size_t)(row0 + ai * HALF + m * 16) * 1024 + col0;
#pragma unroll
                for (int bj = 0; bj < 2; ++bj) { f32x4 v0 = acc[ai][bj][m][0], v1 = acc[ai][bj][m][1];
                    if (xin32) { v0 += *(const f32x4*)(xin32 + off + bj * HALF); v1 += *(const f32x4*)(xin32 + off + bj * HALF + 4); }
                    else { const u32x4 w = *(const u32x4*)(xin16 + off + bj * HALF); v0 += (f32x4){bflo(w.x), bfhi(w.x), bflo(w.y), bfhi(w.y)}; v1 += (f32x4){bflo(w.z), bfhi(w.z), bflo(w.w), bfhi(w.w)}; }
                    *(u32x4*)(out + off + bj * HALF) = (u32x4){pk2(v0[0], v0[1]), pk2(v0[2], v0[3]), pk2(v1[0], v1[1]), pk2(v1[2], v1[3])}; }
                asm volatile("" ::: "memory"); }
    }
};
struct EpiGlu {
    static constexpr int PERM = 1;
    bf16_t* act; const float* bgu_l;
    __device__ __forceinline__ void operator()(const AccT& acc, const GUnit& u, int wr, int wc, int fr, int fq) const {
        const int row0 = u.row0 + wr * 64 + fr, j0 = (u.col0 >> 1) + wc * 32 + 8 * fq;
        const float* bg = bgu_l + (size_t)u.e * 2048 + 2 * j0;
        f32x4 b0 = *(const f32x4*)(bg), b1 = *(const f32x4*)(bg + 4), b2 = *(const f32x4*)(bg + 8), b3 = *(const f32x4*)(bg + 12);
        const float bgl[8] = {b0[0], b0[2], b1[0], b1[2], b2[0], b2[2], b3[0], b3[2]}, bll[8] = {b0[1], b0[3], b1[1], b1[3], b2[1], b2[3], b3[1], b3[3]};
#pragma unroll
        for (int ai = 0; ai < 2; ++ai)
#pragma unroll
            for (int m = 0; m < 4; ++m) { float r[8];
#pragma unroll
                for (int n = 0; n < 2; ++n)
#pragma unroll
                    for (int i = 0; i < 4; ++i) { const float vg = acc[ai][0][m][n][i] + bgl[4 * n + i], vl = acc[ai][1][m][n][i] + bll[4 * n + i];
                        const float xg = fminf(vg, 7.f), xl = fminf(fmaxf(vl, -7.f), 7.f);
                        r[4 * n + i] = xg * (xl + 1.f) * __builtin_amdgcn_rcpf(1.f + __builtin_amdgcn_exp2f(-2.4554669595930156f * xg)); }
                *(u32x4*)(act + (size_t)(row0 + ai * HALF + m * 16) * 1024 + j0) = (u32x4){pk2(r[0], r[1]), pk2(r[2], r[3]), pk2(r[4], r[5]), pk2(r[6], r[7])}; }
    }
};
constexpr float W8_SCALE = 32.f, W8_INV = 1.f / 32.f;
struct EpiGlu8 {
    static constexpr int PERM = 1;
    unsigned char* act; const float* bgu_l; LAS const float* btab; int nbt;
    __device__ __forceinline__ void operator()(const AccT& acc, const GUnit& u, int wr, int wc, int fr, int fq) const {
        const int row0 = u.row0 + wr * 64 + fr, j0 = (u.col0 >> 1) + wc * 32 + 8 * fq;
        f32x4 b0, b1, b2, b3;
        const int ui_ = u.aux >> 16;
        if (ui_ < nbt) { const LAS float* bl = btab + ui_ * 256 + 2 * (wc * 32 + 8 * fq); b0 = *(const LAS f32x4*)(bl); b1 = *(const LAS f32x4*)(bl + 4); b2 = *(const LAS f32x4*)(bl + 8); b3 = *(const LAS f32x4*)(bl + 12); }
        else { const float* bg = bgu_l + (size_t)u.e * 2048 + 2 * j0; b0 = *(const f32x4*)(bg); b1 = *(const f32x4*)(bg + 4); b2 = *(const f32x4*)(bg + 8); b3 = *(const f32x4*)(bg + 12); }
        const f32x2 bgp[4] = {(f32x2){b0[0], b0[2]}, (f32x2){b1[0], b1[2]}, (f32x2){b2[0], b2[2]}, (f32x2){b3[0], b3[2]}};
        const f32x2 blp[4] = {(f32x2){b0[1] + 1.f, b0[3] + 1.f}, (f32x2){b1[1] + 1.f, b1[3] + 1.f}, (f32x2){b2[1] + 1.f, b2[3] + 1.f}, (f32x2){b3[1] + 1.f, b3[3] + 1.f}};
#pragma unroll
        for (int ai = 0; ai < 2; ++ai)
#pragma unroll
            for (int m = 0; m < 4; ++m) { f32x2 r[4];
#pragma unroll
                for (int n = 0; n < 2; ++n)
#pragma unroll
                    for (int hp = 0; hp < 2; ++hp) { const f32x2 ag = (f32x2){acc[ai][0][m][n][2 * hp], acc[ai][0][m][n][2 * hp + 1]}, al = (f32x2){acc[ai][1][m][n][2 * hp], acc[ai][1][m][n][2 * hp + 1]};
                        f32x2 vg = ag * W8_INV + bgp[2 * n + hp], vl = al * W8_INV + blp[2 * n + hp];
                        vg.x = fminf(vg.x, 7.f); vg.y = fminf(vg.y, 7.f); vl.x = __builtin_amdgcn_fmed3f(vl.x, -6.f, 8.f); vl.y = __builtin_amdgcn_fmed3f(vl.y, -6.f, 8.f);
                        const f32x2 t = vg * -2.4554669595930156f; f32x2 d; d.x = __builtin_amdgcn_exp2f(t.x); d.y = __builtin_amdgcn_exp2f(t.y); d = d + 1.f;
                        f32x2 rc; rc.x = __builtin_amdgcn_rcpf(d.x); rc.y = __builtin_amdgcn_rcpf(d.y);
                        r[2 * n + hp] = (vg * vl) * rc; }
                *(u32x2*)(act + (size_t)(row0 + ai * HALF + m * 16) * 1024 + j0) = (u32x2){pk4_fp8(r[0].x, r[0].y, r[1].x, r[1].y), pk4_fp8(r[2].x, r[2].y, r[3].x, r[3].y)}; }
    }
};
struct EpiDown {
    static constexpr int PERM = 1;
    bf16_t* yb; const float* bdn_l; const float* lgate; LAS const int* cnt; float ascale;
    __device__ __forceinline__ void operator()(const AccT& acc, const GUnit& u, int wr, int wc, int fr, int fq) const {
        const int rl0 = wr * 64 + fr, col0 = u.col0 + wc * 32 + 8 * fq; const int n_valid = __builtin_amdgcn_readfirstlane(cnt[u.e]);
        const float* bd = bdn_l + (size_t)u.e * 1024 + col0;
        f32x4 bv[2][2];
#pragma unroll
        for (int bj = 0; bj < 2; ++bj)
#pragma unroll
            for (int n = 0; n < 2; ++n) bv[bj][n] = *(const f32x4*)(bd + bj * HALF + 4 * n);
#pragma unroll
        for (int ai = 0; ai < 2; ++ai)
#pragma unroll
            for (int m = 0; m < 4; ++m) { const int rl = rl0 + ai * HALF + m * 16, li = u.aux + rl; const float g = (li < n_valid) ? lgate[(size_t)u.e * T + li] : 0.f;
                bf16_t* rowp = yb + (size_t)(u.row0 + rl) * 1024 + col0;
#pragma unroll
                for (int bj = 0; bj < 2; ++bj) { const f32x4 v0 = (acc[ai][bj][m][0] * ascale + bv[bj][0]) * g, v1 = (acc[ai][bj][m][1] * ascale + bv[bj][1]) * g;
                    *(u32x4*)(rowp + bj * HALF) = (u32x4){pk2(v0[0], v0[1]), pk2(v0[2], v0[3]), pk2(v1[0], v1[1]), pk2(v1[2], v1[3])}; } }
    }
};
constexpr float YB_SCALE = 8.f;
struct EpiDown8 {
    static constexpr int PERM = 2;
    unsigned char* yb; const float* bdn_l; LAS const float* btab; int nbt;
    __device__ __forceinline__ void operator()(const AccT& acc, const GUnit& u, int wr, int wc, int fr, int fq) const {
        const int rl0 = wr * 64 + fr, col0 = u.col0 + wc * 64 + 16 * fq;
        const float* bd = bdn_l + (size_t)u.e * 1024 + col0;
        f32x4 bv[2][2]; const int ui_ = u.aux >> 16;
        if (ui_ < nbt) { const LAS float* bl = btab + ui_ * 256 + wc * 64 + 16 * fq;
#pragma unroll
            for (int bj = 0; bj < 2; ++bj)
#pragma unroll
                for (int n = 0; n < 2; ++n) bv[bj][n] = *(const LAS f32x4*)(bl + 8 * bj + 4 * n) * YB_SCALE; }
        else {
#pragma unroll
        for (int bj = 0; bj < 2; ++bj)
#pragma unroll
            for (int n = 0; n < 2; ++n) bv[bj][n] = *(const f32x4*)(bd + 8 * bj + 4 * n) * YB_SCALE; }
#pragma unroll
        for (int ai = 0; ai < 2; ++ai)
#pragma unroll
            for (int m = 0; m < 4; ++m) { const int rl = rl0 + ai * HALF + m * 16;
                u32x4 o;
#pragma unroll
                for (int bj = 0; bj < 2; ++bj)
#pragma unroll
                    for (int n = 0; n < 2; ++n) { const f32x4 v = acc[ai][bj][m][n] * (W8_INV * YB_SCALE) + bv[bj][n]; o[2 * bj + n] = pk4_fp8(v[0], v[1], v[2], v[3]); }
                *(u32x4*)(yb + (size_t)(u.row0 + rl) * 1024 + col0) = o; }
    }
};
struct DenseSched {
    const unsigned char* A; const unsigned char* Bt; int lda, K, nM, nN, G, c, es;
    __device__ __forceinline__ bool next(int i, GUnit& u) const { const int L = i * G + c; if (L >= nM * nN) return false; int pm, pn; tile_of(L, nM, nN, pm, pn);
        u.A = A + (size_t)pm * 256 * lda * es; u.B = Bt + (size_t)pn * 256 * K * es; u.row0 = pm * 256; u.col0 = pn * 256; u.e = 0; u.aux = 0; return true; }
    __device__ __forceinline__ int rowid(const GUnit&, int R) const { return R; }
    __device__ __forceinline__ unsigned idoff(int id) const { return (unsigned)(id * lda * es); }
};
template <bool GATHER, int RB> struct MoeSched {
    const unsigned char* A; const unsigned char* Wt; const int* ltok; LAS const int* ctl; int nN, G, c;
    LAS const unsigned short* tokt; int ntab; int fix;
    __device__ __forceinline__ bool locate(int i, int& pm, int& pn, int& e, int& rb) const { const int nM = __builtin_amdgcn_readfirstlane(ctl[32 + NEXP]); const int L = i * G + c; if (L >= nM * nN) return false; tile_of(L, nM, nN, pm, pn);
        e = 0;
        for (int k = 1; k < NEXP; ++k) e += (__builtin_amdgcn_readfirstlane(ctl[32 + k]) <= pm) ? 1 : 0;
        rb = __builtin_amdgcn_readfirstlane(ctl[32 + e]); return true; }
    __device__ __forceinline__ bool next(int i, GUnit& u) const { int pm, pn, e, rb; if (!locate(i, pm, pn, e, rb)) return false;
        u.A = GATHER ? A : A + (size_t)((fix & 2) ? 0 : pm) * 256 * RB; u.B = Wt + ((size_t)((fix & 1) ? 0 : e) * nN + ((fix & 1) ? 0 : pn)) * 256 * RB;   u.row0 = pm * 256; u.col0 = pn * 256; u.e = e; u.aux = (i << 16) | (pm - rb); return true; }
    __device__ __forceinline__ int rowid(const GUnit& u, int R) const {
        if (GATHER) return (int)tokt[(u.aux >> 16) * 256 + R];
        return R; }
    __device__ __forceinline__ unsigned idoff(int id) const { return (unsigned)id * (unsigned)RB; }
};
}

__device__ __forceinline__ void moe_tables(const Ctx& C, int l) {
    LAS int* ctl = (LAS int*)(C.lds + LDS_CTL);
    __syncthreads();
    if (C.tid < NEXP) ctl[C.tid] = (int)__hip_atomic_load(WSP(unsigned, WS_CTL) + CW_GCNT + (l * NEXP + C.tid) * 64, __ATOMIC_RELAXED, __HIP_MEMORY_SCOPE_AGENT);
    __syncthreads();
    if (C.tid == 0) { int a = 0; for (int e = 0; e < NEXP; ++e) { ctl[32 + e] = a; a += (ctl[e] + 255) >> 8; } ctl[32 + NEXP] = a; }
    __syncthreads();
}
__device__ __forceinline__ int moe_find_expert(const Ctx& C, int rt) {
    LAS int* ctl = (LAS int*)(C.lds + LDS_CTL);
    int e = 0;
    for (int k = 1; k < NEXP; ++k) e += (ctl[32 + k] <= rt) ? 1 : 0;
    return e;
}

__device__ __forceinline__ void ph_inproj(const Ctx& C, int l) {
    const bf16_t* hb = WSP(bf16_t, WS_HB); const bf16_t* W = WSP(bf16_t, WS_WIN) + (size_t)l * DINP * 1024; bf16_t* z = WSP(bf16_t, WS_Z);
    for (int u = C.bid; u < 256 * 10; u += C.G) { const int rt = u / 10, ct = u % 10;
        sg_tile<1>(C, [&](int r) { return hb + (size_t)(rt * 128 + r) * 1024; }, W + (size_t)ct * 128 * 1024, nullptr, 1024,
                   [&](int r, int c, float v, float) { z[(size_t)(rt * 128 + r) * DINP + ct * 128 + c] = (bf16_t)f2bf(v); });
    }
}
template <int SKIP = 0> __device__ __forceinline__ void ph_mix1(const Ctx& C, int l) {
    const bf16_t* z = WSP(bf16_t, WS_Z); bf16_t* A2 = WSP(bf16_t, WS_A2);
    LAS float* vs = (LAS float*)C.lds;
    LAS float* dw = (LAS float*)(C.lds + 62 * 256 * 4);
    const int tid = C.tid, c = tid & 255, half = tid >> 8;
    float wj[31];
#pragma unroll
    for (int j = 0; j < 31; ++j) wj[j] = WSP(float, WS_PAR)[P_CDW + (l * 31 + j) * 256 + c];
    const float cb = WSP(float, WS_PAR)[P_CDWB + l * 256 + c];
    u32x4 ga[4], gg[4];
#define MIX1_LOAD(TILE) do { const int tok0_ = (TILE) * 32, s0_ = tok0_ % SEQ; _Pragma("unroll") for (int p = 0; p < 4; ++p) { const int row = p * 16 + (tid >> 5), ch8 = (tid & 31) * 8; const int srow = s0_ - 30 + row; \
              if (row < 62 && srow >= 0) { const bf16_t* zr = z + (size_t)(tok0_ - 30 + row) * DINP; ga[p] = *(const u32x4*)(zr + 256 + ch8); gg[p] = *(const u32x4*)(zr + 512 + ch8); } \
              else { ga[p] = (u32x4){0u, 0u, 0u, 0u}; gg[p] = (u32x4){0u, 0u, 0u, 0u}; } } } while (0)
    if (C.bid < T / 32 && !(SKIP & 4)) MIX1_LOAD(C.bid);
    for (int tile = C.bid; tile < T / 32; tile += C.G) {
        const int tok0 = tile * 32, s0 = tok0 % SEQ;
        if (!(SKIP & 4)) {
#pragma unroll
          for (int p = 0; p < 4; ++p) { const int row = p * 16 + (tid >> 5), ch8 = (tid & 31) * 8;
              if (row < 62) { const u32x4 a = ga[p], g = gg[p]; float v[8];
                  v[0] = bflo(a.x) * sigmoidf_(bflo(g.x)); v[1] = bfhi(a.x) * sigmoidf_(bfhi(g.x)); v[2] = bflo(a.y) * sigmoidf_(bflo(g.y)); v[3] = bfhi(a.y) * sigmoidf_(bfhi(g.y));
                  v[4] = bflo(a.z) * sigmoidf_(bflo(g.z)); v[5] = bfhi(a.z) * sigmoidf_(bfhi(g.z)); v[6] = bflo(a.w) * sigmoidf_(bflo(g.w)); v[7] = bfhi(a.w) * sigmoidf_(bfhi(g.w));
                  *(LAS f32x4*)(vs + row * 256 + ch8) = (f32x4){v[0], v[1], v[2], v[3]}; *(LAS f32x4*)(vs + row * 256 + ch8 + 4) = (f32x4){v[4], v[5], v[6], v[7]}; } }
          if (tile + C.G < T / 32) MIX1_LOAD(tile + C.G); }
        __syncthreads();
        if (!(SKIP & 2)) { float vv[46];
#pragma unroll
            for (int r = 0; r < 46; ++r) vv[r] = vs[(half * 16 + r) * 256 + c];
#pragma unroll
            for (int i = 0; i < 16; ++i) { float acc = cb;
#pragma unroll
                for (int j = 0; j < 31; ++j) acc += vv[i + j] * wj[j];
                dw[(half * 16 + i) * 256 + c] = acc; } }
        __syncthreads();
        if (!(SKIP & 8)) for (int q = 0; q < 4; ++q) { const int tl = C.wave * 4 + q, ch = C.lane * 4;
            const f32x4 x = *(const LAS f32x4*)(dw + tl * 256 + ch);
            const float mean = wave_sum((x.x + x.y) + (x.z + x.w)) * (1.f / 256.f);
            const f32x4 d = x - mean;
            const float var = wave_sum((d.x * d.x + d.y * d.y) + (d.z * d.z + d.w * d.w)) * (1.f / 256.f);
            const float rstd = rsqrtf(var + EPS);
            const f32x4 g = *(const f32x4*)(WSP(float, WS_PAR) + P_CLNG + l * 256 + ch), b = *(const f32x4*)(WSP(float, WS_PAR) + P_CLNB + l * 256 + ch);
            f32x4 y = d * rstd * g + b;
            y.x *= sigmoidf_(y.x); y.y *= sigmoidf_(y.y); y.z *= sigmoidf_(y.z); y.w *= sigmoidf_(y.w);
            *(u32x2*)(A2 + (size_t)(tok0 + tl) * 512 + 256 + ch) = (u32x2){pk2(y.x, y.y), pk2(y.z, y.w)}; }
        if (!(SKIP & 1)) { const int cp = tid & 127, tg = tid >> 7, g = cp >> 5, tf = s0 + tg * 8; const bf16_t* zc = z + (size_t)(tok0 - s0) * DINP + 2 * cp;
          float u0[23], u1[23];
#pragma unroll
          for (int d = 0; d < 23; ++d) { const int sq = tf - 15 + d; const unsigned wv = (sq >= 0) ? *(const unsigned*)(zc + (size_t)sq * DINP) : 0u; u0[d] = bflo(wv); u1[d] = bfhi(wv); }
          bf16_t* ao = A2 + (size_t)(tok0 - s0 + tf) * 512 + 2 * cp;
#define POOL_W(W) do { _Pragma("unroll") for (int i = 0; i < 8; ++i) { float sa = 0.f, sb = 0.f; _Pragma("unroll") for (int d = 0; d < (W); ++d) { sa += u0[15 + i - d]; sb += u1[15 + i - d]; } \
              const int sq = tf + i; const int cnt = (sq + 1 < (W)) ? (sq + 1) : (W); const float rc = __builtin_amdgcn_rcpf((float)cnt); \
              *(unsigned*)(ao + (size_t)i * 512) = pk2(sa * rc - u0[15 + i], sb * rc - u1[15 + i]); } } while (0)
          if (g == 0) POOL_W(2); else if (g == 1) POOL_W(4); else if (g == 2) POOL_W(8); else POOL_W(16);
#undef POOL_W
        }
        __syncthreads();
    }
#undef MIX1_LOAD
}
__device__ __forceinline__ void ph_smallgemm(const Ctx& C, int l) {
    const bf16_t* z = WSP(bf16_t, WS_Z); const bf16_t* A2 = WSP(bf16_t, WS_A2);
    const bf16_t* Wm = WSP(bf16_t, WS_WMIX) + (size_t)l * 512 * 512; const bf16_t* Wq = WSP(bf16_t, WS_WQ) + (size_t)l * 768 * 256; const bf16_t* Wkv = WSP(bf16_t, WS_WKV) + (size_t)l * 1024 * 256;
    bf16_t* ymix = WSP(bf16_t, WS_YMIX); bf16_t* qraw = WSP(bf16_t, WS_QRAW); bf16_t* kvraw = WSP(bf16_t, WS_KVRAW);
    const float* pwb = WSP(float, WS_PAR) + P_CPWB + l * 256;
    for (int u = C.bid; u < 256 * (4 + 6 + 8); u += C.G) { const int rt = u / 18, q = u % 18;
        if (q < 4) { const int ct = q;
            sg_tile<1>(C, [&](int r) { return A2 + (size_t)(rt * 128 + r) * 512; }, Wm + (size_t)ct * 128 * 512, nullptr, 512,
                       [&](int r, int c, float v, float) { const int col = ct * 128 + c; if (col >= 256) v += pwb[col - 256]; ymix[(size_t)(rt * 128 + r) * 512 + col] = (bf16_t)f2bf(v); });
        } else if (q < 10) { const int ct = q - 4;
            sg_tile<1>(C, [&](int r) { return z + (size_t)(rt * 128 + r) * DINP + 768; }, Wq + (size_t)ct * 128 * 256, nullptr, 256,
                       [&](int r, int c, float v, float) { qraw[(size_t)(rt * 128 + r) * 768 + ct * 128 + c] = (bf16_t)f2bf(v); });
        } else { const int ct = q - 10;
            sg_tile<1>(C, [&](int r) { return z + (size_t)(rt * 128 + r) * DINP + 1024; }, Wkv + (size_t)ct * 128 * 256, nullptr, 256,
                       [&](int r, int c, float v, float) { kvraw[(size_t)(rt * 128 + r) * 1024 + ct * 128 + c] = (bf16_t)f2bf(v); });
        }
    }
}
struct QkIn { u32x2 cq; unsigned ckv; f32x2 cs0, cs1; u32x4 qa; unsigned qp1, qp2; u32x4 ka; unsigned kp1, kp2; u32x4 vv; };
__device__ __forceinline__ QkIn qk_load(const Ctx& C, int t, int lane) {
    const bf16_t* zr = WSP(bf16_t, WS_Z) + (size_t)t * DINP; const int h = lane >> 4, l16 = lane & 15;
    const bf16_t* qr = WSP(bf16_t, WS_QRAW) + (size_t)t * 768 + 192 * h; const bf16_t* kr = WSP(bf16_t, WS_KVRAW) + (size_t)t * 1024 + 256 * h; const f32x2* cs = WSP(f32x2, WS_COS) + (size_t)t * 32 + 2 * l16;
    QkIn r; r.cq = *(const u32x2*)(zr + 768 + 4 * lane); r.ckv = *(const unsigned*)(zr + 1024 + 2 * lane); r.cs0 = cs[0]; r.cs1 = cs[1];
    r.qa = *(const u32x4*)(qr + 8 * l16); r.qp1 = *(const unsigned*)(qr + 128 + 2 * l16); r.qp2 = *(const unsigned*)(qr + 160 + 2 * l16);
    r.ka = *(const u32x4*)(kr + 8 * l16); r.kp1 = *(const unsigned*)(zr + 1152 + 2 * l16); r.kp2 = *(const unsigned*)(zr + 1184 + 2 * l16); r.vv = ATT_PV8 ? (u32x4){0u, 0u, 0u, 0u} : *(const u32x4*)(kr + 128 + 8 * l16);
    return r;
}
template <int SKIP = 0> __device__ __forceinline__ void ph_qkfin(const Ctx& C, int l) {
    bf16_t* Qb = WSP(bf16_t, WS_Q);
    const int lane = C.lane, h = lane >> 4, l16 = lane & 15;
    const float* qg = WSP(float, WS_PAR) + P_QNG + l * 192; const float* kg = WSP(float, WS_PAR) + P_KNG + l * 192;
    float gq[12], gk[12];
#pragma unroll
    for (int i = 0; i < 8; ++i) { gq[i] = qg[8 * l16 + i]; gk[i] = kg[8 * l16 + i]; }
#pragma unroll
    for (int i = 0; i < 2; ++i) { gq[8 + i] = qg[128 + 2 * l16 + i]; gq[10 + i] = qg[160 + 2 * l16 + i]; gk[8 + i] = kg[128 + 2 * l16 + i]; gk[10 + i] = kg[160 + 2 * l16 + i]; }
    const int stride = C.G * NWAVE; int t = C.bid * NWAVE + C.wave;
    if (t >= T) return;
    QkIn cur = qk_load(C, t, lane), cur2 = cur;
    if (t + stride < T) cur2 = qk_load(C, t + stride, lane);
    for (; t < T; t += stride) {
        const QkIn in = cur; cur = cur2;
        if (t + 2 * stride < T) cur2 = qk_load(C, t + 2 * stride, lane);
        float rsq, rskv;
        { const float x0 = bflo(in.cq.x), x1 = bfhi(in.cq.x), x2 = bflo(in.cq.y), x3 = bfhi(in.cq.y);
          rsq = rsqrtf(wave_sum((x0 * x0 + x1 * x1) + (x2 * x2 + x3 * x3)) * (1.f / 256.f) + EPS); }
        { const float x0 = bflo(in.ckv), x1 = bfhi(in.ckv);
          rskv = rsqrtf(wave_sum(x0 * x0 + x1 * x1) * (1.f / 128.f) + EPS); }
        const f32x2 cs0 = in.cs0, cs1 = in.cs1;
        { const u32x4 a = in.qa; const unsigned p1 = in.qp1, p2 = in.qp2;
          float v[12] = {bflo(a.x), bfhi(a.x), bflo(a.y), bfhi(a.y), bflo(a.z), bfhi(a.z), bflo(a.w), bfhi(a.w), bflo(p1), bfhi(p1), bflo(p2), bfhi(p2)};
          float ss = 0.f;
#pragma unroll
          for (int i = 0; i < 12; ++i) { v[i] *= rsq; ss += v[i] * v[i]; }
          const float rh = rsqrtf(grp16_sum(ss) * (1.f / 192.f) + EPS);
#pragma unroll
          for (int i = 0; i < 12; ++i) v[i] *= rh * gq[i];
          const float o10 = v[8] * cs0.x - v[10] * cs0.y, o20 = v[10] * cs0.x + v[8] * cs0.y, o11 = v[9] * cs1.x - v[11] * cs1.y, o21 = v[11] * cs1.x + v[9] * cs1.y;
#if ATT_QK8
          unsigned char* qo = (unsigned char*)Qb + (size_t)t * 768 + 192 * h;
          if (!(SKIP & 4)) { *(u32x2*)(qo + 8 * l16) = (u32x2){pk4_fp8(v[0], v[1], v[2], v[3]), pk4_fp8(v[4], v[5], v[6], v[7])};
              *(unsigned*)(qo + 128 + 4 * l16) = pk4_fp8(o10, o11, o20, o21); } }
#else
          bf16_t* qo = Qb + (size_t)t * 768 + 192 * h;
          if (!(SKIP & 4)) { *(u32x4*)(qo + 8 * l16) = (u32x4){pk2(v[0], v[1]), pk2(v[2], v[3]), pk2(v[4], v[5]), pk2(v[6], v[7])};
              *(u32x2*)(qo + 128 + 4 * l16) = (u32x2){pk2(o10, o11), pk2(o20, o21)}; } }
#endif
        { const u32x4 a = in.ka; const unsigned p1 = in.kp1, p2 = in.kp2;
          float v[12] = {bflo(a.x) * rskv, bfhi(a.x) * rskv, bflo(a.y) * rskv, bfhi(a.y) * rskv, bflo(a.z) * rskv, bfhi(a.z) * rskv, bflo(a.w) * rskv, bfhi(a.w) * rskv, bflo(p1), bfhi(p1), bflo(p2), bfhi(p2)};
          float ss = 0.f;
#pragma unroll
          for (int i = 0; i < 12; ++i) ss += v[i] * v[i];
          const float rh = rsqrtf(grp16_sum(ss) * (1.f / 192.f) + EPS);
#pragma unroll
          for (int i = 0; i < 12; ++i) v[i] *= rh * gk[i];
          const float o10 = v[8] * cs0.x - v[10] * cs0.y, o20 = v[10] * cs0.x + v[8] * cs0.y, o11 = v[9] * cs1.x - v[11] * cs1.y, o21 = v[11] * cs1.x + v[9] * cs1.y;
#if ATT_QK8
          unsigned char* ko = C.ws + WS_KIMG + (size_t)t * 768 + 192 * h;
          if (!(SKIP & 1)) { *(u32x2*)(ko + 8 * l16) = (u32x2){pk4_fp8(v[0], v[1], v[2], v[3]), pk4_fp8(v[4], v[5], v[6], v[7])};
              *(unsigned*)(ko + 128 + 4 * l16) = pk4_fp8(o10, o11, o20, o21); }
#else
          bf16_t* ko = WSP(bf16_t, WS_KIMG) + (size_t)t * 768 + 192 * h;
          if (!(SKIP & 1)) { *(u32x4*)(ko + 8 * l16) = (u32x4){pk2(v[0], v[1]), pk2(v[2], v[3]), pk2(v[4], v[5]), pk2(v[6], v[7])};
              *(u32x2*)(ko + 128 + 4 * l16) = (u32x2){pk2(o10, o11), pk2(o20, o21)}; }
#endif
          const u32x4 vv = in.vv;
          if (!(SKIP & 2) && !ATT_PV8) *(u32x4*)(WSP(bf16_t, WS_VIMG) + (size_t)t * 512 + 128 * h + 8 * l16) = (u32x4){pk2(bflo(vv.x) * rskv, bfhi(vv.x) * rskv), pk2(bflo(vv.y) * rskv, bfhi(vv.y) * rskv), pk2(bflo(vv.z) * rskv, bfhi(vv.z) * rskv), pk2(bflo(vv.w) * rskv, bfhi(vv.w) * rskv)}; }
    }
}
#if ATT_PV8
__device__ __forceinline__ void ph_vtbuild(const Ctx& C, int l) {
    const bf16_t* z = WSP(bf16_t, WS_Z); const bf16_t* kv = WSP(bf16_t, WS_KVRAW); unsigned char* vt = C.ws + WS_VIMG;
    LAS unsigned* img = (LAS unsigned*)C.lds;
    LAS float* rsl = (LAS float*)(C.lds + 512 * 68);
    const int tid = C.tid, lane = C.lane, w = C.wave;
    __syncthreads();
    for (int it = C.bid; it < T / 64; it += C.G) { const int tok0 = it * 64;
        { const int tt = tid >> 3, part = tid & 7; const u32x4* cp = (const u32x4*)(z + (size_t)(tok0 + tt) * DINP + 1024 + 16 * part); const u32x4 a = cp[0], b = cp[1];
          float ss = bflo(a.x) * bflo(a.x) + bfhi(a.x) * bfhi(a.x) + bflo(a.y) * bflo(a.y) + bfhi(a.y) * bfhi(a.y) + bflo(a.z) * bflo(a.z) + bfhi(a.z) * bfhi(a.z) + bflo(a.w) * bflo(a.w) + bfhi(a.w) * bfhi(a.w)
                   + bflo(b.x) * bflo(b.x) + bfhi(b.x) * bfhi(b.x) + bflo(b.y) * bflo(b.y) + bfhi(b.y) * bfhi(b.y) + bflo(b.z) * bflo(b.z) + bfhi(b.z) * bfhi(b.z) + bflo(b.w) * bflo(b.w) + bfhi(b.w) * bfhi(b.w);
          ss += __shfl_xor(ss, 1); ss += __shfl_xor(ss, 2); ss += __shfl_xor(ss, 4);
          if (part == 0) rsl[tt] = rsqrtf(ss * (1.f / 128.f) + EPS); }
        unsigned u[8][4];
#pragma unroll
        for (int i = 0; i < 8; ++i) { const int pr = w + 8 * i, q = pr >> 2, hh = pr & 3;
#pragma unroll
            for (int k = 0; k < 4; ++k) u[i][k] = *(const unsigned*)(kv + (size_t)(tok0 + 4 * q + k) * 1024 + 256 * hh + 128 + 2 * lane); }
        __syncthreads();
#pragma unroll
        for (int i = 0; i < 8; ++i) { const int pr = w + 8 * i, q = pr >> 2, hh = pr & 3; const f32x4 rs = *(const LAS f32x4*)(rsl + 4 * q);
            img[(hh * 128 + 2 * lane) * 17 + q] = pk4_fp8(bflo(u[i][0]) * rs.x, bflo(u[i][1]) * rs.y, bflo(u[i][2]) * rs.z, bflo(u[i][3]) * rs.w);
            img[(hh * 128 + 2 * lane + 1) * 17 + q] = pk4_fp8(bfhi(u[i][0]) * rs.x, bfhi(u[i][1]) * rs.y, bfhi(u[i][2]) * rs.z, bfhi(u[i][3]) * rs.w); }
        __syncthreads();
#pragma unroll
        for (int k = 0; k < 4; ++k) { const int c = tid + 512 * k, row = c >> 2, pt = c & 3; const LAS unsigned* sp = img + row * 17 + 4 * pt;
            *(u32x4*)(vt + (size_t)it * 32768 + (size_t)c * 16) = (u32x4){sp[0], sp[1], sp[2], sp[3]}; }
        __syncthreads();
    }
}
#endif
typedef float f32x16 __attribute__((ext_vector_type(16)));
typedef short s16x4 __attribute__((ext_vector_type(4)));
constexpr int AT_KB = ATT_QK8 ? 12288 : 24576, AT_VB = ATT_PV8 ? 8192 : 16384, AT_NS = ATT_PV8 ? 5 : 3;
constexpr int AT_K = 0, AT_V = AT_NS * AT_KB, AT_WS = AT_V + AT_NS * AT_VB;
constexpr float AT_SCALE = 0.07216878364870323f;
constexpr float AT_THR = 8.f;
#define SBAR() __builtin_amdgcn_sched_barrier(0)
__device__ __forceinline__ int crow(int r, int hi) { return (r & 3) + 8 * (r >> 2) + 4 * hi; }
__device__ __forceinline__ unsigned cvtpk(float lo, float hi) { unsigned r; asm volatile("v_cvt_pk_bf16_f32 %0, %1, %2" : "=v"(r) : "v"(lo), "v"(hi)); return r; }
__device__ __forceinline__ void glds16(const void* sbase, unsigned voff, unsigned lds_dst) { unsigned keep;
    asm volatile("s_mov_b32 %0, m0\n\ts_mov_b32 m0, %3\n\ts_nop 0\n\tglobal_load_lds_dwordx4 %1, %2\n\ts_mov_b32 m0, %0" : "=&s"(keep) : "v"(voff), "s"(sbase), "s"(lds_dst) : "memory"); }
__device__ __forceinline__ const unsigned char* uniform_ptr(const unsigned char* p) { const unsigned long long v = (unsigned long long)p;
    const unsigned lo = __builtin_amdgcn_readfirstlane((unsigned)v), hi = __builtin_amdgcn_readfirstlane((unsigned)(v >> 32)); return (const unsigned char*)(((unsigned long long)hi << 32) | lo); }
__device__ __forceinline__ void at_partialSM(f32x16& p0, f32x16& p1, float& m_reg, float& mn, float& alpha) {
    constexpr float Cc = AT_SCALE * 1.4426950408889634f;
    float pmax = p0[0];
#pragma unroll
    for (int r = 1; r < 16; ++r) pmax = fmaxf(pmax, p0[r]);
#pragma unroll
    for (int r = 0; r < 16; ++r) pmax = fmaxf(pmax, p1[r]);
    { auto rr = __builtin_amdgcn_permlane32_swap(__float_as_uint(pmax), __float_as_uint(pmax), false, false);
      pmax = fmaxf(__uint_as_float(rr[0]), __uint_as_float(rr[1])); }
    if (__builtin_expect(__all(pmax - m_reg <= AT_THR / AT_SCALE), 1)) { mn = m_reg; alpha = 1.f; }
    else { mn = fmaxf(m_reg, pmax); alpha = __builtin_amdgcn_exp2f((m_reg - mn) * Cc); m_reg = mn; }
    const float mnC = -mn * Cc + (ATT_PV8 ? 4.f : 0.f);
#pragma unroll
    for (int r = 0; r < 16; ++r) p0[r] = fmaf(p0[r], Cc, mnC);
#pragma unroll
    for (int r = 0; r < 16; ++r) p1[r] = fmaf(p1[r], Cc, mnC);
#pragma unroll
    for (int r = 0; r < 16; ++r) p0[r] = __builtin_amdgcn_exp2f(p0[r]);
}
__device__ __forceinline__ void at_finishSM(f32x16& p0, f32x16& p1, float alpha, float& l_reg, bf16x8& pa0, bf16x8& pa1, bf16x8& pa2, bf16x8& pa3) {
#pragma unroll
    for (int r = 0; r < 16; ++r) p1[r] = __builtin_amdgcn_exp2f(p1[r]);
    float ps = 0.f;
#pragma unroll
    for (int r = 0; r < 16; ++r) ps += p0[r];
#pragma unroll
    for (int r = 0; r < 16; ++r) ps += p1[r];
    { auto rr = __builtin_amdgcn_permlane32_swap(__float_as_uint(ps), __float_as_uint(ps), false, false);
      ps = __uint_as_float(rr[0]) + __uint_as_float(rr[1]); }
    l_reg = l_reg * alpha + ps;
#define PK4(P, BASE, OUT) do { unsigned a0 = cvtpk(P[BASE + 0], P[BASE + 1]), a1 = cvtpk(P[BASE + 2], P[BASE + 3]);   \
    unsigned b0 = cvtpk(P[BASE + 4], P[BASE + 5]), b1 = cvtpk(P[BASE + 6], P[BASE + 7]);                              \
    auto r0 = __builtin_amdgcn_permlane32_swap(a0, b0, false, false); auto r1 = __builtin_amdgcn_permlane32_swap(a1, b1, false, false); \
    u32x4 w = {r0[0], r1[0], r0[1], r1[1]}; OUT = __builtin_bit_cast(bf16x8, w); } while (0)
    PK4(p0, 0, pa0); PK4(p0, 8, pa1); PK4(p1, 0, pa2); PK4(p1, 8, pa3);
#undef PK4
}
__device__ __forceinline__ void at_qkt(f32x16& p0, f32x16& p1, const LAS char* ks, const int (&kro)[4], const bf16x8* qr) {
    p0 = f32x16{}; p1 = f32x16{};
#pragma unroll
    for (int d0 = 0; d0 < 12; ++d0) {
        const bf16x8 b0 = *(const LAS bf16x8*)(ks + kro[d0 & 3] + 128 * (d0 >> 2));
        const bf16x8 b1 = *(const LAS bf16x8*)(ks + kro[d0 & 3] + 128 * (d0 >> 2) + 12288);
        p0 = __builtin_amdgcn_mfma_f32_32x32x16_bf16(b0, qr[d0], p0, 0, 0, 0);
        p1 = __builtin_amdgcn_mfma_f32_32x32x16_bf16(b1, qr[d0], p1, 0, 0, 0); }
}
#if ATT_QK8
typedef int at_v8i __attribute__((ext_vector_type(8)));
__device__ __forceinline__ at_v8i at_cat8(u32x4 lo, u32x4 hi) { return (at_v8i){(int)lo.x, (int)lo.y, (int)lo.z, (int)lo.w, (int)hi.x, (int)hi.y, (int)hi.z, (int)hi.w}; }
__device__ __forceinline__ void at_qkt8(f32x16& p0, f32x16& p1, const LAS char* ks, int kb0, int kb1, const at_v8i* qf) {
    p0 = f32x16{}; p1 = f32x16{};
#pragma unroll
    for (int s = 0; s < 3; ++s) {
        const u32x4 a0 = *(const LAS u32x4*)(ks + kb0 + 64 * s), a1 = *(const LAS u32x4*)(ks + kb1 + 64 * s);
        const u32x4 b0 = *(const LAS u32x4*)(ks + kb0 + 64 * s + 6144), b1 = *(const LAS u32x4*)(ks + kb1 + 64 * s + 6144);
        p0 = __builtin_amdgcn_mfma_scale_f32_32x32x64_f8f6f4(at_cat8(a0, a1), qf[s], p0, 0, 0, 0, 0, 0, 0);
        p1 = __builtin_amdgcn_mfma_scale_f32_32x32x64_f8f6f4(at_cat8(b0, b1), qf[s], p1, 0, 0, 0, 0, 0, 0); }
}
#endif
#if ATT_PV8
__device__ __forceinline__ unsigned pk4_bf8(float a, float b, float c, float d) { unsigned w = 0; w = __builtin_amdgcn_cvt_pk_bf8_f32(a, b, w, false); w = __builtin_amdgcn_cvt_pk_bf8_f32(c, d, w, true); return w; }
__device__ __forceinline__ void at_packP8(const f32x16& p0, const f32x16& p1, at_v8i& PA) {
#pragma unroll
    for (int g = 0; g < 4; ++g) { const unsigned a = pk4_bf8(p0[4 * g], p0[4 * g + 1], p0[4 * g + 2], p0[4 * g + 3]), b = pk4_bf8(p1[4 * g], p1[4 * g + 1], p1[4 * g + 2], p1[4 * g + 3]);
        auto r = __builtin_amdgcn_permlane32_swap(a, b, false, false); PA[2 * g] = (int)r[0]; PA[2 * g + 1] = (int)r[1]; }
}
__device__ __forceinline__ void at_finishSM8(f32x16& p0, f32x16& p1, float alpha, float& l_reg, at_v8i& PA) {
#pragma unroll
    for (int r = 0; r < 16; ++r) p1[r] = __builtin_amdgcn_exp2f(p1[r]);
    float ps = 0.f;
#pragma unroll
    for (int r = 0; r < 16; ++r) ps += p0[r];
#pragma unroll
    for (int r = 0; r < 16; ++r) ps += p1[r];
    { auto rr = __builtin_amdgcn_permlane32_swap(__float_as_uint(ps), __float_as_uint(ps), false, false);
      ps = __uint_as_float(rr[0]) + __uint_as_float(rr[1]); }
    l_reg = l_reg * alpha + ps;
    at_packP8(p0, p1, PA);
}
__device__ __forceinline__ void pv8(f32x16* o, const LAS char* vs, int vk0, int vk1, const at_v8i& PA) {
#pragma unroll
    for (int d0 = 0; d0 < 4; ++d0) { const u32x4 a = *(const LAS u32x4*)(vs + vk0 + 2048 * d0), b = *(const LAS u32x4*)(vs + vk1 + 2048 * d0);
        o[d0] = __builtin_amdgcn_mfma_scale_f32_32x32x64_f8f6f4(PA, at_cat8(a, b), o[d0], 1, 0, 0, 0, 0, 0); }
}
#endif
__device__ __forceinline__ int v_rd_base(int lane) { return ((lane & 3) << 3) | (((lane >> 2) & 3) << 6) | (((lane >> 4) & 1) << 5) | (((lane >> 5) & 1) << 8); }
constexpr int v_rd_off(int d0, int ks, int half) { return d0 * 512 + ks * 4096 + half * 2048; }
template <int OFF> __device__ __forceinline__ s16x4 tr_read(int vb) { s16x4 r; asm volatile("ds_read_b64_tr_b16 %0, %1 offset:%2" : "=&v"(r) : "v"(vb), "i"(OFF) : "memory"); return r; }
template <int D0> __device__ __forceinline__ void pv_one(f32x16& od, int vb, bf16x8 pa0, bf16x8 pa1, bf16x8 pa2, bf16x8 pa3) {
    const s16x4 l0 = tr_read<v_rd_off(D0, 0, 0)>(vb), h0 = tr_read<v_rd_off(D0, 0, 1)>(vb), l1 = tr_read<v_rd_off(D0, 1, 0)>(vb), h1 = tr_read<v_rd_off(D0, 1, 1)>(vb);
    const s16x4 l2 = tr_read<v_rd_off(D0, 2, 0)>(vb), h2 = tr_read<v_rd_off(D0, 2, 1)>(vb), l3 = tr_read<v_rd_off(D0, 3, 0)>(vb), h3 = tr_read<v_rd_off(D0, 3, 1)>(vb);
    asm volatile("s_waitcnt lgkmcnt(0)" ::: "memory"); SBAR();
#define PKV(L, H) (bf16x8){L[0], L[1], L[2], L[3], H[0], H[1], H[2], H[3]}
    od = __builtin_amdgcn_mfma_f32_32x32x16_bf16(pa0, PKV(l0, h0), od, 0, 0, 0);
    od = __builtin_amdgcn_mfma_f32_32x32x16_bf16(pa1, PKV(l1, h1), od, 0, 0, 0);
    od = __builtin_amdgcn_mfma_f32_32x32x16_bf16(pa2, PKV(l2, h2), od, 0, 0, 0);
    od = __builtin_amdgcn_mfma_f32_32x32x16_bf16(pa3, PKV(l3, h3), od, 0, 0, 0);
#undef PKV
}
#if PV_PIPE
__device__ __forceinline__ void pv_d0(f32x16* o, int vb, bf16x8 pa0, bf16x8 pa1, bf16x8 pa2, bf16x8 pa3) {
#define TRSET(D0, N) const s16x4 N##0 = tr_read<v_rd_off(D0, 0, 0)>(vb), N##1 = tr_read<v_rd_off(D0, 0, 1)>(vb), N##2 = tr_read<v_rd_off(D0, 1, 0)>(vb), N##3 = tr_read<v_rd_off(D0, 1, 1)>(vb), \
                                   N##4 = tr_read<v_rd_off(D0, 2, 0)>(vb), N##5 = tr_read<v_rd_off(D0, 2, 1)>(vb), N##6 = tr_read<v_rd_off(D0, 3, 0)>(vb), N##7 = tr_read<v_rd_off(D0, 3, 1)>(vb)
#define PKV(L, H) (bf16x8){L[0], L[1], L[2], L[3], H[0], H[1], H[2], H[3]}
#define PVM(OD, N) do { OD = __builtin_amdgcn_mfma_f32_32x32x16_bf16(pa0, PKV(N##0, N##1), OD, 0, 0, 0); OD = __builtin_amdgcn_mfma_f32_32x32x16_bf16(pa1, PKV(N##2, N##3), OD, 0, 0, 0); \
                        OD = __builtin_amdgcn_mfma_f32_32x32x16_bf16(pa2, PKV(N##4, N##5), OD, 0, 0, 0); OD = __builtin_amdgcn_mfma_f32_32x32x16_bf16(pa3, PKV(N##6, N##7), OD, 0, 0, 0); } while (0)
    TRSET(0, a); TRSET(1, b);
    asm volatile("s_waitcnt lgkmcnt(8)" ::: "memory"); SBAR(); PVM(o[0], a);
    TRSET(2, c);
    asm volatile("s_waitcnt lgkmcnt(8)" ::: "memory"); SBAR(); PVM(o[1], b);
    TRSET(3, d);
    asm volatile("s_waitcnt lgkmcnt(8)" ::: "memory"); SBAR(); PVM(o[2], c);
    asm volatile("s_waitcnt lgkmcnt(0)" ::: "memory"); SBAR(); PVM(o[3], d);
#undef TRSET
#undef PKV
#undef PVM
}
#else
__device__ __forceinline__ void pv_d0(f32x16* o, int vb, bf16x8 pa0, bf16x8 pa1, bf16x8 pa2, bf16x8 pa3) {
    pv_one<0>(o[0], vb, pa0, pa1, pa2, pa3); pv_one<1>(o[1], vb, pa0, pa1, pa2, pa3); pv_one<2>(o[2], vb, pa0, pa1, pa2, pa3); pv_one<3>(o[3], vb, pa0, pa1, pa2, pa3);
}
#endif
#define AT_WAITBAR(N) asm volatile("s_waitcnt vmcnt(" #N ") lgkmcnt(0)\n\ts_barrier" ::: "memory")
#define AT_WAITBAR_N(N) AT_WAITBAR(N)

__device__ __forceinline__ void attn_unit(const Ctx& C, int b, int h, int qb) {
    const bf16_t* Qb = WSP(bf16_t, WS_Q); float* ya = WSP(float, WS_YATT);
    const int lane = C.lane, wid = C.wave, r32 = lane & 31, hi = lane >> 5;
    const int rowbase = b * SEQ, q0 = qb * 256;
    const unsigned lds0 = (unsigned)(uintptr_t)C.lds;
    LAS float* wsf = (LAS float*)(C.lds + AT_WS) + wid * 64; LAS float* li_l = wsf; LAS float* al_l = wsf + 32;
    const unsigned char* kimg = uniform_ptr(C.ws + WS_KIMG + ((size_t)rowbase * 768 + h * 192) * (ATT_QK8 ? 1 : 2));
#if ATT_PV8
    const unsigned char* vimg = uniform_ptr(C.ws + WS_VIMG + ((size_t)(rowbase / 64) * 4 + h) * 8192);
#else
    const unsigned char* vimg = uniform_ptr(C.ws + WS_VIMG + ((size_t)rowbase * 512 + h * 128) * 2);
#endif
#if ATT_QK8
    unsigned kvoff[2];
#pragma unroll
    for (int i = 0; i < 2; ++i) { const int q = 64 * (wid + 8 * i) + lane, row = q / 12, cp = q % 12, c = (cp & ~3) | ((cp & 3) ^ ((row >> 2) & 3)); kvoff[i] = (unsigned)(row * 768 + c * 16); }
#else
    unsigned kvoff[3];
#pragma unroll
    for (int i = 0; i < 3; ++i) { const int q = 64 * (wid + 8 * i) + lane, row = q / 24, cp = q % 24, c = (cp & ~7) | ((cp & 7) ^ ((row >> 1) & 7)); kvoff[i] = (unsigned)(row * 1536 + c * 16); }
#endif
#if ATT_PV8
    unsigned vvoff[1];
    { const int q = 64 * wid + lane, row = q >> 2, cp = q & 3; vvoff[0] = (unsigned)(row * 64 + ((cp ^ ((row >> 2) & 3)) * 16)); }
#else
    unsigned vvoff[2];
#pragma unroll
    for (int j = 0; j < 2; ++j) { const int P = wid + 8 * j, sub = 2 * P + (lane >> 5), kk = (sub >> 2) * 8 + ((lane & 31) >> 2), k = (kk & ~0xC) | ((kk & 4) << 1) | ((kk & 8) >> 1), col = (sub & 3) * 32 + (lane & 3) * 8;
        vvoff[j] = (unsigned)(k * 1024 + col * 2); }
#endif
    const unsigned kdst = lds0 + AT_K + wid * 1024, vdst = lds0 + AT_V + wid * 1024;
#if ATT_PV8
#define AT_DMA(t, slot) do { const unsigned char* ks_ = kimg + (size_t)(t) * (64 * 768); const unsigned char* vs_ = vimg + (size_t)(t) * 32768; \
        const unsigned kd_ = (unsigned)__builtin_amdgcn_readfirstlane(kdst + (slot) * AT_KB), vd_ = (unsigned)__builtin_amdgcn_readfirstlane(vdst + (slot) * AT_VB); \
        glds16(vs_, vvoff[0], vd_); glds16(ks_, kvoff[0], kd_); if (wid < 4) glds16(ks_, kvoff[1], kd_ + 8192); } while (0)
#define AT_NDMA 2
#elif ATT_QK8
#define AT_DMA(t, slot) do { const unsigned char* ks_ = kimg + (size_t)(t) * (64 * 768); const unsigned char* vs_ = vimg + (size_t)(t) * (64 * 1024); \
        const unsigned kd_ = (unsigned)__builtin_amdgcn_readfirstlane(kdst + (slot) * AT_KB), vd_ = (unsigned)__builtin_amdgcn_readfirstlane(vdst + (slot) * AT_VB); \
        glds16(vs_, vvoff[0], vd_); glds16(vs_, vvoff[1], vd_ + 8192); glds16(ks_, kvoff[0], kd_); if (wid < 4) glds16(ks_, kvoff[1], kd_ + 8192); } while (0)
#define AT_NDMA 3
#else
#define AT_DMA(t, slot) do { const unsigned char* ks_ = kimg + (size_t)(t) * (64 * 1536); const unsigned char* vs_ = vimg + (size_t)(t) * (64 * 1024); \
        const unsigned kd_ = (unsigned)__builtin_amdgcn_readfirstlane(kdst + (slot) * AT_KB), vd_ = (unsigned)__builtin_amdgcn_readfirstlane(vdst + (slot) * AT_VB); \
        glds16(ks_, kvoff[0], kd_); glds16(ks_, kvoff[1], kd_ + 8192); glds16(ks_, kvoff[2], kd_ + 16384); glds16(vs_, vvoff[0], vd_); glds16(vs_, vvoff[1], vd_ + 8192); } while (0)
#define AT_NDMA 5
#endif
    const int NT = 4 * qb + 4, jlim = 4 * qb + (wid >> 1);
#if ATT_QK8
    at_v8i qf[3];
    { const unsigned char* Qw = (const unsigned char*)Qb + (size_t)(rowbase + q0 + wid * 32 + r32) * 768 + h * 192 + hi * 32;
#pragma unroll
      for (int s = 0; s < 3; ++s) qf[s] = at_cat8(*(const u32x4*)(Qw + 64 * s), *(const u32x4*)(Qw + 64 * s + 16)); }
    const int kb0 = r32 * 192 + 16 * ((2 * hi) ^ ((r32 >> 2) & 3)), kb1 = kb0 ^ 16;
#define AT_QKT(C0, C1, KS) at_qkt8(C0, C1, KS, kb0, kb1, qf)
#else
    bf16x8 qr[12];
    { const bf16_t* Qw = Qb + (size_t)(rowbase + q0 + wid * 32 + r32) * 768 + h * 192 + hi * 8;
#pragma unroll
      for (int d0 = 0; d0 < 12; ++d0) qr[d0] = *(const bf16x8*)(Qw + d0 * 16); }
#define AT_QKT(C0, C1, KS) at_qkt(C0, C1, KS, kro, qr)
#endif
    AT_DMA(0, 0); AT_DMA(1, 1);
    const LAS char* kp0 = (const LAS char*)C.lds + AT_K;
#if !ATT_QK8
    int kro[4];
#pragma unroll
    for (int j = 0; j < 4; ++j) kro[j] = r32 * 384 + 16 * ((2 * j + hi) ^ ((r32 >> 1) & 7));
#endif
    float m_reg = -1e30f, l_reg = 0.f; f32x16 o[4] = {};
    f32x16 pA0, pA1, pB0, pB1; float mnA, mnB, alA, alB;
#if ATT_PV8
    const LAS char* vp0 = (const LAS char*)C.lds + AT_V; const int vk0 = r32 * 64 + 16 * ((2 * hi) ^ ((r32 >> 2) & 3)), vk1 = vk0 ^ 16;
    at_v8i PA;
#define AT_FIN(P0, P1, ALP) at_finishSM8(P0, P1, ALP, l_reg, PA)
#define AT_PV(SLOT) pv8(o, vp0 + (SLOT) * AT_VB, vk0, vk1, PA)
#else
    const int vb0 = (int)(lds0 + AT_V) + v_rd_base(lane);
    bf16x8 pa0, pa1, pa2, pa3;
#define AT_FIN(P0, P1, ALP) at_finishSM(P0, P1, ALP, l_reg, pa0, pa1, pa2, pa3)
#define AT_PV(SLOT) pv_d0(o, vb0 + (SLOT) * AT_VB, pa0, pa1, pa2, pa3)
#endif
#define AT_RESC(a) do { if (__any((a) < 1.f)) { if (hi == 0) al_l[r32] = (a); asm volatile("s_waitcnt lgkmcnt(0)" ::: "memory"); \
        _Pragma("unroll") for (int d = 0; d < 4; ++d) _Pragma("unroll") for (int r = 0; r < 16; ++r) o[d][r] *= al_l[crow(r, hi)]; } } while (0)
#define AT_MASKED(P0, P1) do { _Pragma("unroll") for (int r = 0; r < 16; ++r) { P0[r] = -1e30f; P1[r] = -1e30f; } } while (0)
#if ATT_PV8
#define AT_W_FIRST() do { if (wid < 4) AT_WAITBAR(9); else AT_WAITBAR(6); } while (0)
#define AT_W_STEADY() do { if (wid < 4) AT_WAITBAR(6); else AT_WAITBAR(4); } while (0)
#define AT_STEP(C0, C1, MNC, ALC, P0, P1, ALP, j) do { const int sj_ = (j) % 5, sp_ = ((j) + 4) % 5; \
        SBAR(); if ((j) <= jlim) AT_QKT(C0, C1, kp0 + sj_ * AT_KB); else AT_MASKED(C0, C1); \
        AT_FIN(P0, P1, ALP); SBAR(); \
        if ((j) - 1 <= jlim) AT_PV(sp_); \
        at_partialSM(C0, C1, m_reg, MNC, ALC); \
        if ((j) + 3 < NT) AT_W_STEADY(); else AT_WAITBAR(0); \
        if ((j) + 4 < NT) AT_DMA((j) + 4, sp_); \
        AT_RESC(ALC); } while (0)
    AT_DMA(2, 2); AT_DMA(3, 3);
    AT_W_FIRST();
    AT_QKT(pA0, pA1, kp0); at_partialSM(pA0, pA1, m_reg, mnA, alA);
    AT_W_STEADY();
    if (4 < NT) AT_DMA(4, 4);
    AT_RESC(alA);
    for (int j = 1; j + 1 < NT; j += 2) {
        AT_STEP(pB0, pB1, mnB, alB, pA0, pA1, alA, j);
        AT_STEP(pA0, pA1, mnA, alA, pB0, pB1, alB, j + 1);
    }
    AT_STEP(pB0, pB1, mnB, alB, pA0, pA1, alA, NT - 1);
    AT_FIN(pB0, pB1, alB); SBAR();
    if (NT - 1 <= jlim) AT_PV((NT - 1) % 5);
#undef AT_W_FIRST
#undef AT_W_STEADY
#else
#define AT_STEP(C0, C1, MNC, ALC, P0, P1, ALP, j) do { const int sj_ = (j) % 3, sp_ = ((j) + 2) % 3; \
        SBAR(); if ((j) <= jlim) AT_QKT(C0, C1, kp0 + sj_ * AT_KB); else AT_MASKED(C0, C1); \
        AT_FIN(P0, P1, ALP); SBAR(); \
        if ((j) - 1 <= jlim) AT_PV(sp_); \
        at_partialSM(C0, C1, m_reg, MNC, ALC); \
        AT_WAITBAR(0); \
        if ((j) + 2 < NT) AT_DMA((j) + 2, sp_); \
        AT_RESC(ALC); } while (0)
    AT_WAITBAR_N(AT_NDMA);
    AT_QKT(pA0, pA1, kp0); at_partialSM(pA0, pA1, m_reg, mnA, alA);
    AT_DMA(2, 2);
    AT_WAITBAR_N(AT_NDMA);
    AT_RESC(alA);
    for (int j = 1; j + 1 < NT; j += 2) {
        AT_STEP(pB0, pB1, mnB, alB, pA0, pA1, alA, j);
        AT_STEP(pA0, pA1, mnA, alA, pB0, pB1, alB, j + 1);
    }
    AT_STEP(pB0, pB1, mnB, alB, pA0, pA1, alA, NT - 1);
    AT_FIN(pB0, pB1, alB); SBAR();
    if (NT - 1 <= jlim) AT_PV((NT - 1) % 3);
#endif
    if (hi == 0) li_l[r32] = l_reg;
    asm volatile("s_waitcnt lgkmcnt(0)" ::: "memory");
    float rli[16];
#pragma unroll
    for (int r = 0; r < 16; ++r) rli[r] = __builtin_amdgcn_rcpf(li_l[crow(r, hi)]);
    float* Ow = ya + (size_t)(rowbase + q0 + wid * 32) * 512 + h * 128;
#pragma unroll
    for (int r = 0; r < 16; ++r) { const int orow = crow(r, hi);
#pragma unroll
        for (int d0 = 0; d0 < 4; ++d0) Ow[(size_t)orow * 512 + d0 * 32 + r32] = o[d0][r] * rli[r]; }
    AT_WAITBAR(0);
#undef AT_FIN
#undef AT_PV
#undef AT_DMA
#undef AT_NDMA
#undef AT_QKT
#undef AT_RESC
#undef AT_MASKED
#undef AT_STEP
}
__device__ __forceinline__ void ph_attn(const Ctx& C, int l) {
    const int vcu = (C.G % 8 == 0) ? (C.bid % 8) * (C.G / 8) + C.bid / 8 : C.bid;
    for (int p = vcu; p < 256; p += C.G) { const int bh = p >> 3, s = p & 7;
        for (int u = 0; u < 2; ++u) attn_unit(C, bh >> 2, bh & 3, u ? s : 15 - s); }
}
__device__ __forceinline__ void ph_mixnorm(const Ctx& C, int l) {
    const bf16_t* ymix = WSP(bf16_t, WS_YMIX); const float* ya = WSP(float, WS_YATT); bf16_t* mix = WSP(bf16_t, WS_MIX);
    const int lane = C.lane, stride = C.G * NWAVE; int t = C.bid * NWAVE + C.wave;
    if (t >= T) return;
    u32x2 pn = *(const u32x2*)(ymix + (size_t)t * 512 + 4 * lane), qn = *(const u32x2*)(ymix + (size_t)t * 512 + 256 + 4 * lane);
    f32x4 a0n = *(const f32x4*)(ya + (size_t)t * 512 + 8 * lane), a1n = *(const f32x4*)(ya + (size_t)t * 512 + 8 * lane + 4);
    u32x2 pn2 = pn, qn2 = qn; f32x4 a0n2 = a0n, a1n2 = a1n;
    if (t + stride < T) { const int tn = t + stride;
        pn2 = *(const u32x2*)(ymix + (size_t)tn * 512 + 4 * lane); qn2 = *(const u32x2*)(ymix + (size_t)tn * 512 + 256 + 4 * lane);
        a0n2 = *(const f32x4*)(ya + (size_t)tn * 512 + 8 * lane); a1n2 = *(const f32x4*)(ya + (size_t)tn * 512 + 8 * lane + 4); }
    for (; t < T; t += stride) {
        const u32x2 p = pn, q = qn; const f32x4 a0 = a0n, a1 = a1n;
        pn = pn2; qn = qn2; a0n = a0n2; a1n = a1n2;
        if (t + 2 * stride < T) { const int tn = t + 2 * stride;
            pn2 = *(const u32x2*)(ymix + (size_t)tn * 512 + 4 * lane); qn2 = *(const u32x2*)(ymix + (size_t)tn * 512 + 256 + 4 * lane);
            a0n2 = *(const f32x4*)(ya + (size_t)tn * 512 + 8 * lane); a1n2 = *(const f32x4*)(ya + (size_t)tn * 512 + 8 * lane + 4); }
        const float p0 = bflo(p.x), p1 = bfhi(p.x), p2 = bflo(p.y), p3 = bfhi(p.y), q0 = bflo(q.x), q1 = bfhi(q.x), q2 = bflo(q.y), q3 = bfhi(q.y);
        const float rp = rsqrtf(wave_sum((p0 * p0 + p1 * p1) + (p2 * p2 + p3 * p3)) * (1.f / 256.f) + EPS);
        const float rq = rsqrtf(wave_sum((q0 * q0 + q1 * q1) + (q2 * q2 + q3 * q3)) * (1.f / 256.f) + EPS);
        const float ra = rsqrtf(wave_sum((a0.x * a0.x + a0.y * a0.y) + (a0.z * a0.z + a0.w * a0.w) + (a1.x * a1.x + a1.y * a1.y) + (a1.z * a1.z + a1.w * a1.w)) * (1.f / 512.f) + EPS);
#if OUTPROJ_FP8
        unsigned char* mr8 = C.ws + WS_MIX + (size_t)t * 1024;
        *(unsigned*)(mr8 + 4 * lane) = pk4_fp8(p0 * rp, p1 * rp, p2 * rp, p3 * rp);
        *(unsigned*)(mr8 + 256 + 4 * lane) = pk4_fp8(q0 * rq, q1 * rq, q2 * rq, q3 * rq);
        *(u32x2*)(mr8 + 512 + 8 * lane) = (u32x2){pk4_fp8(a0.x * ra, a0.y * ra, a0.z * ra, a0.w * ra), pk4_fp8(a1.x * ra, a1.y * ra, a1.z * ra, a1.w * ra)};
#else
        bf16_t* mr = mix + (size_t)t * 1024;
        *(u32x2*)(mr + 4 * lane) = (u32x2){pk2(p0 * rp, p1 * rp), pk2(p2 * rp, p3 * rp)};
        *(u32x2*)(mr + 256 + 4 * lane) = (u32x2){pk2(q0 * rq, q1 * rq), pk2(q2 * rq, q3 * rq)};
        *(u32x4*)(mr + 512 + 8 * lane) = (u32x4){pk2(a0.x * ra, a0.y * ra), pk2(a0.z * ra, a0.w * ra), pk2(a1.x * ra, a1.y * ra), pk2(a1.z * ra, a1.w * ra)};
#endif
    }
}
__device__ __forceinline__ void ph_outproj(const Ctx& C, int l) {
    const bf16_t* mix = WSP(bf16_t, WS_MIX); const bf16_t* W = WSP(bf16_t, WS_WO) + (size_t)l * 1024 * 1024;
    const float* xin = (l == 0) ? C.x : C.out; float* xo = C.out;
    for (int u = C.bid; u < 256 * 8; u += C.G) { const int rt = u / 8, ct = u % 8;
        sg_tile<1>(C, [&](int r) { return mix + (size_t)(rt * 128 + r) * 1024; }, W + (size_t)ct * 128 * 1024, nullptr, 1024,
                   [&](int r, int c, float v, float) { const size_t o = (size_t)(rt * 128 + r) * 1024 + ct * 128 + c; xo[o] = xin[o] + v; });
    }
}
typedef float f32x16_r __attribute__((ext_vector_type(16)));
__device__ __forceinline__ void ph_route(const Ctx& C, int l, int dummy = 0) {
    const bf16_t* x = WSP(bf16_t, WS_XB); const bf16_t* Wh = WSP(bf16_t, WS_WR) + (size_t)(l * 2) * 32 * 1024; const bf16_t* Wl = Wh + 32 * 1024;
    int* ltok = dummy ? WSP(int, WS_YB) : WSP(int, WS_LTOK); float* lgate = dummy ? WSP(float, WS_YB + 8 * MiB) : WSP(float, WS_LGATE); unsigned* asg = dummy ? WSP(unsigned, WS_YB + 16 * MiB) : WSP(unsigned, WS_ASG);
    unsigned* gcnt = WSP(unsigned, WS_CTL) + CW_GCNT + l * NEXP * 64 + (dummy ? 8192 : 0);
    constexpr int XROW = 2064;
    LAS unsigned char* xt = C.lds;
    LAS float* red = (LAS float*)(C.lds + 66048);
    LAS float* lg = (LAS float*)(C.lds + 98816);
    LAS float* rsv = (LAS float*)(C.lds + 102912);
    LAS float* tmpv = (LAS float*)(C.lds + 103040) + C.wave * 4;
    LAS int* sel_e = (LAS int*)(C.lds + 103424);
    LAS float* sel_g = (LAS float*)(C.lds + 105472);
    LAS int* ctl = (LAS int*)(C.lds + LDS_CTL);
    const int lane = C.lane, w = C.wave, tid = C.tid, r32 = lane & 31, hi = lane >> 5;
    bf16x8 ah[8], al[8];
#pragma unroll
    for (int ks = 0; ks < 8; ++ks) { ah[ks] = *(const bf16x8*)(Wh + (size_t)r32 * 1024 + 128 * w + 16 * ks + 8 * hi); al[ks] = *(const bf16x8*)(Wl + (size_t)r32 * 1024 + 128 * w + 16 * ks + 8 * hi); }
    const float* bias = WSP(float, WS_PAR) + P_BR + l * 32;
    for (int chunk = C.bid; chunk < T / 128; chunk += C.G) {
        const int tok0 = chunk * 128;
        if (tid < 32) ctl[96 + tid] = 0;
        u32x4 q[4][2];
#pragma unroll
        for (int i = 0; i < 4; ++i) { const u32x4* xr = (const u32x4*)(x + (size_t)(tok0 + 4 * w + i) * DM + 16 * lane); q[i][0] = xr[0]; q[i][1] = xr[1]; }
        for (int tile = 0; tile < 4; ++tile) {
#pragma unroll
            for (int i = 0; i < 4; ++i) { const int t = tok0 + 32 * tile + 4 * w + i; const u32x4 a = q[i][0], b = q[i][1];
                float v[16] = {bflo(a.x), bfhi(a.x), bflo(a.y), bfhi(a.y), bflo(a.z), bfhi(a.z), bflo(a.w), bfhi(a.w), bflo(b.x), bfhi(b.x), bflo(b.y), bfhi(b.y), bflo(b.z), bfhi(b.z), bflo(b.w), bfhi(b.w)};
                float ss = 0.f;
#pragma unroll
                for (int j = 0; j < 16; ++j) ss += v[j] * v[j];
                const float rs = rsqrtf(wave_sum(ss) * (1.f / DM) + EPS);
                *(u32x4*)(C.ws + WS_HB8 + (size_t)t * 1024 + 16 * lane) = (u32x4){pk4_fp8(v[0] * rs, v[1] * rs, v[2] * rs, v[3] * rs), pk4_fp8(v[4] * rs, v[5] * rs, v[6] * rs, v[7] * rs),
                                                                                 pk4_fp8(v[8] * rs, v[9] * rs, v[10] * rs, v[11] * rs), pk4_fp8(v[12] * rs, v[13] * rs, v[14] * rs, v[15] * rs)};
                LAS u32x4* dst = (LAS u32x4*)(xt + (4 * w + i) * XROW + 32 * lane); dst[0] = a; dst[1] = b;
                if (lane == 0) rsv[4 * w + i] = rs; }
            if (tile < 3) {
#pragma unroll
                for (int i = 0; i < 4; ++i) { const u32x4* xr = (const u32x4*)(x + (size_t)(tok0 + 32 * (tile + 1) + 4 * w + i) * DM + 16 * lane); q[i][0] = xr[0]; q[i][1] = xr[1]; } }
            __syncthreads();
            { f32x16_r d = {};
#pragma unroll
              for (int ks = 0; ks < 8; ++ks) { const bf16x8 bx = *(const LAS bf16x8*)(xt + r32 * XROW + (128 * w + 16 * ks + 8 * hi) * 2);
                  d = __builtin_amdgcn_mfma_f32_32x32x16_bf16(ah[ks], bx, d, 0, 0, 0); d = __builtin_amdgcn_mfma_f32_32x32x16_bf16(al[ks], bx, d, 0, 0, 0); }
#pragma unroll
              for (int r = 0; r < 16; ++r) red[(w * 16 + r) * 64 + lane] = d[r]; }
            __syncthreads();
            { const int tk = tid & 31, hi_ = (tid >> 5) & 1, r0 = tid >> 6; const float rs = rsv[tk];
#pragma unroll
              for (int rr = 0; rr < 2; ++rr) { const int r = r0 + 8 * rr; float sm = 0.f;
#pragma unroll
                  for (int ww = 0; ww < 8; ++ww) sm += red[(ww * 16 + r) * 64 + tk + 32 * hi_];
                  const int e = (r & 3) + 8 * (r >> 2) + 4 * hi_; lg[tk * 32 + e] = sm * rs + bias[e]; } }
            __syncthreads();
#pragma unroll
            for (int i = 0; i < 4; ++i) { const int tk = 4 * w + i, e = lane & 31; const float mine = lg[tk * 32 + e]; int rank = 0;
#pragma unroll
                for (int c4 = 0; c4 < 8; ++c4) { const f32x4 qv = *(const LAS f32x4*)(lg + tk * 32 + 4 * c4);
                    rank += (qv.x > mine || (qv.x == mine && 4 * c4 + 0 < e)) ? 1 : 0; rank += (qv.y > mine || (qv.y == mine && 4 * c4 + 1 < e)) ? 1 : 0;
                    rank += (qv.z > mine || (qv.z == mine && 4 * c4 + 2 < e)) ? 1 : 0; rank += (qv.w > mine || (qv.w == mine && 4 * c4 + 3 < e)) ? 1 : 0; }
                if (lane < 32 && rank < 4) tmpv[rank] = mine;
                asm volatile("s_waitcnt lgkmcnt(0)" ::: "memory");
                const f32x4 tv = *(const LAS f32x4*)tmpv;
                const float inv = 1.f / (1.f + __expf(tv.y - tv.x) + __expf(tv.z - tv.x) + __expf(tv.w - tv.x));
                if (lane < 32 && rank < 4) { const int tl = 32 * tile + tk; sel_e[tl * 4 + rank] = e; sel_g[tl * 4 + rank] = __expf(mine - tv.x) * inv; }
                asm volatile("s_waitcnt lgkmcnt(0)" ::: "memory"); }
        }
        __syncthreads();
        const int e = sel_e[tid]; const float gt = sel_g[tid];
        const int rank = __hip_atomic_fetch_add(&ctl[96 + e], 1, __ATOMIC_RELAXED, __HIP_MEMORY_SCOPE_WORKGROUP);
        __syncthreads();
        if (tid < 32) ctl[128 + tid] = (int)__hip_atomic_fetch_add(gcnt + tid * 64, (unsigned)ctl[96 + tid], __ATOMIC_RELAXED, __HIP_MEMORY_SCOPE_AGENT);
        __syncthreads();
        const int slot = ctl[128 + e] + rank, tok = tok0 + (tid >> 2);
        ltok[(size_t)e * T + slot] = tok; lgate[(size_t)tok * 4 + (tid & 3)] = gt; asg[(size_t)tok * 4 + (tid & 3)] = ((unsigned)e << 24) | (unsigned)slot;
        __syncthreads();
    }
}
__device__ __forceinline__ void ph_gateup(const Ctx& C, int l) {
    moe_tables(C, l);
    LAS int* ctl = (LAS int*)(C.lds + LDS_CTL);
    const bf16_t* hb = WSP(bf16_t, WS_HB); const int* ltok = WSP(int, WS_LTOK); bf16_t* act = WSP(bf16_t, WS_ACT);
    const int nrt = ctl[32 + NEXP];
    for (int u = C.bid; u < nrt * 2 * 8; u += C.G) { const int rt128 = u >> 3, pn = u & 7, rt = rt128 >> 1, sub = rt128 & 1;
        const int e = moe_find_expert(C, rt), cnt = ctl[e], lrow0 = (rt - ctl[32 + e]) * 256 + sub * 128;
        const bf16_t* W = WSP(bf16_t, WS_WGU) + ((size_t)(l * NEXP + e) * 2048 + pn * 256) * 1024;
        const float* bg = WSP(float, WS_PAR) + P_BGU + (size_t)(l * NEXP + e) * 2048;
        const size_t arow0 = (size_t)rt * 256 + sub * 128;
        sg_tile<2>(C, [&](int r) { const int li = lrow0 + r; const int tok = (li < cnt) ? ltok[(size_t)e * T + li] : 0; return hb + (size_t)tok * 1024; }, W, W + (size_t)128 * 1024, 1024,
                   [&](int r, int c, float vg, float vl) { const int j = pn * 128 + c; vg += bg[2 * j]; vl += bg[2 * j + 1];
                       const float xg = fminf(vg, 7.f), xl = fminf(fmaxf(vl, -7.f), 7.f);
                       act[(arow0 + r) * 1024 + j] = (bf16_t)f2bf(xg * sigmoidf_(1.702f * xg) * (xl + 1.f)); });
    }
}
__device__ __forceinline__ void ph_down(const Ctx& C, int l) {
    moe_tables(C, l);
    LAS int* ctl = (LAS int*)(C.lds + LDS_CTL);
    const bf16_t* act = WSP(bf16_t, WS_ACT); const float* lgate = WSP(float, WS_LGATE); bf16_t* yb = WSP(bf16_t, WS_YB);
    const int nrt = ctl[32 + NEXP];
    for (int u = C.bid; u < nrt * 2 * 8; u += C.G) { const int rt128 = u >> 3, ct = u & 7, rt = rt128 >> 1, sub = rt128 & 1;
        const int e = moe_find_expert(C, rt), cnt = ctl[e], lrow0 = (rt - ctl[32 + e]) * 256 + sub * 128;
        const bf16_t* W = WSP(bf16_t, WS_WD) + ((size_t)(l * NEXP + e) * 1024 + ct * 128) * 1024;
        const float* bd = WSP(float, WS_PAR) + P_BDN + (size_t)(l * NEXP + e) * 1024;
        const size_t arow0 = (size_t)rt * 256 + sub * 128;
        sg_tile<1>(C, [&](int r) { return act + (arow0 + r) * 1024; }, W, nullptr, 1024,
                   [&](int r, int c, float v, float) { const int li = lrow0 + r; const float g = (li < cnt) ? lgate[(size_t)e * T + li] : 0.f;
                       yb[(arow0 + r) * 1024 + ct * 128 + c] = (bf16_t)f2bf((v + bd[ct * 128 + c]) * g); });
    }
}
static_assert(MOE_FP8 == 1, "the combine phase reads the expert outputs as fp8 x16 (the MOE_FP8 path)");
struct CmbIn { u32x4 x0, x1; u32x4 y[4]; f32x4 g; };
__device__ __forceinline__ CmbIn cmb_load(const Ctx& C, int t, u32x4 a4, int lane) {
    LAS int* ctl = (LAS int*)(C.lds + LDS_CTL); CmbIn r;
    const u32x4* xr = (const u32x4*)(WSP(bf16_t, WS_XB) + (size_t)t * DM + 16 * lane); r.x0 = xr[0]; r.x1 = xr[1]; r.g = *(const f32x4*)(WSP(float, WS_LGATE) + (size_t)t * 4);
#pragma unroll
    for (int k = 0; k < 4; ++k) { const unsigned a = a4[k]; const int e = a >> 24, slot = a & 0xffffff; const size_t row = (size_t)ctl[32 + e] * 256 + slot;
        r.y[k] = *(const u32x4*)(C.ws + WS_YB + row * 1024 + 16 * lane); }
    return r;
}
__device__ __forceinline__ void ph_combine(const Ctx& C, int l, float ysc = 1.f) {
    moe_tables(C, l);
    const unsigned* asg = WSP(unsigned, WS_ASG); bf16_t* xb = WSP(bf16_t, WS_XB);
    const int lane = C.lane; const bool last_layer = (l == NLAYER - 1) && ysc == 1.f;
    const int stride = C.G * NWAVE; int t = C.bid * NWAVE + C.wave;
    if (t >= T) return;
    u32x4 a_nx = *(const u32x4*)(asg + (size_t)t * 4);
    CmbIn nx = cmb_load(C, t, a_nx, lane), nx2 = nx;
    if (t + stride < T) { a_nx = *(const u32x4*)(asg + (size_t)(t + stride) * 4); nx2 = cmb_load(C, t + stride, a_nx, lane); }
    if (t + 2 * stride < T) a_nx = *(const u32x4*)(asg + (size_t)(t + 2 * stride) * 4);
    for (; t < T; t += stride) {
        const CmbIn in = nx; nx = nx2;
        if (t + 2 * stride < T) { nx2 = cmb_load(C, t + 2 * stride, a_nx, lane); if (t + 3 * stride < T) a_nx = *(const u32x4*)(asg + (size_t)(t + 3 * stride) * 4); }
        f32x4 v[4];
        v[0] = (f32x4){bflo(in.x0.x), bfhi(in.x0.x), bflo(in.x0.y), bfhi(in.x0.y)}; v[1] = (f32x4){bflo(in.x0.z), bfhi(in.x0.z), bflo(in.x0.w), bfhi(in.x0.w)};
        v[2] = (f32x4){bflo(in.x1.x), bfhi(in.x1.x), bflo(in.x1.y), bfhi(in.x1.y)}; v[3] = (f32x4){bflo(in.x1.z), bfhi(in.x1.z), bflo(in.x1.w), bfhi(in.x1.w)};
#pragma unroll
        for (int k = 0; k < 4; ++k) { const float sc = ysc * (1.f / g8::YB_SCALE) * in.g[k];
#pragma unroll
            for (int j = 0; j < 4; ++j) { const f32x2 lo = __builtin_amdgcn_cvt_pk_f32_fp8((int)in.y[k][j], false), hi = __builtin_amdgcn_cvt_pk_f32_fp8((int)in.y[k][j], true);
                v[j].x += sc * lo.x; v[j].y += sc * lo.y; v[j].z += sc * hi.x; v[j].w += sc * hi.y; } }
        if (last_layer) { f32x4* o = (f32x4*)(C.out + (size_t)t * DM + 16 * lane);
#pragma unroll
            for (int j = 0; j < 4; ++j) o[j] = v[j];
            continue; }
        float s = 0.f;
#pragma unroll
        for (int j = 0; j < 4; ++j) s += (v[j].x * v[j].x + v[j].y * v[j].y) + (v[j].z * v[j].z + v[j].w * v[j].w);
        u32x4* xr = (u32x4*)(xb + (size_t)t * DM + 16 * lane);
        xr[0] = (u32x4){pk2(v[0].x, v[0].y), pk2(v[0].z, v[0].w), pk2(v[1].x, v[1].y), pk2(v[1].z, v[1].w)};
        xr[1] = (u32x4){pk2(v[2].x, v[2].y), pk2(v[2].z, v[2].w), pk2(v[3].x, v[3].y), pk2(v[3].z, v[3].w)};
        const float rs = rsqrtf(wave_sum(s) * (1.f / DM) + EPS);
        if (lane == 0) WSP(float, WS_RS)[t] = rs;
    }
}

#ifndef FAST_INPROJ
#define FAST_INPROJ 1
#endif
#ifndef FAST_SMALL
#define FAST_SMALL 1
#endif
#ifndef FAST_OUTPROJ
#define FAST_OUTPROJ 1
#endif
#ifndef FAST_GATEUP
#define FAST_GATEUP 1
#endif
#ifndef FAST_DOWN
#define FAST_DOWN 1
#endif
#ifndef G8_SP2
#define G8_SP2 true
#endif
#ifndef G8_ALIGN
#define G8_ALIGN true
#endif
__device__ __forceinline__ void ph_inproj_f(const Ctx& C, int l) {
    const g8::DenseSched S{C.ws + WS_XB, C.ws + WS_WIN + (size_t)l * DINP * 1024 * 2, 1024, 1024, T / 256, DINP / 256, C.G, C.bid, 2};
    const g8::EpiBf16Rs E{WSP(bf16_t, WS_Z), DINP, WSP(float, WS_RS)};
    g8::gemm_phase<g8::EpiBf16Rs, g8::DenseSched, G8_ALIGN, G8_SP2>(C.lds, 1024, S, E);
}
__device__ __forceinline__ void ph_mixgemm_f(const Ctx& C, int l) {
    const g8::DenseSched S{C.ws + WS_A2, C.ws + WS_WMIX + (size_t)l * 512 * 512 * 2, 512, 512, T / 256, 2, C.G, C.bid, 2};
    const g8::EpiBf16 E{WSP(bf16_t, WS_YMIX), 512, WSP(float, WS_PAR) + P_MIXB + l * 512};
    g8::gemm_phase<g8::EpiBf16, g8::DenseSched, G8_ALIGN, G8_SP2>(C.lds, 512, S, E);
}
__device__ __forceinline__ void ph_qkvgemm_f(const Ctx& C, int l) {
    { const g8::DenseSched S{C.ws + WS_Z + 768 * 2, C.ws + WS_WQ + (size_t)l * 768 * 256 * 2, DINP, 256, T / 256, 3, C.G, C.bid, 2};
      const g8::EpiBf16 E{WSP(bf16_t, WS_QRAW), 768, nullptr};
      g8::gemm_phase<g8::EpiBf16, g8::DenseSched, G8_ALIGN, G8_SP2>(C.lds, 256, S, E); }
    { const g8::DenseSched S{C.ws + WS_Z + 1024 * 2, C.ws + WS_WKV + (size_t)l * 1024 * 256 * 2, DINP, 256, T / 256, 4, C.G, C.bid, 2};
      const g8::EpiBf16 E{WSP(bf16_t, WS_KVRAW), 1024, nullptr};
      g8::gemm_phase<g8::EpiBf16, g8::DenseSched, G8_ALIGN, G8_SP2>(C.lds, 256, S, E); }
}
__device__ __forceinline__ void ph_smallgemm_f(const Ctx& C, int l) { ph_mixgemm_f(C, l); ph_qkvgemm_f(C, l); }
__device__ __forceinline__ void ph_outproj_f(const Ctx& C, int l) {
#if OUTPROJ_FP8
    const g8::DenseSched S{C.ws + WS_MIX, C.ws + WS_WO + (size_t)l * 1024 * 1024, 1024, 1024, T / 256, 4, C.G, C.bid, 1};
    const g8::EpiResF32 E{(l == 0) ? C.x : C.out, C.out, 1024, 1.f / 32.f};
    g8::gemm_phase<g8::EpiResF32, g8::DenseSched, G8_ALIGN, G8_SP2, true>(C.lds, 1024, S, E);
#else
    const g8::DenseSched S{C.ws + WS_MIX, C.ws + WS_WO + (size_t)l * 1024 * 1024 * 2, 1024, 1024, T / 256, 4, C.G, C.bid, 2};
    const g8::EpiResBf16 E{nullptr, WSP(bf16_t, WS_XB), WSP(bf16_t, WS_XB)};
    g8::gemm_phase<g8::EpiResBf16, g8::DenseSched, G8_ALIGN, G8_SP2>(C.lds, 1024, S, E);
#endif
}
template <int PM = 0> __device__ __forceinline__ void ph_gateup_f(const Ctx& C, int l) {
    moe_tables(C, l);
    LAS const int* ctl = (LAS const int*)(C.lds + LDS_CTL);
    LAS unsigned short* tokt = (LAS unsigned short*)(C.lds + LDS_TOKT); LAS float* btab = (LAS float*)(C.lds + LDS_BIAST); constexpr int NTAB = 28, NBT = 17;
    g8::MoeSched<true, 1024> S{C.ws + WS_HB8, C.ws + WS_WGU + (size_t)l * NEXP * 2048 * 1024, WSP(int, WS_LTOK), ctl, 8, C.G, C.bid, tokt, 0, 0};
    const float* bgu_l = WSP(float, WS_PAR) + P_BGU + (size_t)l * NEXP * 2048;
    int nu = 0;
    for (int i = 0; i < NTAB; ++i) { int pm, pn, e, rb; if (!S.locate(i, pm, pn, e, rb)) break; nu = i + 1;
        if (C.tid < 256) { const int li = (pm - rb) * 256 + C.tid, nv = ctl[e]; tokt[i * 256 + C.tid] = (unsigned short)S.ltok[(size_t)e * T + (li < nv ? li : nv - 1)]; }
        else if (i < NBT) btab[i * 256 + (C.tid - 256)] = bgu_l[(size_t)e * 2048 + pn * 256 + (C.tid - 256)]; }
    S.ntab = nu;
    __syncthreads();
    const g8::EpiGlu8 E{C.ws + (PM ? 1600 * MiB : WS_ACT), bgu_l, btab, nu < NBT ? nu : NBT};
    if constexpr (PM == 3) { const g8::MoeSched<false, 1024> S2{C.ws + WS_HB8, C.ws + WS_WGU + (size_t)l * NEXP * 2048 * 1024, WSP(int, WS_LTOK), ctl, 8, C.G, C.bid, nullptr, 0, PROBE_FIX};
        g8::gemm_phase<g8::EpiGlu8, g8::MoeSched<false, 1024>, G8_ALIGN, G8_SP2, true, 1>(C.lds, 1024, S2, E); }
    else g8::gemm_phase<g8::EpiGlu8, g8::MoeSched<true, 1024>, G8_ALIGN, G8_SP2, true, PM>(C.lds, 1024, S, E);
}
template <int PM = 0> __device__ __forceinline__ void ph_down_f(const Ctx& C, int l) {
    moe_tables(C, l);
    LAS const int* ctl = (LAS const int*)(C.lds + LDS_CTL);
    LAS float* btab = (LAS float*)(C.lds + LDS_BIAST); constexpr int NBT = 17;
    const g8::MoeSched<false, 1024> S{C.ws + WS_ACT, C.ws + WS_WD + (size_t)l * NEXP * 1024 * 1024, WSP(int, WS_LTOK), ctl, 4, C.G, C.bid, nullptr, 0, PM ? PROBE_FIX : 0};
    const float* bdn_l = WSP(float, WS_PAR) + P_BDN + (size_t)l * NEXP * 1024;
    int nu = 0;
    for (int i = 0; i < NBT; ++i) { int pm, pn, e, rb; if (!S.locate(i, pm, pn, e, rb)) break; nu = i + 1;
        if (C.tid < 256) btab[i * 256 + C.tid] = bdn_l[(size_t)e * 1024 + pn * 256 + C.tid]; }
    __syncthreads();
    const g8::EpiDown8 E{C.ws + (PM ? 1600 * MiB : WS_YB), bdn_l, btab, nu};
    g8::gemm_phase<g8::EpiDown8, g8::MoeSched<false, 1024>, G8_ALIGN, G8_SP2, true, PM>(C.lds, 1024, S, E);
}

#define XB_TMO      128
#define XB_XCNT(j)  (256  + 64 * (j))
#define XB_XSUB(j)  (1280 + 64 * (j))
#define XB_XGEN(j)  (2304 + 64 * (j))
#define XB_TOP      3328
#define XB_TOPGEN   3392
#define XCD_BAR_WORDS 3456
#define XB_SPIN_CAP (1u << 24)

__device__ __forceinline__ unsigned xb_ld(unsigned* p)              { return __hip_atomic_load(p, __ATOMIC_RELAXED, __HIP_MEMORY_SCOPE_AGENT); }
__device__ __forceinline__ unsigned xb_add(unsigned* p, unsigned v) { return __hip_atomic_fetch_add(p, v, __ATOMIC_RELAXED, __HIP_MEMORY_SCOPE_AGENT); }
__device__ __forceinline__ unsigned xb_xcc_id() { return (unsigned)__builtin_amdgcn_s_getreg((3 << 11) | 20) & 0xFu; }
#define XB_SPIN(cond, bar) do { unsigned _sp = 0; while (cond) { __builtin_amdgcn_s_sleep(1); \
    if ((++_sp & 255u) == 0u) { if (xb_ld(&(bar)[XB_TMO])) break; if (_sp > XB_SPIN_CAP) { atomicAdd(&(bar)[XB_TMO], 1u); break; } } } } while (0)

struct XcdBarrier {
    unsigned* bar; unsigned x;
    volatile LAS unsigned* st;
};

__device__ __forceinline__ XcdBarrier xcd_barrier_post(unsigned* bar, volatile LAS unsigned* st) {
    XcdBarrier b; b.bar = bar; b.x = xb_xcc_id(); b.st = st;
    if (threadIdx.x == 0) (void)xb_add(&bar[XB_XCNT(b.x)], 1u);
    return b;
}
__device__ __forceinline__ void xcd_barrier_complete(unsigned* bar, unsigned x, unsigned& nloc, unsigned& nx) {
    const unsigned G = gridDim.x * gridDim.y * gridDim.z;
    unsigned sum, cnt, mine, sp = 0u;
    for (;;) {
        sum = 0u; cnt = 0u; mine = 0u;
#pragma unroll
        for (unsigned j = 0; j < 16; ++j) { const unsigned c = xb_ld(&bar[XB_XCNT(j)]); sum += c; cnt += (c > 0u) ? 1u : 0u; mine = (j == x) ? c : mine; }
        if (sum == G) break;
        __builtin_amdgcn_s_sleep(1);
        if ((++sp & 255u) == 0u) { if (xb_ld(&bar[XB_TMO])) break; if (sp > XB_SPIN_CAP) { atomicAdd(&bar[XB_TMO], 1u); break; } }
    }
    nloc = mine > 0u ? mine : 1u; nx = cnt > 0u ? cnt : 1u;
}

__device__ __forceinline__ void xcd_barrier(const XcdBarrier& b) {
    asm volatile("s_waitcnt vmcnt(0)" ::: "memory");
    __syncthreads();
    if (threadIdx.x == 0) {
        unsigned* bar = b.bar;
        __builtin_amdgcn_s_waitcnt(0);
        unsigned nloc = b.st[0], nx = b.st[1];
        if (nloc == 0u) { xcd_barrier_complete(bar, b.x, nloc, nx); b.st[0] = nloc; b.st[1] = nx; }
        const unsigned old = xb_add(&bar[XB_XSUB(b.x)], 1u);
        const unsigned gen = old / nloc;
        if (old + 1u == (gen + 1u) * nloc) {
            __builtin_amdgcn_fence(__ATOMIC_RELEASE, "agent");
            asm volatile("s_waitcnt vmcnt(0)" ::: "memory");
            const unsigned og = xb_add(&bar[XB_TOP], 1u);
            const unsigned tg = og / nx;
            if (og + 1u == (tg + 1u) * nx) xb_add(&bar[XB_TOPGEN], 1u);
            else XB_SPIN(xb_ld(&bar[XB_TOPGEN]) == tg, bar);
            __builtin_amdgcn_fence(__ATOMIC_ACQUIRE, "agent");
            xb_add(&bar[XB_XGEN(b.x)], 1u);
            asm volatile("s_waitcnt vmcnt(0)" ::: "memory");
        } else {
            XB_SPIN(xb_ld(&bar[XB_XGEN(b.x)]) == gen, bar);
            __builtin_amdgcn_fence(__ATOMIC_ACQUIRE, "agent");
            asm volatile("s_waitcnt vmcnt(0)" ::: "memory");
        }
    }
    __syncthreads();
}

constexpr int NPH = 11;
struct Args { const float* in[N_IN]; float* out; unsigned char* ws; int ph_lo, ph_hi; };
__global__ void __launch_bounds__(NTHR, 2) fwd(Args args) {
    extern __shared__ __attribute__((aligned(16))) unsigned char lds_raw[];
    Ctx C;
    C.x = args.in[I_X]; C.out = args.out; C.ws = args.ws; C.lds = (LAS unsigned char*)lds_raw;
    C.tid = threadIdx.x; C.lane = C.tid & 63; C.wave = __builtin_amdgcn_readfirstlane(C.tid >> 6); C.G = gridDim.x; C.bid = blockIdx.x;
    const int lo = args.ph_lo, hi = args.ph_hi;
    if (C.tid < 4) ((LAS unsigned*)(C.lds + LDS_CTL))[160 + C.tid] = 0u;
    __syncthreads();
    XcdBarrier bar = xcd_barrier_post(WSP(unsigned, WS_CTL) + CW_BAR, (volatile LAS unsigned*)(C.lds + LDS_CTL) + 160);
#define IN(k) (lo <= (k) && (k) < hi)
#ifndef PROBE_DUP
#define PROBE_DUP 0
#endif
#ifndef PROBE_PM
#define PROBE_PM 0
#endif
#ifndef PROBE_BAR2
#define PROBE_BAR2 0
#endif
#define DUPN(bit) (((PROBE_DUP) >> (bit)) & 1 ? 2 : 1)
#define SEAM(k) do { if (IN(k) && IN((k) + 1)) { XcdBarrier b2_ = bar; unsigned long long p_ = (unsigned long long)b2_.bar; asm volatile("" : "+s"(p_)); b2_.bar = (unsigned*)p_; xcd_barrier(b2_); if (PROBE_BAR2) xcd_barrier(b2_); } } while (0)
    if (IN(0)) for (int r_ = 0; r_ < DUPN(0); ++r_) { const Ctx L = phase_enter(C); ph_prologue(L, args.in); }
    SEAM(0);
    for (int l = 0; l < NLAYER; ++l) {
        const int p0 = 1 + l * NPH;
        if (IN(p0 + 0)) for (int r_ = 0; r_ < (DUPN(1)); ++r_) { const Ctx L = phase_enter(C);
#if FAST_INPROJ
            ph_inproj_f(L, l);
#else
            ph_inproj(L, l);
#endif
        }
        SEAM(p0 + 0);
        if (IN(p0 + 1)) { for (int r_ = 0; r_ < (DUPN(2)); ++r_) { const Ctx L = phase_enter(C); if (r_ == 0 && DUPN(2) == 2 && PROBE_PM) ph_mix1<PROBE_PM>(L, l); else ph_mix1<0>(L, l); }
            for (int r_ = 0; r_ < (DUPN(3)); ++r_) { const Ctx L = phase_enter(C); ph_qkvgemm_f(L, l); } }
        SEAM(p0 + 1);
        if (IN(p0 + 2)) { for (int r_ = 0; r_ < (DUPN(3)); ++r_) { const Ctx L = phase_enter(C); ph_mixgemm_f(L, l); }
            for (int r_ = 0; r_ < (DUPN(4)); ++r_) { const Ctx L = phase_enter(C); if (r_ == 0 && DUPN(4) == 2 && PROBE_PM) ph_qkfin<PROBE_PM>(L, l); else ph_qkfin<0>(L, l); }
#if ATT_PV8
            { const Ctx L = phase_enter(C); ph_vtbuild(L, l); }
#endif
        }
        if (IN(p0 + 2) && !IN(p0 + 3)) {   }
        SEAM(p0 + 3);
                if (IN(p0 + 4)) for (int r_ = 0; r_ < (DUPN(5)); ++r_) { const Ctx L = phase_enter(C); ph_attn(L, l); }
        SEAM(p0 + 4);
        if (IN(p0 + 5)) for (int r_ = 0; r_ < (DUPN(6)); ++r_) { const Ctx L = phase_enter(C); ph_mixnorm(L, l); }
        SEAM(p0 + 5);
        if (IN(p0 + 6)) for (int r_ = 0; r_ < (l == 0 ? DUPN(7) : 1); ++r_) { const Ctx L = phase_enter(C);
#if FAST_OUTPROJ
            ph_outproj_f(L, l);
#else
            ph_outproj(L, l);
#endif
        }
        SEAM(p0 + 6);
        if (IN(p0 + 7)) { if (DUPN(10) == 2) { const Ctx L = phase_enter(C); ph_route(L, l, 1); } const Ctx L = phase_enter(C); ph_route(L, l); }
        SEAM(p0 + 7);
        if (IN(p0 + 8)) for (int r_ = 0; r_ < (DUPN(8)); ++r_) { const Ctx L = phase_enter(C);
#if FAST_GATEUP
            if (r_ == 0 && DUPN(8) == 2 && PROBE_PM) ph_gateup_f<PROBE_PM>(L, l); else ph_gateup_f<0>(L, l);
#else
            ph_gateup(L, l);
#endif
        }
        SEAM(p0 + 8);
        if (IN(p0 + 9)) for (int r_ = 0; r_ < (DUPN(9)); ++r_) { const Ctx L = phase_enter(C);
#if FAST_DOWN
            if (r_ == 0 && DUPN(9) == 2 && PROBE_PM) ph_down_f<PROBE_PM>(L, l); else ph_down_f<0>(L, l);
#else
            ph_down(L, l);
#endif
        }
        SEAM(p0 + 9);
        if (IN(p0 + 10)) { if (DUPN(11) == 2) { { const Ctx L = phase_enter(C); ph_combine(L, l, 0.5f); } xcd_barrier(bar); { const Ctx L = phase_enter(C); ph_combine(L, l, 0.5f); } } else { const Ctx L = phase_enter(C); ph_combine(L, l); } }
        SEAM(p0 + 10);
    }
#undef SEAM
#undef IN
}

extern "C" void kernel_launch(void* const* d_in, const int* in_sizes, int n_in, void* d_out, int out_size, void* d_ws, size_t ws_size, hipStream_t stream) {
    static int grid = 0;
    if (grid == 0) {
        if (n_in != N_IN || in_sizes[0] != T * DM || out_size != T * DM || ws_size < WS_END) {
            fprintf(stderr, "kernel_launch: shape mismatch (n_in %d, in0 %d, out %d, ws %zu need %zu)\n", n_in, n_in > 0 ? in_sizes[0] : -1, out_size, ws_size, (size_t)WS_END); grid = -1; return; }
        int dev = 0, cus = 0;
        if (hipGetDevice(&dev) != hipSuccess || hipDeviceGetAttribute(&cus, hipDeviceAttributeMultiprocessorCount, dev) != hipSuccess) { grid = -1; return; }
        if (hipFuncSetAttribute((const void*)fwd, hipFuncAttributeMaxDynamicSharedMemorySize, LDS_BYTES) != hipSuccess) { fprintf(stderr, "kernel_launch: hipFuncSetAttribute failed\n"); grid = -1; return; }
        if (cus < 160) { fprintf(stderr, "kernel_launch: built for a >= 160-CU device (per-workgroup unit tables); %d CUs\n", cus); grid = -1; return; }
        grid = cus;
    }
    if (grid < 0) return;
    (void)hipMemsetAsync((char*)d_ws + WS_CTL, 0, CTL_ZERO_BYTES, stream);
    Args a{};
    for (int i = 0; i < N_IN; ++i) a.in[i] = (const float*)d_in[i];
    a.out = (float*)d_out; a.ws = (unsigned char*)d_ws;
    const int nphase = 1 + NLAYER * NPH;
#if defined(MK_PER_PHASE)
    for (int p = 0; p < nphase; ++p) { a.ph_lo = p; a.ph_hi = p + 1; hipLaunchKernelGGL(fwd, dim3(grid), dim3(NTHR), LDS_BYTES, stream, a); }
#else
    a.ph_lo = 0; a.ph_hi = nphase;
    hipLaunchKernelGGL(fwd, dim3(grid), dim3(NTHR), LDS_BYTES, stream, a);
#endif
}
```

```cpp
#include <hip/hip_runtime.h>
#include <cstdio>
#include <cstdint>

#ifndef OUTPROJ_FP8
#define OUTPROJ_FP8 0
#endif
#ifndef PROBE_FIX
#define PROBE_FIX 0
#endif
#ifndef MOE_FP8
#define MOE_FP8 1
#define PV_PIPE 1
#define DENSE_I8 1
#define ATT_CREF 1
#define YATT_BF16 1
#define ATT_PV8 1
#define ATT_QK8 1
#endif
#define LAS __attribute__((address_space(3)))
typedef unsigned short bf16_t;
typedef short bf16x8 __attribute__((ext_vector_type(8)));
typedef float f32x4 __attribute__((ext_vector_type(4)));
typedef float f32x2 __attribute__((ext_vector_type(2)));
typedef unsigned u32x4 __attribute__((ext_vector_type(4)));
typedef unsigned u32x2 __attribute__((ext_vector_type(2)));

constexpr int T = 32768, DM = 1024, SEQ = 4096, NBATCH = 8, NLAYER = 2;
constexpr int DIN = 1216, DINP = 1280;
constexpr int NEXP = 32, TOPK = 4, DFF = 1024;
constexpr int MOE_ROWS = T * TOPK + NEXP * 256;
constexpr float EPS = 1e-6f;
constexpr int NTHR = 512, NWAVE = 8;

enum { I_X = 0, I_POS, I_ANG, I_WIN, I_POOLW, I_POOLS, I_CDW, I_CDWB, I_CLNG, I_CLNB, I_CPW, I_CPWB, I_QAG, I_WUQ, I_KVAG, I_WUKV,
       I_QNG, I_KNG, I_POG, I_COG, I_AOG, I_WO, I_FNG, I_WR, I_BR, I_WGU, I_BGU, I_WDN, I_BDN, N_IN };

constexpr size_t MiB = 1u << 20;
constexpr size_t WS_CTL = 0, CTL_ZERO_BYTES = 1 * MiB;
constexpr size_t WS_COS = 1 * MiB;
constexpr size_t WS_WIN = 9 * MiB;
constexpr size_t WS_WMIX = 14 * MiB;
constexpr size_t WS_WQ = 15 * MiB;
constexpr size_t WS_WKV = 16 * MiB;
constexpr size_t WS_WO = 17 * MiB;
constexpr size_t WS_WR = 21 * MiB;
constexpr size_t WS_WGU = 22 * MiB;
constexpr size_t WS_WD = 278 * MiB;
constexpr size_t WS_HB = 406 * MiB;
constexpr size_t WS_XQ = 407 * MiB;
constexpr size_t WS_MS = 440 * MiB;
constexpr size_t WS_RS = 406 * MiB;
constexpr size_t WS_Z = 470 * MiB;
constexpr size_t WS_A2 = 550 * MiB;
constexpr size_t WS_YMIX = 582 * MiB;
constexpr size_t WS_QRAW = 614 * MiB;
constexpr size_t WS_KVRAW = 662 * MiB;
constexpr size_t WS_Q = 726 * MiB;
constexpr size_t WS_KIMG = 774 * MiB;
constexpr size_t WS_VIMG = 822 * MiB;
constexpr size_t WS_YATT = 854 * MiB;
constexpr size_t WS_MIX = 918 * MiB;
constexpr size_t WS_LTOK = 982 * MiB;
constexpr size_t WS_LGATE = 986 * MiB;
constexpr size_t WS_ASG = 990 * MiB;
constexpr size_t WS_PAR = 991 * MiB;
constexpr int P_CDW = 0, P_CDWB = 15872, P_CLNG = 16384, P_CLNB = 16896, P_CPWB = 17408, P_QNG = 17920, P_KNG = 18304, P_BR = 18688, P_MIXB = 19456, P_BGU = 20480, P_BDN = 151552, P_END = 217088;
static_assert((size_t)P_END * 4 <= 1 * MiB, "param area");
constexpr size_t WS_ACT = 992 * MiB;
constexpr size_t WS_YB = 1264 * MiB;
constexpr size_t WS_HB8 = 1536 * MiB;
constexpr size_t WS_XB = 1568 * MiB;
constexpr size_t WS_END = 1632 * MiB;
static_assert((size_t)MOE_ROWS * 1024 * 2 <= 272 * MiB, "act buffer");

constexpr int CW_BAR = 4096;
constexpr int CW_WQ = 66560;
constexpr int CW_GCNT = 16384;

constexpr int LDS_BYTES = 163840;
constexpr int LDS_CTL = 162816;
constexpr int LDS_TOKT = 131072, LDS_BIAST = 131072 + 28 * 512;

__device__ __forceinline__ unsigned f2bf(float f) { unsigned u = __builtin_bit_cast(unsigned, f); return (u + 0x7fffu + ((u >> 16) & 1u)) >> 16; }
typedef __bf16 bf16x2_hw __attribute__((ext_vector_type(2)));
__device__ __forceinline__ unsigned pk2(float lo, float hi) { typedef float f2_ __attribute__((ext_vector_type(2))); const f2_ v = {lo, hi}; return __builtin_bit_cast(unsigned, __builtin_convertvector(v, bf16x2_hw)); }
__device__ __forceinline__ float bf2f(unsigned b) { return __builtin_bit_cast(float, b << 16); }
__device__ __forceinline__ float bflo(unsigned w) { return __builtin_bit_cast(float, w << 16); }
__device__ __forceinline__ float bfhi(unsigned w) { return __builtin_bit_cast(float, w & 0xffff0000u); }
#define DPPF(v, ctrl) __int_as_float(__builtin_amdgcn_update_dpp(0, __float_as_int(v), ctrl, 0xf, 0xf, true))
__device__ __forceinline__ float grp16_sum(float v) { v += DPPF(v, 0xB1); v += DPPF(v, 0x4E); v += DPPF(v, 0x141); v += DPPF(v, 0x140); return v; }
__device__ __forceinline__ float wave_sum(float v) {
    v = grp16_sum(v);
    { auto r = __builtin_amdgcn_permlane16_swap(__float_as_uint(v), __float_as_uint(v), false, false); const unsigned r0 = r[0], r1 = r[1]; v = __uint_as_float(r0) + __uint_as_float(r1); }
    { auto r = __builtin_amdgcn_permlane32_swap(__float_as_uint(v), __float_as_uint(v), false, false); const unsigned r0 = r[0], r1 = r[1]; v = __uint_as_float(r0) + __uint_as_float(r1); }
    return v;
}
__device__ __forceinline__ unsigned pk4_fp8(float a, float b, float c, float d) { unsigned w = 0; w = __builtin_amdgcn_cvt_pk_fp8_f32(a, b, w, false); w = __builtin_amdgcn_cvt_pk_fp8_f32(c, d, w, true); return w; }
__device__ __forceinline__ float sigmoidf_(float x) { return __builtin_amdgcn_rcpf(1.0f + __expf(-x)); }
__device__ __forceinline__ float wave_max(float v) {
    v = fmaxf(v, DPPF(v, 0xB1)); v = fmaxf(v, DPPF(v, 0x4E)); v = fmaxf(v, DPPF(v, 0x141)); v = fmaxf(v, DPPF(v, 0x140));
    { auto r = __builtin_amdgcn_permlane16_swap(__float_as_uint(v), __float_as_uint(v), false, false); const unsigned r0 = r[0], r1 = r[1]; v = fmaxf(__uint_as_float(r0), __uint_as_float(r1)); }
    { auto r = __builtin_amdgcn_permlane32_swap(__float_as_uint(v), __float_as_uint(v), false, false); const unsigned r0 = r[0], r1 = r[1]; v = fmaxf(__uint_as_float(r0), __uint_as_float(r1)); }
    return v;
}
__device__ __forceinline__ unsigned pk4_i8(float a, float b, float c, float d) {
    const int ia = (int)__builtin_rintf(a), ib = (int)__builtin_rintf(b), ic = (int)__builtin_rintf(c), id = (int)__builtin_rintf(d);
    return (unsigned)(ia & 255) | ((unsigned)(ib & 255) << 8) | ((unsigned)(ic & 255) << 16) | ((unsigned)id << 24); }

struct Ctx {
    const float* x; float* out; unsigned char* ws; LAS unsigned char* lds;
    int tid, lane, wave, G, bid;
};
#define WSP(T_, off) ((T_*)(C.ws + (off)))
__device__ __forceinline__ Ctx phase_enter(const Ctx& C0) {
    Ctx C = C0; int t = threadIdx.x; asm volatile("" : "+v"(t)); C.tid = t; C.lane = t & 63; C.wave = __builtin_amdgcn_readfirstlane(t >> 6);
    unsigned long long w = (unsigned long long)C0.ws, o = (unsigned long long)C0.out, x = (unsigned long long)C0.x;
    asm volatile("" : "+s"(w), "+s"(o), "+s"(x));
    C.ws = (unsigned char*)(__attribute__((address_space(1))) unsigned char*)w; C.out = (float*)(__attribute__((address_space(1))) float*)o; C.x = (const float*)(const __attribute__((address_space(1))) float*)x; return C; }

__device__ __forceinline__ int kimg_off(int r, int c) { return (c >> 1) * 2048 + (c & 1) * 1024 + (r >> 5) * 512 + (r & 31) * 16; }
__device__ __forceinline__ int v_st(int k, int c) { const int kk = (k & ~0xC) | ((k & 4) << 1) | ((k & 8) >> 1); return ((kk >> 3) * 4 + (c >> 5)) * 512 + ((kk & 7) * 32 + (c & 31)) * 2; }

template <class RowMap>
__device__ __forceinline__ void tconv_item(const float* W, int N, int k0, int n0, const float* kscale, bf16_t* WT, int ldk, RowMap rm, LAS float* scr, int lane) {
#pragma unroll 8
    for (int i = 0; i < 32; ++i) { const int kk = 2 * i + (lane >> 5); float v = W[(size_t)(k0 + kk) * N + n0 + (lane & 31)]; if (kscale) v *= kscale[k0 + kk]; scr[kk * 33 + (lane & 31)] = v; }
    asm volatile("s_waitcnt lgkmcnt(0)" ::: "memory");
    const int c = lane & 7;
#pragma unroll
    for (int j = 0; j < 4; ++j) { const int n = (lane >> 3) + 8 * j; const LAS float* s = scr + (8 * c) * 33 + n;
        u32x4 o; o.x = pk2(s[0 * 33], s[1 * 33]); o.y = pk2(s[2 * 33], s[3 * 33]); o.z = pk2(s[4 * 33], s[5 * 33]); o.w = pk2(s[6 * 33], s[7 * 33]);
        *(u32x4*)(WT + (size_t)rm(n0 + n) * ldk + k0 + 8 * c) = o; }
    asm volatile("s_waitcnt lgkmcnt(0)" ::: "memory");
}
__device__ __forceinline__ float tmax_item(const float* W, int N, int k0, int n0, const float* kscale, int lane) {
    float tv_[32], m = 0.f;
#pragma unroll
    for (int i = 0; i < 32; ++i) { const int kk = 2 * i + (lane >> 5); tv_[i] = W[(size_t)(k0 + kk) * N + n0 + (lane & 31)]; }
#pragma unroll
    for (int i = 0; i < 32; ++i) { const int kk = 2 * i + (lane >> 5); m = fmaxf(m, fabsf(tv_[i] * kscale[k0 + kk])); }
    return m;
}
__device__ __forceinline__ void tconv_i8_item(const float* W, int N, int k0, int n0, const float* kscale, float qmul, unsigned char* WT, int ldk, LAS float* scr, int lane) {
    float tv_[32];
#pragma unroll
    for (int i = 0; i < 32; ++i) { const int kk = 2 * i + (lane >> 5); tv_[i] = W[(size_t)(k0 + kk) * N + n0 + (lane & 31)]; }
#pragma unroll
    for (int i = 0; i < 32; ++i) { const int kk = 2 * i + (lane >> 5); scr[kk * 33 + (lane & 31)] = tv_[i] * kscale[k0 + kk] * qmul; }
    asm volatile("s_waitcnt lgkmcnt(0)" ::: "memory");
    const int c = lane & 3;
#pragma unroll
    for (int j = 0; j < 2; ++j) { const int n = (lane >> 2) + 16 * j; const LAS float* sp = scr + (16 * c) * 33 + n;
        u32x4 o; o.x = pk4_i8(sp[0 * 33], sp[1 * 33], sp[2 * 33], sp[3 * 33]); o.y = pk4_i8(sp[4 * 33], sp[5 * 33], sp[6 * 33], sp[7 * 33]);
        o.z = pk4_i8(sp[8 * 33], sp[9 * 33], sp[10 * 33], sp[11 * 33]); o.w = pk4_i8(sp[12 * 33], sp[13 * 33], sp[14 * 33], sp[15 * 33]);
        *(u32x4*)(WT + (size_t)(n0 + n) * ldk + k0 + 16 * c) = o; }
    asm volatile("s_waitcnt lgkmcnt(0)" ::: "memory");
}
template <class RowMap>
__device__ __forceinline__ void tconv128_item(const float* W, int N, int k0, int n0, const float* kscale, bf16_t* WT, int ldk, RowMap rm, LAS unsigned* scr, int lane) {
    const float* src = W + (size_t)k0 * N + n0 + 2 * lane;
#pragma unroll 8
    for (int kp = 0; kp < 32; ++kp) {
        const f32x2 r0 = *(const f32x2*)(src + (size_t)(2 * kp) * N), r1 = *(const f32x2*)(src + (size_t)(2 * kp + 1) * N);
        const float s0 = kscale ? kscale[k0 + 2 * kp] : 1.f, s1 = kscale ? kscale[k0 + 2 * kp + 1] : 1.f;
        scr[(2 * lane) * 33 + kp] = pk2(r0.x * s0, r1.x * s1); scr[(2 * lane + 1) * 33 + kp] = pk2(r0.y * s0, r1.y * s1); }
    asm volatile("s_waitcnt lgkmcnt(0)" ::: "memory");
    const int c = lane & 7;
#pragma unroll 4
    for (int j = 0; j < 16; ++j) { const int n = (lane >> 3) + 8 * j; const LAS unsigned* p = scr + n * 33 + 4 * c;
        *(u32x4*)(WT + (size_t)rm(n0 + n) * ldk + k0 + 8 * c) = (u32x4){p[0], p[1], p[2], p[3]}; }
    asm volatile("s_waitcnt lgkmcnt(0)" ::: "memory");
}
template <class RowMap>
__device__ __forceinline__ void tconv128_f8_item(const float* W, int N, int k0, int n0, const float* kscale, float wscale, unsigned char* WT, int ldk, RowMap rm, LAS unsigned* scr, int lane) {
    const float* src = W + (size_t)k0 * N + n0 + 2 * lane;
#pragma unroll 8
    for (int kq = 0; kq < 32; ++kq) {
        const f32x2 r0 = *(const f32x2*)(src + (size_t)(4 * kq) * N), r1 = *(const f32x2*)(src + (size_t)(4 * kq + 1) * N), r2 = *(const f32x2*)(src + (size_t)(4 * kq + 2) * N), r3 = *(const f32x2*)(src + (size_t)(4 * kq + 3) * N);
        float s0 = wscale, s1 = wscale, s2 = wscale, s3 = wscale;
        if (kscale) { s0 *= kscale[k0 + 4 * kq]; s1 *= kscale[k0 + 4 * kq + 1]; s2 *= kscale[k0 + 4 * kq + 2]; s3 *= kscale[k0 + 4 * kq + 3]; }
        scr[(2 * lane) * 33 + kq] = pk4_fp8(r0.x * s0, r1.x * s1, r2.x * s2, r3.x * s3); scr[(2 * lane + 1) * 33 + kq] = pk4_fp8(r0.y * s0, r1.y * s1, r2.y * s2, r3.y * s3); }
    asm volatile("s_waitcnt lgkmcnt(0)" ::: "memory");
    const int c = lane & 7;
#pragma unroll 4
    for (int j = 0; j < 16; ++j) { const int n = (lane >> 3) + 8 * j; const LAS unsigned* p = scr + n * 33 + 4 * c;
        *(u32x4*)(WT + (size_t)rm(n0 + n) * ldk + k0 + 16 * c) = (u32x4){p[0], p[1], p[2], p[3]}; }
    asm volatile("s_waitcnt lgkmcnt(0)" ::: "memory");
}
struct RmId { __device__ __forceinline__ int operator()(int n) const { return n; } };
struct RmGu { __device__ __forceinline__ int operator()(int n) const { const int j = n >> 1, half = n & 1; return ((j >> 7) << 8) + (half << 7) + (j & 127); } };

struct Args;
__device__ __forceinline__ void ph_prologue(const Ctx& C, const float* const* in_) {
#define PIN(i) (in_[i])
    LAS float* scr = (LAS float*)(C.lds + C.wave * 16384);
    const int gw = C.bid * NWAVE + C.wave, NGW = C.G * NWAVE;
    constexpr int I_IN = 16 * 38, I_O = 16 * 32;
    constexpr int N_IN_ = NLAYER * I_IN, N_O_ = NLAYER * I_O;
#if DENSE_I8
    { unsigned* wq = WSP(unsigned, WS_CTL) + CW_WQ;
      for (int it = gw; it < N_IN_ + N_O_; it += NGW) {
        int r = it; float m; int base;
        if (r < N_IN_) { const int l = r / I_IN, q = r % I_IN, kb = q / 38, nb = q % 38; base = (2 * l) * 1280 + nb * 32;
            m = tmax_item(PIN(I_WIN) + (size_t)l * 1024 * DIN, DIN, kb * 64, nb * 32, PIN(I_ANG) + l * 1024, C.lane); }
        else { r -= N_IN_; const int l = r / I_O, q = r % I_O, kb = q / 32, nb = q % 32, k0 = kb * 64; base = (2 * l + 1) * 1280 + nb * 32;
            const float* ks = (k0 < 256) ? (PIN(I_POG) + l * 256) : (k0 < 512) ? (PIN(I_COG) + l * 256 - 256) : (PIN(I_AOG) + l * 512 - 512);
            m = tmax_item(PIN(I_WO) + (size_t)l * 1024 * 1024, 1024, k0, nb * 32, ks, C.lane); }
        m = fmaxf(m, __shfl_xor(m, 32));
        if (C.lane < 32 && m > 0.f) __hip_atomic_fetch_max(wq + 32 + base + C.lane, __float_as_uint(m), __ATOMIC_RELAXED, __HIP_MEMORY_SCOPE_AGENT); }
      asm volatile("s_waitcnt vmcnt(0)" ::: "memory");
      if (C.lane == 0) __hip_atomic_fetch_add(wq + 16, 1u, __ATOMIC_RELAXED, __HIP_MEMORY_SCOPE_AGENT); }
#else
    for (int it = gw; it < N_IN_ + N_O_; it += NGW) {
        int r = it;
        if (r < N_IN_) { const int l = r / I_IN, q = r % I_IN, kb = q / 38, nb = q % 38;
            tconv_item(PIN(I_WIN) + (size_t)l * 1024 * DIN, DIN, kb * 64, nb * 32, PIN(I_ANG) + l * 1024, WSP(bf16_t, WS_WIN) + (size_t)l * DINP * 1024, 1024, RmId(), scr, C.lane); continue; }
        r -= N_IN_;
#if !OUTPROJ_FP8
        { const int l = r / I_O, q = r % I_O, kb = q / 32, nb = q % 32, k0 = kb * 64;
            const float* ks = (k0 < 256) ? (PIN(I_POG) + l * 256) : (k0 < 512) ? (PIN(I_COG) + l * 256 - 256) : (PIN(I_AOG) + l * 512 - 512);
            tconv_item(PIN(I_WO) + (size_t)l * 1024 * 1024, 1024, k0, nb * 32, ks, WSP(bf16_t, WS_WO) + (size_t)l * 1024 * 1024, 1024, RmId(), scr, C.lane); }
#endif
    }
#endif
    __syncthreads();
    { LAS unsigned* scr2 = (LAS unsigned*)(C.lds + C.wave * 16896);
#if OUTPROJ_FP8
      for (int it = gw; it < NLAYER * 64; it += NGW) { const int l = it >> 6, q = it & 63, kb = q >> 3, nb = q & 7, k0 = kb * 128;
          const float* ks = (k0 < 256) ? (PIN(I_POG) + l * 256) : (k0 < 512) ? (PIN(I_COG) + l * 256 - 256) : (PIN(I_AOG) + l * 512 - 512);
          tconv128_f8_item(PIN(I_WO) + (size_t)l * 1024 * 1024, 1024, k0, nb * 128, ks, 32.f, C.ws + WS_WO + (size_t)l * 1024 * 1024, 1024, RmId(), scr2, C.lane); }
#endif
#if MOE_FP8
      constexpr int I_GU = 8 * 16, I_DN = 8 * 8;
      constexpr int N_GU_ = NLAYER * NEXP * I_GU, N_DN_ = NLAYER * NEXP * I_DN;
      for (int it = gw; it < N_GU_ + N_DN_; it += NGW) {
        if (it < N_GU_) { const int le = it / I_GU, q = it % I_GU, kb = q / 16, nb = q % 16, l = le / NEXP;
            tconv128_f8_item(PIN(I_WGU) + (size_t)le * 1024 * 2048, 2048, kb * 128, nb * 128, PIN(I_FNG) + l * 1024, 32.f, C.ws + WS_WGU + (size_t)le * 2048 * 1024, 1024, RmGu(), scr2, C.lane);
        } else { const int r = it - N_GU_, le = r / I_DN, q = r % I_DN, kb = q / 8, nb = q % 8;
            tconv128_f8_item(PIN(I_WDN) + (size_t)le * 1024 * 1024, 1024, kb * 128, nb * 128, nullptr, 32.f, C.ws + WS_WD + (size_t)le * 1024 * 1024, 1024, RmId(), scr2, C.lane); }
      } }
#else
      constexpr int I_GU = 16 * 16, I_DN = 16 * 8;
      constexpr int N_GU_ = NLAYER * NEXP * I_GU, N_DN_ = NLAYER * NEXP * I_DN;
      for (int it = gw; it < N_GU_ + N_DN_; it += NGW) {
        if (it < N_GU_) { const int le = it / I_GU, q = it % I_GU, kb = q / 16, nb = q % 16, l = le / NEXP;
            tconv128_item(PIN(I_WGU) + (size_t)le * 1024 * 2048, 2048, kb * 64, nb * 128, PIN(I_FNG) + l * 1024, WSP(bf16_t, WS_WGU) + (size_t)le * 2048 * 1024, 1024, RmGu(), scr2, C.lane);
        } else { const int r = it - N_GU_, le = r / I_DN, q = r % I_DN, kb = q / 8, nb = q % 8;
            tconv128_item(PIN(I_WDN) + (size_t)le * 1024 * 1024, 1024, kb * 64, nb * 128, nullptr, WSP(bf16_t, WS_WD) + (size_t)le * 1024 * 1024, 1024, RmId(), scr2, C.lane); }
      } }
#endif
    const int gt = C.bid * NTHR + C.tid, NGT = C.G * NTHR;
    for (int i = gt; i < NLAYER * 512 * 512; i += NGT) {
        const int l = i / (512 * 512), n = (i / 512) % 512, k = i % 512; float v = 0.f;
        if (n < 256) { const int g = n >> 6, d = n & 63; if (k < 256 && (k >> 6) == g) v = PIN(I_POOLW)[((size_t)(l * 4 + g) * 64 + (k & 63)) * 64 + d] * PIN(I_POOLS)[l * 256 + n]; }
        else { if (k >= 256) v = PIN(I_CPW)[((size_t)l * 256 + (k - 256)) * 256 + (n - 256)]; }
        WSP(bf16_t, WS_WMIX)[i] = (bf16_t)f2bf(v);
    }
    for (int i = gt; i < NLAYER * 768 * 256; i += NGT) {
        const int l = i / (768 * 256), n = (i / 256) % 768, k = i % 256;
        WSP(bf16_t, WS_WQ)[i] = (bf16_t)f2bf(PIN(I_WUQ)[((size_t)l * 256 + k) * 768 + n] * PIN(I_QAG)[l * 256 + k]);
    }
    for (int i = gt; i < NLAYER * 1024 * 128; i += NGT) {
        const int l = i / (1024 * 128), n = (i / 128) % 1024, k = i % 128;
        WSP(bf16_t, WS_WKV)[i] = (bf16_t)f2bf(PIN(I_WUKV)[((size_t)l * 128 + k) * 1024 + n] * PIN(I_KVAG)[l * 128 + k]);
    }
    for (int i = gt; i < NLAYER * 32 * 1024; i += NGT) {
        const int l = i / (32 * 1024), e = (i / 1024) % 32, k = i % 1024;
        const float wv = PIN(I_WR)[((size_t)l * 1024 + k) * 32 + e] * PIN(I_FNG)[l * 1024 + k];
        const unsigned hi = f2bf(wv); const float rem = wv - bf2f(hi);
        WSP(bf16_t, WS_WR)[((size_t)(l * 2 + 0) * 32 + e) * 1024 + k] = (bf16_t)hi; WSP(bf16_t, WS_WR)[((size_t)(l * 2 + 1) * 32 + e) * 1024 + k] = (bf16_t)f2bf(rem);
    }
    for (int i = gt; i < NLAYER * 64 * 1024; i += NGT) {
        const int l = i / (64 * 1024), r = (i / 1024) % 64, k = i % 1024;
#if DENSE_I8
        (C.ws + WS_WIN)[((size_t)l * DINP + DIN + r) * 1024 + k] = 0;
#else
        WSP(bf16_t, WS_WIN)[((size_t)l * DINP + DIN + r) * 1024 + k] = 0;
#endif
    }
    { float* P = WSP(float, WS_PAR);
      for (int i = gt; i < 2 * 31 * 256; i += NGT) P[P_CDW + i] = PIN(I_CDW)[i];
      for (int i = gt; i < 512; i += NGT) { P[P_CDWB + i] = PIN(I_CDWB)[i]; P[P_CLNG + i] = PIN(I_CLNG)[i]; P[P_CLNB + i] = PIN(I_CLNB)[i]; P[P_CPWB + i] = PIN(I_CPWB)[i]; }
      for (int i = gt; i < 384; i += NGT) { P[P_QNG + i] = PIN(I_QNG)[i]; P[P_KNG + i] = PIN(I_KNG)[i]; }
      for (int i = gt; i < 64; i += NGT) P[P_BR + i] = PIN(I_BR)[i];
      for (int i = gt; i < 1024; i += NGT) { const int l_ = i >> 9, n_ = i & 511; P[P_MIXB + i] = (n_ >= 256) ? PIN(I_CPWB)[l_ * 256 + n_ - 256] : 0.f; }
      for (int i = gt; i < 2 * 32 * 2048; i += NGT) P[P_BGU + i] = PIN(I_BGU)[i];
      for (int i = gt; i < 2 * 32 * 1024; i += NGT) P[P_BDN + i] = PIN(I_BDN)[i]; }
#if DENSE_I8
    __syncthreads();
    { unsigned* wq = WSP(unsigned, WS_CTL) + CW_WQ; unsigned sp_ = 0;
      while (__hip_atomic_load(wq + 16, __ATOMIC_RELAXED, __HIP_MEMORY_SCOPE_AGENT) < (unsigned)NGW) { __builtin_amdgcn_s_sleep(8); if (++sp_ > (1u << 22)) break; }
      for (int it = gw; it < N_IN_ + N_O_; it += NGW) {
        int r = it;
        if (r < N_IN_) { const int l = r / I_IN, q = r % I_IN, kb = q / 38, nb = q % 38;
            const float cm = __uint_as_float(__hip_atomic_load(wq + 32 + (2 * l) * 1280 + nb * 32 + (C.lane & 31), __ATOMIC_RELAXED, __HIP_MEMORY_SCOPE_AGENT));
            tconv_i8_item(PIN(I_WIN) + (size_t)l * 1024 * DIN, DIN, kb * 64, nb * 32, PIN(I_ANG) + l * 1024, cm > 0.f ? 127.f / cm : 0.f, C.ws + WS_WIN + (size_t)l * DINP * 1024, 1024, scr, C.lane); continue; }
        r -= N_IN_;
        { const int l = r / I_O, q = r % I_O, kb = q / 32, nb = q % 32, k0 = kb * 64;
            const float* ks = (k0 < 256) ? (PIN(I_POG) + l * 256) : (k0 < 512) ? (PIN(I_COG) + l * 256 - 256) : (PIN(I_AOG) + l * 512 - 512);
            const float cm = __uint_as_float(__hip_atomic_load(wq + 32 + (2 * l + 1) * 1280 + nb * 32 + (C.lane & 31), __ATOMIC_RELAXED, __HIP_MEMORY_SCOPE_AGENT));
            tconv_i8_item(PIN(I_WO) + (size_t)l * 1024 * 1024, 1024, k0, nb * 32, ks, cm > 0.f ? 127.f / cm : 0.f, C.ws + WS_WO + (size_t)l * 1024 * 1024, 1024, scr, C.lane); } } }
#endif
    const float invf = (float)exp(-9.210340371976184 * (double)(gt & 31) / 32.0);
    for (int i = gt; i < T * 32; i += NGT) {
        const int t = i >> 5;
        const float ang = (float)((const int*)PIN(I_POS))[t] * invf;
        double r = (double)ang * 0.15915494309189533577; r = r - rint(r);
        const float tf = (float)r;
        WSP(f32x2, WS_COS)[i] = (f32x2){__builtin_amdgcn_cosf(tf), __builtin_amdgcn_sinf(tf)};
    }
    f32x4 vn[4], vn2[4];
    if (gw < T) { const f32x4* xr = (const f32x4*)(PIN(I_X) + (size_t)gw * DM) + C.lane;
#pragma unroll
        for (int j = 0; j < 4; ++j) { vn[j] = xr[64 * j]; vn2[j] = vn[j]; } }
    if (gw + NGW < T) { const f32x4* xr = (const f32x4*)(PIN(I_X) + (size_t)(gw + NGW) * DM) + C.lane;
#pragma unroll
        for (int j = 0; j < 4; ++j) vn2[j] = xr[64 * j]; }
    for (int m = gw; m < T; m += NGW) {
        f32x4 v[4]; float s = 0.f;
#pragma unroll
        for (int j = 0; j < 4; ++j) { v[j] = vn[j]; vn[j] = vn2[j]; s += (v[j].x * v[j].x + v[j].y * v[j].y) + (v[j].z * v[j].z + v[j].w * v[j].w); }
        if (m + 2 * NGW < T) { const f32x4* xr = (const f32x4*)(PIN(I_X) + (size_t)(m + 2 * NGW) * DM) + C.lane;
#pragma unroll
            for (int j = 0; j < 4; ++j) vn2[j] = xr[64 * j]; }
        const float rs = rsqrtf(wave_sum(s) * (1.f / DM) + EPS);
        u32x2* o = (u32x2*)(WSP(bf16_t, WS_XB) + (size_t)m * DM) + C.lane;
#pragma unroll
        for (int j = 0; j < 4; ++j) o[64 * j] = (u32x2){pk2(v[j].x, v[j].y), pk2(v[j].z, v[j].w)};
#if DENSE_I8
        { float am = 0.f;
#pragma unroll
          for (int j = 0; j < 4; ++j) am = fmaxf(am, fmaxf(fmaxf(fabsf(v[j].x), fabsf(v[j].y)), fmaxf(fabsf(v[j].z), fabsf(v[j].w))));
          am = wave_max(am); const float qi = am > 0.f ? 127.f * __builtin_amdgcn_rcpf(am) : 0.f;
          unsigned* xq = (unsigned*)(C.ws + WS_XQ + (size_t)m * DM) + C.lane;
#pragma unroll
          for (int j = 0; j < 4; ++j) xq[64 * j] = pk4_i8(v[j].x * qi, v[j].y * qi, v[j].z * qi, v[j].w * qi);
          if (C.lane == 0) WSP(float, WS_RS)[m] = rs * am * (1.f / 127.f); }
#else
        if (C.lane == 0) WSP(float, WS_RS)[m] = rs;
#endif
    }
}
#undef PIN

template <int NBT, class RowPtr, class Epi>
__device__ __forceinline__ void sg_tile(const Ctx& C, RowPtr rowptr, const bf16_t* Bt0, const bf16_t* Bt1, int K, Epi epi) {
    constexpr int LDR = 40;
    LAS bf16_t* SA = (LAS bf16_t*)C.lds; LAS bf16_t* SB = SA + 128 * LDR;
    const int tid = C.tid, lane = C.lane, wid = C.wave, wr = wid >> 1, wc = wid & 1, fr = lane & 15, fq = lane >> 4;
    const int sr = tid >> 2, sc = (tid & 3) * 8;
    const bf16_t* ap = rowptr(sr) + sc;
    const bf16_t* bp0 = Bt0 + (size_t)sr * K + sc; const bf16_t* bp1 = (NBT == 2) ? (Bt1 + (size_t)sr * K + sc) : bp0;
    f32x4 acc[NBT][2][4];
#pragma unroll
    for (int b = 0; b < NBT; ++b)
#pragma unroll
        for (int m = 0; m < 2; ++m)
#pragma unroll
            for (int n = 0; n < 4; ++n) acc[b][m][n] = (f32x4){0.f, 0.f, 0.f, 0.f};
    for (int kt = 0; kt < K / 32; ++kt) {
        const bf16x8 av = *(const bf16x8*)(ap + kt * 32); const bf16x8 bv0 = *(const bf16x8*)(bp0 + kt * 32); bf16x8 bv1 = bv0; if (NBT == 2) bv1 = *(const bf16x8*)(bp1 + kt * 32);
        __syncthreads();
        *(LAS bf16x8*)(SA + sr * LDR + sc) = av; *(LAS bf16x8*)(SB + sr * LDR + sc) = bv0; if (NBT == 2) *(LAS bf16x8*)(SB + (128 + sr) * LDR + sc) = bv1;
        __syncthreads();
        bf16x8 a[2], b[NBT][4];
#pragma unroll
        for (int m = 0; m < 2; ++m) a[m] = *(const LAS bf16x8*)(SA + (wr * 32 + m * 16 + fr) * LDR + fq * 8);
#pragma unroll
        for (int bt = 0; bt < NBT; ++bt)
#pragma unroll
            for (int n = 0; n < 4; ++n) b[bt][n] = *(const LAS bf16x8*)(SB + (bt * 128 + wc * 64 + n * 16 + fr) * LDR + fq * 8);
#pragma unroll
        for (int bt = 0; bt < NBT; ++bt)
#pragma unroll
            for (int m = 0; m < 2; ++m)
#pragma unroll
                for (int n = 0; n < 4; ++n) acc[bt][m][n] = __builtin_amdgcn_mfma_f32_16x16x32_bf16(a[m], b[bt][n], acc[bt][m][n], 0, 0, 0);
    }
#pragma unroll
    for (int m = 0; m < 2; ++m)
#pragma unroll
        for (int n = 0; n < 4; ++n)
#pragma unroll
            for (int j = 0; j < 4; ++j) {
                const int r = wr * 32 + m * 16 + fq * 4 + j, c = wc * 64 + n * 16 + fr;
                if (NBT == 2) epi(r, c, acc[0][m][n][j], acc[NBT - 1][m][n][j]); else epi(r, c, acc[0][m][n][j], 0.f);
            }
    __syncthreads();
}


namespace g8 {
constexpr int BM = 256, BK = 64, HALF = 128, HTB = HALF * BK * 2, STAGE_BYTES = 8 * HTB;
__device__ __forceinline__ int lds_byte(int r, int c) { const int st = (r >> 4) * 2 + (c >> 5), rr = r & 15, cc = c & 31, ob = rr * 64 + cc * 2; return st * 1024 + (ob ^ (((ob >> 9) & 1) << 5)); }
__device__ __forceinline__ void stage_rc(int b, int& R, int& Cc) { const int st = b / 1024, sb = b % 1024, swz = sb ^ (((sb >> 9) & 1) << 5); R = (st >> 1) * 16 + swz / 64; Cc = (st & 1) * 32 + (swz % 64) / 2; }
__device__ __forceinline__ int perm32(int rho) { const int n = rho >> 4, i = rho & 15; return 8 * (i >> 2) + 4 * n + (i & 3); }
__device__ __forceinline__ int h8(int x) { return (int)((0x64753120u >> (4 * x)) & 7u); }
template <bool F8> __device__ __forceinline__ void stage_map(int b, int& R, int& Cc) {
    if constexpr (F8) { const int q = b >> 4; R = q >> 3; Cc = ((q & 7) ^ h8((R >> 1) & 7)) * 8; } else stage_rc(b, R, Cc); }
struct GUnit { const unsigned char* A; const unsigned char* B; int row0, col0, e, aux; };
__device__ __forceinline__ void tile_of(int L, int nM, int nN, int& pm, int& pn) {
    const int nwg = nM * nN; int wgid = L; { const int q = nwg / 8, r = nwg % 8, xcd = wgid % 8, off = wgid / 8; wgid = (xcd < r ? xcd * (q + 1) : r * (q + 1) + (xcd - r) * q) + off; }
    const int nig = 8 * nN, gid = wgid / nig, fm = gid * 8, gsz = (nM - fm) < 8 ? (nM - fm) : 8;
    const int wi = wgid % nig;
    if (gsz == 8) { pm = fm + (wi & 7); pn = wi >> 3; } else { pm = fm + wi % gsz; pn = wi / gsz; }
}
typedef int v8i_t __attribute__((ext_vector_type(8)));
typedef int v4i_t __attribute__((ext_vector_type(4)));
__device__ __forceinline__ v8i_t cat8(bf16x8 lo, bf16x8 hi) { return __builtin_shufflevector(__builtin_bit_cast(v4i_t, lo), __builtin_bit_cast(v4i_t, hi), 0, 1, 2, 3, 4, 5, 6, 7); }
__device__ __forceinline__ void mfma_f8(f32x4& acc, v8i_t a, v8i_t b) { asm("s_nop 1\n\tv_mfma_f32_16x16x128_f8f6f4 %0, %1, %2, %0" : "+v"(acc) : "v"(a), "v"(b)); }
template <class Epi, class Sched, bool ALIGN_EPI, bool SP2, bool F8 = false, int PM = 0, bool I8 = false>
__device__ __forceinline__ void gemm_phase(LAS unsigned char* lds, const int K, const Sched& S, const Epi& E) {
    constexpr int ES = (F8 || I8) ? 1 : 2;
    int tid = threadIdx.x; asm volatile("" : "+v"(tid));
    const int wid = __builtin_amdgcn_readfirstlane(tid >> 6), lane = tid & 63, wr = wid >> 2, wc = wid & 3, fr = lane & 15, fq = lane >> 4;
    const int nt = (PM == 2) ? 4 : K * ES / 128;
    unsigned voffB[2];
#pragma unroll
    for (int i = 0; i < 2; ++i) { int R, Cc; stage_map<F8>(tid * 16 + i * 8192, R, Cc); const int Rb = (Epi::PERM == 1) ? ((R & ~31) + perm32(R & 31)) : (Epi::PERM == 2) ? (64 * (R >> 5) + 16 * ((R >> 2) & 3) + 4 * ((R >> 4) & 1) + (R & 3)) : R;
        voffB[i] = (unsigned)(Rb * K * ES + Cc * 2); }
#define PG8_LOAD_IDS(U) do { int tz_ = threadIdx.x; asm volatile("" : "+v"(tz_)); int R0_, C0_, R1_, C1_; stage_map<F8>(tz_ * 16, R0_, C0_); stage_map<F8>(tz_ * 16 + 8192, R1_, C1_); \
        id00 = S.rowid(U, R0_); id01 = S.rowid(U, R1_); id10 = S.rowid(U, HALF + R0_); id11 = S.rowid(U, HALF + R1_); } while (0)
#define PG8_IDS_TO_VA() do { int tz_ = threadIdx.x; asm volatile("" : "+v"(tz_)); int R0_, C0_, R1_, C1_; stage_map<F8>(tz_ * 16, R0_, C0_); stage_map<F8>(tz_ * 16 + 8192, R1_, C1_); \
        va00 = S.idoff(id00) + (unsigned)C0_ * 2u; va01 = S.idoff(id01) + (unsigned)C1_ * 2u; va10 = S.idoff(id10) + (unsigned)C0_ * 2u; va11 = S.idoff(id11) + (unsigned)C1_ * 2u; } while (0)
    const size_t kstep = (size_t)(BK * 2);
    const size_t hstepB = (size_t)(Epi::PERM == 2 ? 8 : HALF) * K * ES;
    const unsigned ldsw = (unsigned)wid * 1024u;
    const int aoff = F8 ? ((wr * 64 + fr) * 128 + 16 * ((2 * fq) ^ h8((fr >> 1) & 7))) : lds_byte(wr * 64 + fr, fq * 8), boff = F8 ? ((wc * 32 + fr) * 128 + 16 * ((2 * fq) ^ h8((fr >> 1) & 7))) : lds_byte(wc * 32 + fr, fq * 8);
    const int aoff1 = F8 ? (aoff ^ 16) : (aoff + 1024), boff1 = F8 ? (boff ^ 16) : (boff + 1024);
#define PG8_SA(b, h) (((b) * 2 + (h)) * HTB)
#define PG8_SB(b, h) ((4 + (b) * 2 + (h)) * HTB)
#define PG8_STAGE2(bufoff, gbase, v0, v1) do { \
        __builtin_amdgcn_global_load_lds((const unsigned*)((const unsigned char*)(gbase) + (v0)), (LAS unsigned*)(lds + (bufoff) + ldsw), 16, 0, 0); \
        __builtin_amdgcn_global_load_lds((const unsigned*)((const unsigned char*)(gbase) + (v1)), (LAS unsigned*)(lds + (bufoff) + ldsw + 8192), 16, 0, 0); } while (0)
#define PG8_STAGE_B(bufoff, gbase) PG8_STAGE2(bufoff, gbase, voffB[0], voffB[1])
#define PG8_LDA(dst, b, h) do { _Pragma("unroll") for (int m = 0; m < 4; ++m) _Pragma("unroll") for (int k = 0; k < 2; ++k) dst[m][k] = *(const LAS bf16x8*)(lds + PG8_SA(b, h) + (k ? aoff1 : aoff) + m * 2048); } while (0)
#define PG8_LDB(dst, b, h) do { _Pragma("unroll") for (int n = 0; n < 2; ++n) _Pragma("unroll") for (int k = 0; k < 2; ++k) dst[n][k] = *(const LAS bf16x8*)(lds + PG8_SB(b, h) + (k ? boff1 : boff) + n * 2048); } while (0)
#define PG8_MMA(ai, bj, At, Bt) do { __builtin_amdgcn_s_setprio(1); if constexpr (F8) { _Pragma("unroll") for (int m = 0; m < 4; ++m) _Pragma("unroll") for (int n = 0; n < 2; ++n) \
        mfma_f8(acc[ai][bj][m][n], cat8(Bt[n][0], Bt[n][1]), cat8(At[m][0], At[m][1])); } else if constexpr (I8) { \
        _Pragma("unroll") for (int m = 0; m < 4; ++m) _Pragma("unroll") for (int n = 0; n < 2; ++n) _Pragma("unroll") for (int k = 0; k < 2; ++k) \
        acc[ai][bj][m][n] = __builtin_bit_cast(f32x4, __builtin_amdgcn_mfma_i32_16x16x64_i8(__builtin_bit_cast(v4i_t, Bt[n][k]), __builtin_bit_cast(v4i_t, At[m][k]), __builtin_bit_cast(v4i_t, acc[ai][bj][m][n]), 0, 0, 0)); } else { \
        _Pragma("unroll") for (int m = 0; m < 4; ++m) _Pragma("unroll") for (int n = 0; n < 2; ++n) _Pragma("unroll") for (int k = 0; k < 2; ++k) \
        acc[ai][bj][m][n] = __builtin_amdgcn_mfma_f32_16x16x32_bf16(Bt[n][k], At[m][k], acc[ai][bj][m][n], 0, 0, 0); } __builtin_amdgcn_s_setprio(0); } while (0)
#define PG8_WAIT_V(n) asm volatile("s_waitcnt vmcnt(" #n ")" ::: "memory")
#define PG8_WAIT_L(n) asm volatile("s_waitcnt lgkmcnt(" #n ")" ::: "memory")
#define PG8_BAR __builtin_amdgcn_s_barrier()
#define PG8_SCHED __builtin_amdgcn_sched_barrier(0)
    GUnit cur, nxt; int ui = 0;
    if (!S.next(0, cur)) return;
    f32x4 acc[2][2][4][2];
#pragma unroll
    for (int a = 0; a < 2; ++a)
#pragma unroll
        for (int b = 0; b < 2; ++b)
#pragma unroll
            for (int m = 0; m < 4; ++m)
#pragma unroll
                for (int n = 0; n < 2; ++n) { f32x2 z0, z1; asm volatile("v_mov_b64 %0, 0" : "=v"(z0)); asm volatile("v_mov_b64 %0, 0" : "=v"(z1)); acc[a][b][m][n] = (f32x4){z0.x, z0.y, z1.x, z1.y}; }
    bf16x8 At[4][2], B0[2][2], B1[2][2];
    const unsigned char* cA = cur.A; const unsigned char* cB = cur.B;
    unsigned va00, va01, va10, va11; int id00, id01, id10, id11; PG8_LOAD_IDS(cur); PG8_IDS_TO_VA();
    if constexpr (SP2) {
        PG8_STAGE_B(PG8_SB(0, 0), cB); PG8_STAGE_B(PG8_SB(0, 1), cB + hstepB); PG8_STAGE2(PG8_SA(0, 0), cA, va00, va01); PG8_STAGE2(PG8_SA(0, 1), cA, va10, va11);
        if (wr == 1) PG8_BAR;
        PG8_WAIT_V(2); PG8_BAR;
        PG8_STAGE_B(PG8_SB(1, 0), cB + kstep); PG8_STAGE2(PG8_SA(1, 0), cA + kstep, va00, va01); PG8_STAGE_B(PG8_SB(1, 1), cB + hstepB + kstep);
        PG8_WAIT_V(6); PG8_BAR;
    } else {
        PG8_STAGE_B(PG8_SB(0, 0), cB); PG8_STAGE2(PG8_SA(0, 0), cA, va00, va01); PG8_STAGE_B(PG8_SB(0, 1), cB + hstepB); PG8_STAGE2(PG8_SA(0, 1), cA, va10, va11);
        if (wr == 1) PG8_BAR;
        PG8_WAIT_V(4); PG8_BAR;
        PG8_STAGE_B(PG8_SB(1, 0), cB + kstep); PG8_STAGE2(PG8_SA(1, 0), cA + kstep, va00, va01); PG8_STAGE_B(PG8_SB(1, 1), cB + hstepB + kstep);
        PG8_WAIT_V(6); PG8_BAR;
    }
    for (;;) {
        const bool has_next = S.next(ui + 1, nxt);
        const unsigned char* nA = has_next ? nxt.A : cA; const unsigned char* nB = has_next ? nxt.B : cB;
        if (has_next) PG8_LOAD_IDS(nxt);
        for (int t = 0; t < nt; t += 2) {
            const bool last = (t == nt - 2);
            const unsigned char* a1 = cA + (size_t)(t + 1) * kstep;
            PG8_STAGE2(PG8_SA(1, 1), a1, va10, va11);
            if (last && has_next) PG8_IDS_TO_VA();
            const unsigned char* a2 = last ? nA : cA + (size_t)(t + 2) * kstep; const unsigned char* b2 = last ? nB : cB + (size_t)(t + 2) * kstep;
            const unsigned char* a3 = a2 + kstep; const unsigned char* b3 = b2 + kstep;
            if constexpr (SP2) {
            PG8_LDB(B0, 0, 0); PG8_LDB(B1, 0, 1); PG8_SCHED; PG8_LDA(At, 0, 0);
            PG8_WAIT_V(8); PG8_WAIT_L(0); PG8_BAR; PG8_MMA(0, 0, At, B0); PG8_MMA(0, 1, At, B1); PG8_BAR; PG8_SCHED;
            PG8_LDA(At, 0, 1); PG8_STAGE_B(PG8_SB(0, 0), b2); PG8_STAGE_B(PG8_SB(0, 1), b2 + hstepB); PG8_STAGE2(PG8_SA(0, 0), a2, va00, va01);
            PG8_WAIT_V(8); PG8_WAIT_L(0); PG8_BAR; PG8_MMA(1, 0, At, B0); PG8_MMA(1, 1, At, B1); PG8_BAR; PG8_SCHED;
            PG8_LDB(B0, 1, 0); PG8_LDB(B1, 1, 1); PG8_SCHED; PG8_LDA(At, 1, 0); PG8_STAGE2(PG8_SA(0, 1), a2, va10, va11);
            PG8_WAIT_V(8); PG8_WAIT_L(0); PG8_BAR; PG8_MMA(0, 0, At, B0); PG8_MMA(0, 1, At, B1); PG8_BAR; PG8_SCHED;
            PG8_LDA(At, 1, 1); PG8_STAGE_B(PG8_SB(1, 0), b3); PG8_STAGE_B(PG8_SB(1, 1), b3 + hstepB); PG8_STAGE2(PG8_SA(1, 0), a3, va00, va01);
            PG8_WAIT_V(8); PG8_WAIT_L(0); PG8_BAR; PG8_MMA(1, 0, At, B0); PG8_MMA(1, 1, At, B1); PG8_BAR; PG8_SCHED;
            } else {
            PG8_LDB(B0, 0, 0); PG8_SCHED; PG8_LDA(At, 0, 0);
            PG8_WAIT_L(8); PG8_BAR; PG8_WAIT_L(0); PG8_MMA(0, 0, At, B0); PG8_BAR; PG8_SCHED;
            PG8_LDB(B1, 0, 1); PG8_STAGE_B(PG8_SB(0, 0), b2);
            PG8_BAR; PG8_WAIT_L(0); PG8_MMA(0, 1, At, B1); PG8_BAR;
            PG8_LDA(At, 0, 1); PG8_STAGE2(PG8_SA(0, 0), a2, va00, va01);
            PG8_BAR; PG8_WAIT_L(0); PG8_MMA(1, 0, At, B0); PG8_BAR; PG8_SCHED;
            PG8_STAGE_B(PG8_SB(0, 1), b2 + hstepB);
            PG8_WAIT_V(6); PG8_BAR; PG8_MMA(1, 1, At, B1); PG8_BAR;
            PG8_LDB(B0, 1, 0); PG8_SCHED; PG8_LDA(At, 1, 0); PG8_STAGE2(PG8_SA(0, 1), a2, va10, va11);
            PG8_WAIT_L(8); PG8_BAR; PG8_WAIT_L(0); PG8_MMA(0, 0, At, B0); PG8_BAR; PG8_SCHED;
            PG8_LDB(B1, 1, 1); PG8_STAGE_B(PG8_SB(1, 0), b3);
            PG8_BAR; PG8_WAIT_L(0); PG8_MMA(0, 1, At, B1); PG8_BAR;
            PG8_LDA(At, 1, 1); PG8_STAGE2(PG8_SA(1, 0), a3, va00, va01);
            PG8_BAR; PG8_WAIT_L(0); PG8_MMA(1, 0, At, B0); PG8_BAR; PG8_SCHED;
            PG8_STAGE_B(PG8_SB(1, 1), b3 + hstepB);
            PG8_WAIT_V(6); PG8_BAR; PG8_MMA(1, 1, At, B1); PG8_BAR;
            }
        }
        if constexpr (ALIGN_EPI) { if (wr == 0) PG8_BAR; }
        if constexpr (F8) { PG8_SCHED; asm volatile("s_nop 15" ::: "memory"); PG8_SCHED; }
        if constexpr (PM != 1) E(acc, cur, wr, wc, fr, fq);
        if (!has_next) break;
#pragma unroll
        for (int a = 0; a < 2; ++a)
#pragma unroll
            for (int b = 0; b < 2; ++b)
#pragma unroll
                for (int m = 0; m < 4; ++m)
#pragma unroll
                    for (int n = 0; n < 2; ++n) { f32x2 z0, z1; asm volatile("v_mov_b64 %0, 0" : "=v"(z0)); asm volatile("v_mov_b64 %0, 0" : "=v"(z1));
                        acc[a][b][m][n] = (f32x4){z0.x, z0.y, z1.x, z1.y}; }
        cur = nxt; cA = nA; cB = nB; ++ui;
        if constexpr (ALIGN_EPI) { if (wr == 1) PG8_BAR; }
    }
    PG8_WAIT_V(0);
    if constexpr (!ALIGN_EPI) { if (wr == 0) PG8_BAR; }
    PG8_BAR;
#undef PG8_SA
#undef PG8_SB
#undef PG8_STAGE2
#undef PG8_STAGE_B
#undef PG8_LOAD_IDS
#undef PG8_IDS_TO_VA
#undef PG8_LDA
#undef PG8_LDB
#undef PG8_MMA
#undef PG8_WAIT_V
#undef PG8_WAIT_L
#undef PG8_BAR
#undef PG8_SCHED
}
typedef f32x4 AccT[2][2][4][2];
struct EpiBf16 {
    static constexpr int PERM = 1;
    bf16_t* O; int ldc; const float* bias;
    __device__ __forceinline__ void operator()(const AccT& acc, const GUnit& u, int wr, int wc, int fr, int fq) const {
        const int row0 = u.row0 + wr * 64 + fr, col0 = u.col0 + wc * 32 + 8 * fq;
        f32x4 bv[2][2];
#pragma unroll
        for (int bj = 0; bj < 2; ++bj)
#pragma unroll
            for (int n = 0; n < 2; ++n) bv[bj][n] = bias ? *(const f32x4*)(bias + col0 + bj * HALF + 4 * n) : (f32x4){0.f, 0.f, 0.f, 0.f};
#pragma unroll
        for (int ai = 0; ai < 2; ++ai)
#pragma unroll
            for (int m = 0; m < 4; ++m) { bf16_t* rowp = O + (size_t)(row0 + ai * HALF + m * 16) * ldc + col0;
#pragma unroll
                for (int bj = 0; bj < 2; ++bj) { const f32x4 v0 = acc[ai][bj][m][0] + bv[bj][0], v1 = acc[ai][bj][m][1] + bv[bj][1];
                    *(u32x4*)(rowp + bj * HALF) = (u32x4){pk2(v0[0], v0[1]), pk2(v0[2], v0[3]), pk2(v1[0], v1[1]), pk2(v1[2], v1[3])}; } }
    }
};
struct EpiBf16Rs {
    static constexpr int PERM = 1;
    bf16_t* O; int ldc; const float* rs;
    __device__ __forceinline__ void operator()(const AccT& acc, const GUnit& u, int wr, int wc, int fr, int fq) const {
        const int row0 = u.row0 + wr * 64 + fr, col0 = u.col0 + wc * 32 + 8 * fq;
#pragma unroll
        for (int ai = 0; ai < 2; ++ai)
#pragma unroll
            for (int m = 0; m < 4; ++m) { const int row = row0 + ai * HALF + m * 16; const float sc = rs[row]; bf16_t* rowp = O + (size_t)row * ldc + col0;
#pragma unroll
                for (int bj = 0; bj < 2; ++bj) { const f32x4 v0 = acc[ai][bj][m][0] * sc, v1 = acc[ai][bj][m][1] * sc;
                    *(u32x4*)(rowp + bj * HALF) = (u32x4){pk2(v0[0], v0[1]), pk2(v0[2], v0[3]), pk2(v1[0], v1[1]), pk2(v1[2], v1[3])}; } }
    }
};
__device__ __forceinline__ f32x4 i2f4(f32x4 a) { const v4i_t q = __builtin_bit_cast(v4i_t, a); return (f32x4){(float)q[0], (float)q[1], (float)q[2], (float)q[3]}; }
struct EpiI8Rs {
    static constexpr int PERM = 1;
    bf16_t* O; int ldc; const float* rowf; const float* wstep;
    __device__ __forceinline__ void operator()(const AccT& acc, const GUnit& u, int wr, int wc, int fr, int fq) const {
        const int row0 = u.row0 + wr * 64 + fr, col0 = u.col0 + wc * 32 + 8 * fq;
        f32x4 cs[2][2];
#pragma unroll
        for (int bj = 0; bj < 2; ++bj)
#pragma unroll
            for (int n = 0; n < 2; ++n) cs[bj][n] = *(const f32x4*)(wstep + col0 + bj * HALF + 4 * n);
        __builtin_amdgcn_sched_barrier(0);
#pragma unroll
        for (int bj = 0; bj < 2; ++bj)
#pragma unroll
            for (int n = 0; n < 2; ++n) cs[bj][n] = cs[bj][n] * (1.f / 127.f);
#pragma unroll
        for (int ai = 0; ai < 2; ++ai)
#pragma unroll
            for (int m = 0; m < 4; ++m) { const int row = row0 + ai * HALF + m * 16; const float sc = rowf[row]; bf16_t* rowp = O + (size_t)row * ldc + col0;
#pragma unroll
                for (int bj = 0; bj < 2; ++bj) { const f32x4 v0 = i2f4(acc[ai][bj][m][0]) * cs[bj][0] * sc, v1 = i2f4(acc[ai][bj][m][1]) * cs[bj][1] * sc;
                    *(u32x4*)(rowp + bj * HALF) = (u32x4){pk2(v0[0], v0[1]), pk2(v0[2], v0[3]), pk2(v1[0], v1[1]), pk2(v1[2], v1[3])}; } }
    }
};
struct EpiI8Res {
    static constexpr int PERM = 1;
    const bf16_t* xin16; bf16_t* out; const float* rowf; const float* wstep;
    __device__ __forceinline__ void operator()(const AccT& acc, const GUnit& u, int wr, int wc, int fr, int fq) const {
        const int row0 = u.row0 + wr * 64 + fr, col0 = u.col0 + wc * 32 + 8 * fq;
        f32x4 cs[2][2];
#pragma unroll
        for (int bj = 0; bj < 2; ++bj)
#pragma unroll
            for (int n = 0; n < 2; ++n) cs[bj][n] = *(const f32x4*)(wstep + col0 + bj * HALF + 4 * n);
        __builtin_amdgcn_sched_barrier(0);
#pragma unroll
        for (int bj = 0; bj < 2; ++bj)
#pragma unroll
            for (int n = 0; n < 2; ++n) cs[bj][n] = cs[bj][n] * (1.f / 127.f);
#pragma unroll
        for (int ai = 0; ai < 2; ++ai) {
            u32x4 w[4][2]; float sc[4];
#pragma unroll
            for (int m = 0; m < 4; ++m) { const int row = row0 + ai * HALF + m * 16; const size_t off = (size_t)row * 1024 + col0; sc[m] = rowf[row];
#pragma unroll
                for (int bj = 0; bj < 2; ++bj) w[m][bj] = *(const u32x4*)(xin16 + off + bj * HALF); }
            __builtin_amdgcn_sched_barrier(0);
#pragma unroll
            for (int m = 0; m < 4; ++m) { const int row = row0 + ai * HALF + m * 16; const size_t off = (size_t)row * 1024 + col0;
#pragma unroll
                for (int bj = 0; bj < 2; ++bj) { f32x4 v0 = i2f4(acc[ai][bj][m][0]) * cs[bj][0] * sc[m], v1 = i2f4(acc[ai][bj][m][1]) * cs[bj][1] * sc[m]; const u32x4 ww = w[m][bj];
                    v0 += (f32x4){bflo(ww.x), bfhi(ww.x), bflo(ww.y), bfhi(ww.y)}; v1 += (f32x4){bflo(ww.z), bfhi(ww.z), bflo(ww.w), bfhi(ww.w)};
                    *(u32x4*)(out + off + bj * HALF) = (u32x4){pk2(v0[0], v0[1]), pk2(v0[2], v0[3]), pk2(v1[0], v1[1]), pk2(v1[2], v1[3])}; } }
            asm volatile("" ::: "memory"); }
    }
};
struct EpiResF32 {
    static constexpr int PERM = 0;
    const float* xin; float* out; int ldc; float ascale;
    __device__ __forceinline__ void operator()(const AccT& acc, const GUnit& u, int wr, int wc, int fr, int fq) const {
        const int row0 = u.row0 + wr * 64 + fr, col0 = u.col0 + wc * 32 + 4 * fq;
#pragma unroll
        for (int ai = 0; ai < 2; ++ai)
#pragma unroll
            for (int m = 0; m < 4; ++m) { const size_t off = (size_t)(row0 + ai * HALF + m * 16) * ldc + col0;
#pragma unroll
                for (int bj = 0; bj < 2; ++bj)
#pragma unroll
                    for (int n = 0; n < 2; ++n) { const f32x4 b = *(const f32x4*)(xin + off + bj * HALF + n * 16); *(f32x4*)(out + off + bj * HALF + n * 16) = b + acc[ai][bj][m][n] * ascale; }
                asm volatile("" ::: "memory"); }
    }
};
struct EpiResBf16 {
    static constexpr int PERM = 1;
    const float* xin32; const bf16_t* xin16; bf16_t* out;
    __device__ __forceinline__ void operator()(const AccT& acc, const GUnit& u, int wr, int wc, int fr, int fq) const {
        const int row0 = u.row0 + wr * 64 + fr, col0 = u.col0 + wc * 32 + 8 * fq;
#pragma unroll
        for (int ai = 0; ai < 2; ++ai)
#pragma unroll
            for (int m = 0; m < 4; ++m) { const size_t off = (size_t)(row0 + ai * HALF + m * 16) * 1024 + col0;
#pragma unroll
                for (int bj = 0; bj < 2; ++bj) { f32x4 v0 = acc[ai][bj][m][0], v1 = acc[ai][bj][m][1];
                    if (xin32) { v0 += *(const f32x4*)(xin32 + off + bj * HALF); v1 += *(const f32x4*)(xin32 + off + bj * HALF + 4); }
                    else { const u32x4 w = *(const u32x4*)(xin16 + off + bj * HALF); v0 += (f32x4){bflo(w.x), bfhi(w.x), bflo(w.y), bfhi(w.y)}; v1 += (f32x4){bflo(w.z), bfhi(w.z), bflo(w.w), bfhi(w.w)}; }
                    *(u32x4*)(out + off + bj * HALF) = (u32x4){pk2(v0[0], v0[1]), pk2(v0[2], v0[3]), pk2(v1[0], v1[1]), pk2(v1[2], v1[3])}; }
                asm volatile("" ::: "memory"); }
    }
};
struct EpiGlu {
    static constexpr int PERM = 1;
    bf16_t* act; const float* bgu_l;
    __device__ __forceinline__ void operator()(const AccT& acc, const GUnit& u, int wr, int wc, int fr, int fq) const {
        const int row0 = u.row0 + wr * 64 + fr, j0 = (u.col0 >> 1) + wc * 32 + 8 * fq;
        const float* bg = bgu_l + (size_t)u.e * 2048 + 2 * j0;
        f32x4 b0 = *(const f32x4*)(bg), b1 = *(const f32x4*)(bg + 4), b2 = *(const f32x4*)(bg + 8), b3 = *(const f32x4*)(bg + 12);
        const float bgl[8] = {b0[0], b0[2], b1[0], b1[2], b2[0], b2[2], b3[0], b3[2]}, bll[8] = {b0[1], b0[3], b1[1], b1[3], b2[1], b2[3], b3[1], b3[3]};
#pragma unroll
        for (int ai = 0; ai < 2; ++ai)
#pragma unroll
            for (int m = 0; m < 4; ++m) { float r[8];
#pragma unroll
                for (int n = 0; n < 2; ++n)
#pragma unroll
                    for (int i = 0; i < 4; ++i) { const float vg = acc[ai][0][m][n][i] + bgl[4 * n + i], vl = acc[ai][1][m][n][i] + bll[4 * n + i];
                        const float xg = fminf(vg, 7.f), xl = fminf(fmaxf(vl, -7.f), 7.f);
                        r[4 * n + i] = xg * (xl + 1.f) * __builtin_amdgcn_rcpf(1.f + __builtin_amdgcn_exp2f(-2.4554669595930156f * xg)); }
                *(u32x4*)(act + (size_t)(row0 + ai * HALF + m * 16) * 1024 + j0) = (u32x4){pk2(r[0], r[1]), pk2(r[2], r[3]), pk2(r[4], r[5]), pk2(r[6], r[7])}; }
    }
};
constexpr float W8_SCALE = 32.f, W8_INV = 1.f / 32.f;
struct EpiGlu8 {
    static constexpr int PERM = 1;
    unsigned char* act; const float* bgu_l; LAS const float* btab; int nbt;
    __device__ __forceinline__ void operator()(const AccT& acc, const GUnit& u, int wr, int wc, int fr, int fq) const {
        const int row0 = u.row0 + wr * 64 + fr, j0 = (u.col0 >> 1) + wc * 32 + 8 * fq;
        f32x4 b0, b1, b2, b3;
        const int ui_ = u.aux >> 16;
        if (ui_ < nbt) { const LAS float* bl = btab + ui_ * 256 + 2 * (wc * 32 + 8 * fq); b0 = *(const LAS f32x4*)(bl); b1 = *(const LAS f32x4*)(bl + 4); b2 = *(const LAS f32x4*)(bl + 8); b3 = *(const LAS f32x4*)(bl + 12); }
        else { const float* bg = bgu_l + (size_t)u.e * 2048 + 2 * j0; b0 = *(const f32x4*)(bg); b1 = *(const f32x4*)(bg + 4); b2 = *(const f32x4*)(bg + 8); b3 = *(const f32x4*)(bg + 12); }
        const f32x2 bgp[4] = {(f32x2){b0[0], b0[2]}, (f32x2){b1[0], b1[2]}, (f32x2){b2[0], b2[2]}, (f32x2){b3[0], b3[2]}};
        const f32x2 blp[4] = {(f32x2){b0[1] + 1.f, b0[3] + 1.f}, (f32x2){b1[1] + 1.f, b1[3] + 1.f}, (f32x2){b2[1] + 1.f, b2[3] + 1.f}, (f32x2){b3[1] + 1.f, b3[3] + 1.f}};
#pragma unroll
        for (int ai = 0; ai < 2; ++ai)
#pragma unroll
            for (int m = 0; m < 4; ++m) { f32x2 r[4];
#pragma unroll
                for (int n = 0; n < 2; ++n)
#pragma unroll
                    for (int hp = 0; hp < 2; ++hp) { const f32x2 ag = (f32x2){acc[ai][0][m][n][2 * hp], acc[ai][0][m][n][2 * hp + 1]}, al = (f32x2){acc[ai][1][m][n][2 * hp], acc[ai][1][m][n][2 * hp + 1]};
                        f32x2 vg = ag * W8_INV + bgp[2 * n + hp], vl = al * W8_INV + blp[2 * n + hp];
                        vg.x = fminf(vg.x, 7.f); vg.y = fminf(vg.y, 7.f); vl.x = __builtin_amdgcn_fmed3f(vl.x, -6.f, 8.f); vl.y = __builtin_amdgcn_fmed3f(vl.y, -6.f, 8.f);
                        const f32x2 t = vg * -2.4554669595930156f; f32x2 d; d.x = __builtin_amdgcn_exp2f(t.x); d.y = __builtin_amdgcn_exp2f(t.y); d = d + 1.f;
                        f32x2 rc; rc.x = __builtin_amdgcn_rcpf(d.x); rc.y = __builtin_amdgcn_rcpf(d.y);
                        r[2 * n + hp] = (vg * vl) * rc; }
                *(u32x2*)(act + (size_t)(row0 + ai * HALF + m * 16) * 1024 + j0) = (u32x2){pk4_fp8(r[0].x, r[0].y, r[1].x, r[1].y), pk4_fp8(r[2].x, r[2].y, r[3].x, r[3].y)}; }
    }
};
struct EpiDown {
    static constexpr int PERM = 1;
    bf16_t* yb; const float* bdn_l; const float* lgate; LAS const int* cnt; float ascale;
    __device__ __forceinline__ void operator()(const AccT& acc, const GUnit& u, int wr, int wc, int fr, int fq) const {
        const int rl0 = wr * 64 + fr, col0 = u.col0 + wc * 32 + 8 * fq; const int n_valid = __builtin_amdgcn_readfirstlane(cnt[u.e]);
        const float* bd = bdn_l + (size_t)u.e * 1024 + col0;
        f32x4 bv[2][2];
#pragma unroll
        for (int bj = 0; bj < 2; ++bj)
#pragma unroll
            for (int n = 0; n < 2; ++n) bv[bj][n] = *(const f32x4*)(bd + bj * HALF + 4 * n);
#pragma unroll
        for (int ai = 0; ai < 2; ++ai)
#pragma unroll
            for (int m = 0; m < 4; ++m) { const int rl = rl0 + ai * HALF + m * 16, li = u.aux + rl; const float g = (li < n_valid) ? lgate[(size_t)u.e * T + li] : 0.f;
                bf16_t* rowp = yb + (size_t)(u.row0 + rl) * 1024 + col0;
#pragma unroll
                for (int bj = 0; bj < 2; ++bj) { const f32x4 v0 = (acc[ai][bj][m][0] * ascale + bv[bj][0]) * g, v1 = (acc[ai][bj][m][1] * ascale + bv[bj][1]) * g;
                    *(u32x4*)(rowp + bj * HALF) = (u32x4){pk2(v0[0], v0[1]), pk2(v0[2], v0[3]), pk2(v1[0], v1[1]), pk2(v1[2], v1[3])}; } }
    }
};
constexpr float YB_SCALE = 8.f;
struct EpiDown8 {
    static constexpr int PERM = 2;
    unsigned char* yb; const float* bdn_l; LAS const float* btab; int nbt;
    __device__ __forceinline__ void operator()(const AccT& acc, const GUnit& u, int wr, int wc, int fr, int fq) const {
        const int rl0 = wr * 64 + fr, col0 = u.col0 + wc * 64 + 16 * fq;
        const float* bd = bdn_l + (size_t)u.e * 1024 + col0;
        f32x4 bv[2][2]; const int ui_ = u.aux >> 16;
        if (ui_ < nbt) { const LAS float* bl = btab + ui_ * 256 + wc * 64 + 16 * fq;
#pragma unroll
            for (int bj = 0; bj < 2; ++bj)
#pragma unroll
                for (int n = 0; n < 2; ++n) bv[bj][n] = *(const LAS f32x4*)(bl + 8 * bj + 4 * n) * YB_SCALE; }
        else {
#pragma unroll
        for (int bj = 0; bj < 2; ++bj)
#pragma unroll
            for (int n = 0; n < 2; ++n) bv[bj][n] = *(const f32x4*)(bd + 8 * bj + 4 * n) * YB_SCALE; }
#pragma unroll
        for (int ai = 0; ai < 2; ++ai)
#pragma unroll
            for (int m = 0; m < 4; ++m) { const int rl = rl0 + ai * HALF + m * 16;
                u32x4 o;
#pragma unroll
                for (int bj = 0; bj < 2; ++bj)
#pragma unroll
                    for (int n = 0; n < 2; ++n) { const f32x4 v = acc[ai][bj][m][n] * (W8_INV * YB_SCALE) + bv[bj][n]; o[2 * bj + n] = pk4_fp8(v[0], v[1], v[2], v[3]); }
                *(u32x4*)(yb + (size_t)(u.row0 + rl) * 1024 + col0) = o; }
    }
};
struct DenseSched {
    const unsigned char* A; const unsigned char* Bt; int lda, K, nM, nN, G, c, es;
    __device__ __forceinline__ bool next(int i, GUnit& u) const { const int L = i * G + c; if (L >= nM * nN) return false; int pm, pn; tile_of(L, nM, nN, pm, pn);
        u.A = A + (size_t)pm * 256 * lda * es; u.B = Bt + (size_t)pn * 256 * K * es; u.row0 = pm * 256; u.col0 = pn * 256; u.e = 0; u.aux = 0; return true; }
    __device__ __forceinline__ int rowid(const GUnit&, int R) const { return R; }
    __device__ __forceinline__ unsigned idoff(int id) const { return (unsigned)(id * lda * es); }
};
template <bool GATHER, int RB> struct MoeSched {
    const unsigned char* A; const unsigned char* Wt; const int* ltok; LAS const int* ctl; int nN, G, c;
    LAS const unsigned short* tokt; int ntab; int fix;
    __device__ __forceinline__ bool locate(int i, int& pm, int& pn, int& e, int& rb) const { const int nM = __builtin_amdgcn_readfirstlane(ctl[32 + NEXP]); const int L = i * G + c; if (L >= nM * nN) return false; tile_of(L, nM, nN, pm, pn);
        if (!GATHER) pm = nM - 1 - pm;
        const int lk = (int)(threadIdx.x & 31u), bk = ctl[32 + lk];
        const unsigned long long m = __ballot(lk >= 1 && bk <= pm);
        e = __builtin_popcount((unsigned)m);
        rb = __builtin_amdgcn_readlane(bk, e); return true; }
    __device__ __forceinline__ bool next(int i, GUnit& u) const { int pm, pn, e, rb; if (!locate(i, pm, pn, e, rb)) return false;
        u.A = GATHER ? A : A + (size_t)((fix & 2) ? 0 : pm) * 256 * RB; u.B = Wt + ((size_t)((fix & 1) ? 0 : e) * nN + ((fix & 1) ? 0 : pn)) * 256 * RB;   u.row0 = pm * 256; u.col0 = pn * 256; u.e = e; u.aux = (i << 16) | (pm - rb); return true; }
    __device__ __forceinline__ int rowid(const GUnit& u, int R) const {
        if (GATHER) return (int)tokt[(u.aux >> 16) * 256 + R];
        return R; }
    __device__ __forceinline__ unsigned idoff(int id) const { return (unsigned)id * (unsigned)RB; }
};
}

typedef int v4i_pf __attribute__((ext_vector_type(4)));
__device__ __forceinline__ void moe_tables(const Ctx& C, int l) {
    LAS int* ctl = (LAS int*)(C.lds + LDS_CTL);
    __syncthreads();
    if (C.tid < NEXP) { const int k = C.tid;
        const int cnt = (int)__hip_atomic_load(WSP(unsigned, WS_CTL) + CW_GCNT + (l * NEXP + k) * 64, __ATOMIC_RELAXED, __HIP_MEMORY_SCOPE_AGENT), tl = (cnt + 255) >> 8;
        ctl[k] = cnt; ctl[200 + k] = tl;
        asm volatile("s_waitcnt lgkmcnt(0)" ::: "memory");
        int a_ = 0; v4i_pf tq[NEXP / 4];
#pragma unroll
        for (int j = 0; j < NEXP / 4; ++j) tq[j] = *(const LAS v4i_pf*)(ctl + 200 + 4 * j);
        __builtin_amdgcn_sched_barrier(0);
#pragma unroll
        for (int j = 0; j < NEXP / 4; ++j) { a_ += (4 * j < k ? tq[j].x : 0) + (4 * j + 1 < k ? tq[j].y : 0) + (4 * j + 2 < k ? tq[j].z : 0) + (4 * j + 3 < k ? tq[j].w : 0); }
        ctl[32 + k] = a_; if (k == NEXP - 1) ctl[32 + NEXP] = a_ + tl; }
    __syncthreads();
}
__device__ __forceinline__ int moe_find_expert(const Ctx& C, int rt) {
    LAS int* ctl = (LAS int*)(C.lds + LDS_CTL);
    int e = 0;
    for (int k = 1; k < NEXP; ++k) e += (ctl[32 + k] <= rt) ? 1 : 0;
    return e;
}

__device__ __forceinline__ void ph_inproj(const Ctx& C, int l) {
    const bf16_t* hb = WSP(bf16_t, WS_HB); const bf16_t* W = WSP(bf16_t, WS_WIN) + (size_t)l * DINP * 1024; bf16_t* z = WSP(bf16_t, WS_Z);
    for (int u = C.bid; u < 256 * 10; u += C.G) { const int rt = u / 10, ct = u % 10;
        sg_tile<1>(C, [&](int r) { return hb + (size_t)(rt * 128 + r) * 1024; }, W + (size_t)ct * 128 * 1024, nullptr, 1024,
                   [&](int r, int c, float v, float) { z[(size_t)(rt * 128 + r) * DINP + ct * 128 + c] = (bf16_t)f2bf(v); });
    }
}
template <int SKIP = 0> __device__ __forceinline__ void ph_mix1(const Ctx& C, int l) {
    const bf16_t* z = WSP(bf16_t, WS_Z); bf16_t* A2 = WSP(bf16_t, WS_A2);
    LAS float* vs = (LAS float*)C.lds;
    LAS float* dw = (LAS float*)(C.lds + 62 * 256 * 4);
    const int tid = C.tid, c = tid & 255, half = tid >> 8;
    float wj[31];
#pragma unroll
    for (int j = 0; j < 31; ++j) wj[j] = WSP(float, WS_PAR)[P_CDW + (l * 31 + j) * 256 + c];
    const float cb = WSP(float, WS_PAR)[P_CDWB + l * 256 + c];
    u32x4 ga[4], gg[4];
#define MIX1_LOAD(TILE) do { const int tok0_ = (TILE) * 32, s0_ = tok0_ % SEQ; _Pragma("unroll") for (int p = 0; p < 4; ++p) { const int row = p * 16 + (tid >> 5), ch8 = (tid & 31) * 8; const int srow = s0_ - 30 + row; \
              if (row < 62 && srow >= 0) { const bf16_t* zr = z + (size_t)(tok0_ - 30 + row) * DINP; ga[p] = *(const u32x4*)(zr + 256 + ch8); gg[p] = *(const u32x4*)(zr + 512 + ch8); } \
              else { ga[p] = (u32x4){0u, 0u, 0u, 0u}; gg[p] = (u32x4){0u, 0u, 0u, 0u}; } } } while (0)
    if (C.bid < T / 32 && !(SKIP & 4)) MIX1_LOAD(C.bid);
    for (int tile = C.bid; tile < T / 32; tile += C.G) {
        const int tok0 = tile * 32, s0 = tok0 % SEQ;
        if (!(SKIP & 4)) {
#pragma unroll
          for (int p = 0; p < 4; ++p) { const int row = p * 16 + (tid >> 5), ch8 = (tid & 31) * 8;
              if (row < 62) { const u32x4 a = ga[p], g = gg[p]; float v[8];
                  v[0] = bflo(a.x) * sigmoidf_(bflo(g.x)); v[1] = bfhi(a.x) * sigmoidf_(bfhi(g.x)); v[2] = bflo(a.y) * sigmoidf_(bflo(g.y)); v[3] = bfhi(a.y) * sigmoidf_(bfhi(g.y));
                  v[4] = bflo(a.z) * sigmoidf_(bflo(g.z)); v[5] = bfhi(a.z) * sigmoidf_(bfhi(g.z)); v[6] = bflo(a.w) * sigmoidf_(bflo(g.w)); v[7] = bfhi(a.w) * sigmoidf_(bfhi(g.w));
                  *(LAS f32x4*)(vs + row * 256 + ch8) = (f32x4){v[0], v[1], v[2], v[3]}; *(LAS f32x4*)(vs + row * 256 + ch8 + 4) = (f32x4){v[4], v[5], v[6], v[7]}; } }
          if (tile + C.G < T / 32) MIX1_LOAD(tile + C.G); }
        __syncthreads();
        if (!(SKIP & 2)) { float vv[46];
#pragma unroll
            for (int r = 0; r < 46; ++r) vv[r] = vs[(half * 16 + r) * 256 + c];
#pragma unroll
            for (int i = 0; i < 16; ++i) { float acc = cb;
#pragma unroll
                for (int j = 0; j < 31; ++j) acc += vv[i + j] * wj[j];
                dw[(half * 16 + i) * 256 + c] = acc; } }
        __syncthreads();
        if (!(SKIP & 8)) for (int q = 0; q < 4; ++q) { const int tl = C.wave * 4 + q, ch = C.lane * 4;
            const f32x4 x = *(const LAS f32x4*)(dw + tl * 256 + ch);
            const float mean = wave_sum((x.x + x.y) + (x.z + x.w)) * (1.f / 256.f);
            const f32x4 d = x - mean;
            const float var = wave_sum((d.x * d.x + d.y * d.y) + (d.z * d.z + d.w * d.w)) * (1.f / 256.f);
            const float rstd = rsqrtf(var + EPS);
            const f32x4 g = *(const f32x4*)(WSP(float, WS_PAR) + P_CLNG + l * 256 + ch), b = *(const f32x4*)(WSP(float, WS_PAR) + P_CLNB + l * 256 + ch);
            f32x4 y = d * rstd * g + b;
            y.x *= sigmoidf_(y.x); y.y *= sigmoidf_(y.y); y.z *= sigmoidf_(y.z); y.w *= sigmoidf_(y.w);
            *(u32x2*)(A2 + (size_t)(tok0 + tl) * 512 + 256 + ch) = (u32x2){pk2(y.x, y.y), pk2(y.z, y.w)}; }
        if (!(SKIP & 1)) { const int cp = tid & 127, tg = tid >> 7, g = cp >> 5, tf = s0 + tg * 8; const bf16_t* zc = z + (size_t)(tok0 - s0) * DINP + 2 * cp;
          float u0[23], u1[23];
#pragma unroll
          for (int d = 0; d < 23; ++d) { const int sq = tf - 15 + d; const unsigned wv = (sq >= 0) ? *(const unsigned*)(zc + (size_t)sq * DINP) : 0u; u0[d] = bflo(wv); u1[d] = bfhi(wv); }
          bf16_t* ao = A2 + (size_t)(tok0 - s0 + tf) * 512 + 2 * cp;
#define POOL_W(W) do { _Pragma("unroll") for (int i = 0; i < 8; ++i) { float sa = 0.f, sb = 0.f; _Pragma("unroll") for (int d = 0; d < (W); ++d) { sa += u0[15 + i - d]; sb += u1[15 + i - d]; } \
              const int sq = tf + i; const int cnt = (sq + 1 < (W)) ? (sq + 1) : (W); const float rc = __builtin_amdgcn_rcpf((float)cnt); \
              *(unsigned*)(ao + (size_t)i * 512) = pk2(sa * rc - u0[15 + i], sb * rc - u1[15 + i]); } } while (0)
          if (g == 0) POOL_W(2); else if (g == 1) POOL_W(4); else if (g == 2) POOL_W(8); else POOL_W(16);
#undef POOL_W
        }
        __syncthreads();
    }
#undef MIX1_LOAD
}
__device__ __forceinline__ void ph_smallgemm(const Ctx& C, int l) {
    const bf16_t* z = WSP(bf16_t, WS_Z); const bf16_t* A2 = WSP(bf16_t, WS_A2);
    const bf16_t* Wm = WSP(bf16_t, WS_WMIX) + (size_t)l * 512 * 512; const bf16_t* Wq = WSP(bf16_t, WS_WQ) + (size_t)l * 768 * 256; const bf16_t* Wkv = WSP(bf16_t, WS_WKV) + (size_t)l * 1024 * 256;
    bf16_t* ymix = WSP(bf16_t, WS_YMIX); bf16_t* qraw = WSP(bf16_t, WS_QRAW); bf16_t* kvraw = WSP(bf16_t, WS_KVRAW);
    const float* pwb = WSP(float, WS_PAR) + P_CPWB + l * 256;
    for (int u = C.bid; u < 256 * (4 + 6 + 8); u += C.G) { const int rt = u / 18, q = u % 18;
        if (q < 4) { const int ct = q;
            sg_tile<1>(C, [&](int r) { return A2 + (size_t)(rt * 128 + r) * 512; }, Wm + (size_t)ct * 128 * 512, nullptr, 512,
                       [&](int r, int c, float v, float) { const int col = ct * 128 + c; if (col >= 256) v += pwb[col - 256]; ymix[(size_t)(rt * 128 + r) * 512 + col] = (bf16_t)f2bf(v); });
        } else if (q < 10) { const int ct = q - 4;
            sg_tile<1>(C, [&](int r) { return z + (size_t)(rt * 128 + r) * DINP + 768; }, Wq + (size_t)ct * 128 * 256, nullptr, 256,
                       [&](int r, int c, float v, float) { qraw[(size_t)(rt * 128 + r) * 768 + ct * 128 + c] = (bf16_t)f2bf(v); });
        } else { const int ct = q - 10;
            sg_tile<1>(C, [&](int r) { return z + (size_t)(rt * 128 + r) * DINP + 1024; }, Wkv + (size_t)ct * 128 * 256, nullptr, 256,
                       [&](int r, int c, float v, float) { kvraw[(size_t)(rt * 128 + r) * 1024 + ct * 128 + c] = (bf16_t)f2bf(v); });
        }
    }
}
struct QkIn { u32x2 cq; unsigned ckv; f32x2 cs0, cs1; u32x4 qa; unsigned qp1, qp2; u32x4 ka; unsigned kp1, kp2; u32x4 vv; };
__device__ __forceinline__ QkIn qk_load(const Ctx& C, int t, int lane) {
    const bf16_t* zr = WSP(bf16_t, WS_Z) + (size_t)t * DINP; const int h = lane >> 4, l16 = lane & 15;
    const bf16_t* qr = WSP(bf16_t, WS_QRAW) + (size_t)t * 768 + 192 * h; const bf16_t* kr = WSP(bf16_t, WS_KVRAW) + (size_t)t * 1024 + 256 * h; const f32x2* cs = WSP(f32x2, WS_COS) + (size_t)t * 32 + 2 * l16;
    QkIn r; r.cq = *(const u32x2*)(zr + 768 + 4 * lane); r.ckv = *(const unsigned*)(zr + 1024 + 2 * lane); r.cs0 = cs[0]; r.cs1 = cs[1];
    r.qa = *(const u32x4*)(qr + 8 * l16); r.qp1 = *(const unsigned*)(qr + 128 + 2 * l16); r.qp2 = *(const unsigned*)(qr + 160 + 2 * l16);
    r.ka = *(const u32x4*)(kr + 8 * l16); r.kp1 = *(const unsigned*)(zr + 1152 + 2 * l16); r.kp2 = *(const unsigned*)(zr + 1184 + 2 * l16); r.vv = ATT_PV8 ? (u32x4){0u, 0u, 0u, 0u} : *(const u32x4*)(kr + 128 + 8 * l16);
    return r;
}
template <int SKIP = 0> __device__ __forceinline__ void ph_qkfin(const Ctx& C, int l) {
    bf16_t* Qb = WSP(bf16_t, WS_Q);
    const int lane = C.lane, h = lane >> 4, l16 = lane & 15;
    const float* qg = WSP(float, WS_PAR) + P_QNG + l * 192; const float* kg = WSP(float, WS_PAR) + P_KNG + l * 192;
    float gq[12], gk[12];
#pragma unroll
    for (int i = 0; i < 8; ++i) { gq[i] = qg[8 * l16 + i]; gk[i] = kg[8 * l16 + i]; }
#pragma unroll
    for (int i = 0; i < 2; ++i) { gq[8 + i] = qg[128 + 2 * l16 + i]; gq[10 + i] = qg[160 + 2 * l16 + i]; gk[8 + i] = kg[128 + 2 * l16 + i]; gk[10 + i] = kg[160 + 2 * l16 + i]; }
    const int stride = C.G * NWAVE; int t = C.bid * NWAVE + C.wave;
    if (t >= T) return;
    QkIn cur = qk_load(C, t, lane), cur2 = cur;
    if (t + stride < T) cur2 = qk_load(C, t + stride, lane);
    for (; t < T; t += stride) {
        const QkIn in = cur; cur = cur2;
        if (t + 2 * stride < T) cur2 = qk_load(C, t + 2 * stride, lane);
        float rsq, rskv;
        { const float x0 = bflo(in.cq.x), x1 = bfhi(in.cq.x), x2 = bflo(in.cq.y), x3 = bfhi(in.cq.y);
          rsq = rsqrtf(wave_sum((x0 * x0 + x1 * x1) + (x2 * x2 + x3 * x3)) * (1.f / 256.f) + EPS); }
        { const float x0 = bflo(in.ckv), x1 = bfhi(in.ckv);
          rskv = rsqrtf(wave_sum(x0 * x0 + x1 * x1) * (1.f / 128.f) + EPS); }
        const f32x2 cs0 = in.cs0, cs1 = in.cs1;
        { const u32x4 a = in.qa; const unsigned p1 = in.qp1, p2 = in.qp2;
          float v[12] = {bflo(a.x), bfhi(a.x), bflo(a.y), bfhi(a.y), bflo(a.z), bfhi(a.z), bflo(a.w), bfhi(a.w), bflo(p1), bfhi(p1), bflo(p2), bfhi(p2)};
          float ss = 0.f;
#pragma unroll
          for (int i = 0; i < 12; ++i) { v[i] *= rsq; ss += v[i] * v[i]; }
          const float rh = rsqrtf(grp16_sum(ss) * (1.f / 192.f) + EPS);
#pragma unroll
          for (int i = 0; i < 12; ++i) v[i] *= (ATT_CREF ? rh * (2.f * 0.07216878364870323f * 1.4426950408889634f) : rh) * gq[i];
          const float o10 = v[8] * cs0.x - v[10] * cs0.y, o20 = v[10] * cs0.x + v[8] * cs0.y, o11 = v[9] * cs1.x - v[11] * cs1.y, o21 = v[11] * cs1.x + v[9] * cs1.y;
#if ATT_QK8
          unsigned char* qo = (unsigned char*)Qb + (size_t)t * 768 + 192 * h;
          if (!(SKIP & 4)) { *(u32x2*)(qo + 8 * l16) = (u32x2){pk4_fp8(v[0], v[1], v[2], v[3]), pk4_fp8(v[4], v[5], v[6], v[7])};
              *(unsigned*)(qo + 128 + 4 * l16) = pk4_fp8(o10, o11, o20, o21); } }
#else
          bf16_t* qo = Qb + (size_t)t * 768 + 192 * h;
          if (!(SKIP & 4)) { *(u32x4*)(qo + 8 * l16) = (u32x4){pk2(v[0], v[1]), pk2(v[2], v[3]), pk2(v[4], v[5]), pk2(v[6], v[7])};
              *(u32x2*)(qo + 128 + 4 * l16) = (u32x2){pk2(o10, o11), pk2(o20, o21)}; } }
#endif
        { const u32x4 a = in.ka; const unsigned p1 = in.kp1, p2 = in.kp2;
          float v[12] = {bflo(a.x) * rskv, bfhi(a.x) * rskv, bflo(a.y) * rskv, bfhi(a.y) * rskv, bflo(a.z) * rskv, bfhi(a.z) * rskv, bflo(a.w) * rskv, bfhi(a.w) * rskv, bflo(p1), bfhi(p1), bflo(p2), bfhi(p2)};
          float ss = 0.f;
#pragma unroll
          for (int i = 0; i < 12; ++i) ss += v[i] * v[i];
          const float rh = rsqrtf(grp16_sum(ss) * (1.f / 192.f) + EPS);
#pragma unroll
          for (int i = 0; i < 12; ++i) v[i] *= (ATT_CREF ? 0.5f * rh : rh) * gk[i];
          const float o10 = v[8] * cs0.x - v[10] * cs0.y, o20 = v[10] * cs0.x + v[8] * cs0.y, o11 = v[9] * cs1.x - v[11] * cs1.y, o21 = v[11] * cs1.x + v[9] * cs1.y;
#if ATT_QK8
          unsigned char* ko = C.ws + WS_KIMG + (size_t)t * 768 + 192 * h;
          if (!(SKIP & 1)) { *(u32x2*)(ko + 8 * l16) = (u32x2){pk4_fp8(v[0], v[1], v[2], v[3]), pk4_fp8(v[4], v[5], v[6], v[7])};
              *(unsigned*)(ko + 128 + 4 * l16) = pk4_fp8(o10, o11, o20, o21); }
#else
          bf16_t* ko = WSP(bf16_t, WS_KIMG) + (size_t)t * 768 + 192 * h;
          if (!(SKIP & 1)) { *(u32x4*)(ko + 8 * l16) = (u32x4){pk2(v[0], v[1]), pk2(v[2], v[3]), pk2(v[4], v[5]), pk2(v[6], v[7])};
              *(u32x2*)(ko + 128 + 4 * l16) = (u32x2){pk2(o10, o11), pk2(o20, o21)}; }
#endif
          const u32x4 vv = in.vv;
          if (!(SKIP & 2) && !ATT_PV8) *(u32x4*)(WSP(bf16_t, WS_VIMG) + (size_t)t * 512 + 128 * h + 8 * l16) = (u32x4){pk2(bflo(vv.x) * rskv, bfhi(vv.x) * rskv), pk2(bflo(vv.y) * rskv, bfhi(vv.y) * rskv), pk2(bflo(vv.z) * rskv, bfhi(vv.z) * rskv), pk2(bflo(vv.w) * rskv, bfhi(vv.w) * rskv)}; }
    }
}
#if ATT_PV8
__device__ __forceinline__ void ph_vtbuild(const Ctx& C, int l) {
    const bf16_t* z = WSP(bf16_t, WS_Z); const bf16_t* kv = WSP(bf16_t, WS_KVRAW); unsigned char* vt = C.ws + WS_VIMG;
    LAS unsigned* img = (LAS unsigned*)C.lds;
    LAS float* rsl = (LAS float*)(C.lds + 512 * 68);
    const int tid = C.tid, lane = C.lane, w = C.wave;
    __syncthreads();
    for (int it = C.bid; it < T / 64; it += C.G) { const int tok0 = it * 64;
        { const int tt = tid >> 3, part = tid & 7; const u32x4* cp = (const u32x4*)(z + (size_t)(tok0 + tt) * DINP + 1024 + 16 * part); const u32x4 a = cp[0], b = cp[1];
          float ss = bflo(a.x) * bflo(a.x) + bfhi(a.x) * bfhi(a.x) + bflo(a.y) * bflo(a.y) + bfhi(a.y) * bfhi(a.y) + bflo(a.z) * bflo(a.z) + bfhi(a.z) * bfhi(a.z) + bflo(a.w) * bflo(a.w) + bfhi(a.w) * bfhi(a.w)
                   + bflo(b.x) * bflo(b.x) + bfhi(b.x) * bfhi(b.x) + bflo(b.y) * bflo(b.y) + bfhi(b.y) * bfhi(b.y) + bflo(b.z) * bflo(b.z) + bfhi(b.z) * bfhi(b.z) + bflo(b.w) * bflo(b.w) + bfhi(b.w) * bfhi(b.w);
          ss += DPPF(ss, 0xB1); ss += DPPF(ss, 0x4E); ss += DPPF(ss, 0x141);
          if (part == 0) rsl[tt] = rsqrtf(ss * (1.f / 128.f) + EPS); }
        unsigned u[8][4];
#pragma unroll
        for (int i = 0; i < 8; ++i) { const int pr = w + 8 * i, q = pr >> 2, hh = pr & 3;
#pragma unroll
            for (int k = 0; k < 4; ++k) u[i][k] = *(const unsigned*)(kv + (size_t)(tok0 + 4 * q + k) * 1024 + 256 * hh + 128 + 2 * lane); }
        __syncthreads();
#pragma unroll
        for (int i = 0; i < 8; ++i) { const int pr = w + 8 * i, q = pr >> 2, hh = pr & 3; const f32x4 rs = *(const LAS f32x4*)(rsl + 4 * q);
            img[(hh * 128 + 2 * lane) * 17 + q] = pk4_fp8(bflo(u[i][0]) * rs.x, bflo(u[i][1]) * rs.y, bflo(u[i][2]) * rs.z, bflo(u[i][3]) * rs.w);
            img[(hh * 128 + 2 * lane + 1) * 17 + q] = pk4_fp8(bfhi(u[i][0]) * rs.x, bfhi(u[i][1]) * rs.y, bfhi(u[i][2]) * rs.z, bfhi(u[i][3]) * rs.w); }
        __syncthreads();
#pragma unroll
        for (int k = 0; k < 4; ++k) { const int c = tid + 512 * k, row = c >> 2, pt = c & 3; const LAS unsigned* sp = img + row * 17 + 4 * pt;
            *(u32x4*)(vt + (size_t)it * 32768 + (size_t)c * 16) = (u32x4){sp[0], sp[1], sp[2], sp[3]}; }
        __syncthreads();
    }
}
#endif
typedef float f32x16 __attribute__((ext_vector_type(16)));
typedef short s16x4 __attribute__((ext_vector_type(4)));
constexpr int AT_KB = ATT_QK8 ? 12288 : 24576, AT_VB = ATT_PV8 ? 8192 : 16384, AT_NS = ATT_PV8 ? 5 : 3;
constexpr int AT_K = 0, AT_V = AT_NS * AT_KB, AT_WS = AT_V + AT_NS * AT_VB;
constexpr float AT_SCALE = 0.07216878364870323f;
constexpr float AT_THR = 8.f;
#define SBAR() __builtin_amdgcn_sched_barrier(0)
__device__ __forceinline__ int crow(int r, int hi) { return (r & 3) + 8 * (r >> 2) + 4 * hi; }
__device__ __forceinline__ unsigned cvtpk(float lo, float hi) { unsigned r; asm volatile("v_cvt_pk_bf16_f32 %0, %1, %2" : "=v"(r) : "v"(lo), "v"(hi)); return r; }
__device__ __forceinline__ void glds16(const void* sbase, unsigned voff, unsigned lds_dst) { unsigned keep;
    asm volatile("s_mov_b32 %0, m0\n\ts_mov_b32 m0, %3\n\ts_nop 0\n\tglobal_load_lds_dwordx4 %1, %2\n\ts_mov_b32 m0, %0" : "=&s"(keep) : "v"(voff), "s"(sbase), "s"(lds_dst) : "memory"); }
__device__ __forceinline__ const unsigned char* uniform_ptr(const unsigned char* p) { const unsigned long long v = (unsigned long long)p;
    const unsigned lo = __builtin_amdgcn_readfirstlane((unsigned)v), hi = __builtin_amdgcn_readfirstlane((unsigned)(v >> 32)); return (const unsigned char*)(((unsigned long long)hi << 32) | lo); }
__device__ __forceinline__ void at_partialSM(f32x16& p0, f32x16& p1, float& m_reg, float& mn, float& alpha, bool masked = false) {
    constexpr float Cc = AT_SCALE * 1.4426950408889634f;
    float pmax = p0[0];
#pragma unroll
    for (int r = 1; r < 16; ++r) pmax = fmaxf(pmax, p0[r]);
#pragma unroll
    for (int r = 0; r < 16; ++r) pmax = fmaxf(pmax, p1[r]);
    { auto rr = __builtin_amdgcn_permlane32_swap(__float_as_uint(pmax), __float_as_uint(pmax), false, false);
      pmax = fmaxf(__uint_as_float(rr[0]), __uint_as_float(rr[1])); }
    if (masked) pmax = -1e30f;
    if (__builtin_expect(__all(pmax - m_reg <= AT_THR / AT_SCALE), 1)) { mn = m_reg; alpha = 1.f; }
    else { mn = fmaxf(m_reg, pmax); alpha = __builtin_amdgcn_exp2f((m_reg - mn) * Cc); m_reg = mn; }
    const float mnC = masked ? -1e30f : -mn * Cc + (ATT_PV8 ? 4.f : 0.f);
#pragma unroll
    for (int r = 0; r < 16; ++r) p0[r] = fmaf(p0[r], Cc, mnC);
#pragma unroll
    for (int r = 0; r < 16; ++r) p1[r] = fmaf(p1[r], Cc, mnC);
#pragma unroll
    for (int r = 0; r < 16; ++r) p0[r] = __builtin_amdgcn_exp2f(p0[r]);
}
__device__ __forceinline__ void at_finishSM(f32x16& p0, f32x16& p1, float alpha, float& l_reg, bf16x8& pa0, bf16x8& pa1, bf16x8& pa2, bf16x8& pa3) {
#pragma unroll
    for (int r = 0; r < 16; ++r) p1[r] = __builtin_amdgcn_exp2f(p1[r]);
    float ps = 0.f;
#pragma unroll
    for (int r = 0; r < 16; ++r) ps += p0[r];
#pragma unroll
    for (int r = 0; r < 16; ++r) ps += p1[r];
    { auto rr = __builtin_amdgcn_permlane32_swap(__float_as_uint(ps), __float_as_uint(ps), false, false);
      ps = __uint_as_float(rr[0]) + __uint_as_float(rr[1]); }
    l_reg = l_reg * alpha + ps;
#define PK4(P, BASE, OUT) do { unsigned a0 = cvtpk(P[BASE + 0], P[BASE + 1]), a1 = cvtpk(P[BASE + 2], P[BASE + 3]);   \
    unsigned b0 = cvtpk(P[BASE + 4], P[BASE + 5]), b1 = cvtpk(P[BASE + 6], P[BASE + 7]);                              \
    auto r0 = __builtin_amdgcn_permlane32_swap(a0, b0, false, false); auto r1 = __builtin_amdgcn_permlane32_swap(a1, b1, false, false); \
    u32x4 w = {r0[0], r1[0], r0[1], r1[1]}; OUT = __builtin_bit_cast(bf16x8, w); } while (0)
    PK4(p0, 0, pa0); PK4(p0, 8, pa1); PK4(p1, 0, pa2); PK4(p1, 8, pa3);
#undef PK4
}
__device__ __forceinline__ void at_qkt(f32x16& p0, f32x16& p1, const LAS char* ks, const int (&kro)[4], const bf16x8* qr) {
    p0 = f32x16{}; p1 = f32x16{};
#pragma unroll
    for (int d0 = 0; d0 < 12; ++d0) {
        const bf16x8 b0 = *(const LAS bf16x8*)(ks + kro[d0 & 3] + 128 * (d0 >> 2));
        const bf16x8 b1 = *(const LAS bf16x8*)(ks + kro[d0 & 3] + 128 * (d0 >> 2) + 12288);
        p0 = __builtin_amdgcn_mfma_f32_32x32x16_bf16(b0, qr[d0], p0, 0, 0, 0);
        p1 = __builtin_amdgcn_mfma_f32_32x32x16_bf16(b1, qr[d0], p1, 0, 0, 0); }
}
#if ATT_QK8
typedef int at_v8i __attribute__((ext_vector_type(8)));
__device__ __forceinline__ at_v8i at_cat8(u32x4 lo, u32x4 hi) { return (at_v8i){(int)lo.x, (int)lo.y, (int)lo.z, (int)lo.w, (int)hi.x, (int)hi.y, (int)hi.z, (int)hi.w}; }
__device__ __forceinline__ void at_qkt8(f32x16& p0, f32x16& p1, const LAS char* ks, int kb0, int kb1, const at_v8i* qf) {
    p0 = f32x16{}; p1 = f32x16{};
#pragma unroll
    for (int s = 0; s < 3; ++s) {
        const u32x4 a0 = *(const LAS u32x4*)(ks + kb0 + 64 * s), a1 = *(const LAS u32x4*)(ks + kb1 + 64 * s);
        const u32x4 b0 = *(const LAS u32x4*)(ks + kb0 + 64 * s + 6144), b1 = *(const LAS u32x4*)(ks + kb1 + 64 * s + 6144);
        p0 = __builtin_amdgcn_mfma_scale_f32_32x32x64_f8f6f4(at_cat8(a0, a1), qf[s], p0, 0, 0, 0, 0, 0, 0);
        p1 = __builtin_amdgcn_mfma_scale_f32_32x32x64_f8f6f4(at_cat8(b0, b1), qf[s], p1, 0, 0, 0, 0, 0, 0); }
}
#endif
#if ATT_PV8
__device__ __forceinline__ unsigned pk4_bf8(float a, float b, float c, float d) { unsigned w = __float_as_uint(a);   w = __builtin_amdgcn_cvt_pk_bf8_f32(a, b, w, false); w = __builtin_amdgcn_cvt_pk_bf8_f32(c, d, w, true); return w; }
__device__ __forceinline__ void at_packP8(const f32x16& p0, const f32x16& p1, at_v8i& PA) {
#pragma unroll
    for (int g = 0; g < 4; ++g) { const unsigned a = pk4_bf8(p0[4 * g], p0[4 * g + 1], p0[4 * g + 2], p0[4 * g + 3]), b = pk4_bf8(p1[4 * g], p1[4 * g + 1], p1[4 * g + 2], p1[4 * g + 3]);
        auto r = __builtin_amdgcn_permlane32_swap(a, b, false, false); PA[2 * g] = (int)r[0]; PA[2 * g + 1] = (int)r[1]; }
}
__device__ __forceinline__ void at_finishSM8(f32x16& p0, f32x16& p1, float alpha, float& l_reg, at_v8i& PA) {
#pragma unroll
    for (int r = 0; r < 16; ++r) p1[r] = __builtin_amdgcn_exp2f(p1[r]);
    float ps = 0.f;
#pragma unroll
    for (int r = 0; r < 16; ++r) ps += p0[r];
#pragma unroll
    for (int r = 0; r < 16; ++r) ps += p1[r];
    { auto rr = __builtin_amdgcn_permlane32_swap(__float_as_uint(ps), __float_as_uint(ps), false, false);
      ps = __uint_as_float(rr[0]) + __uint_as_float(rr[1]); }
    l_reg = l_reg * alpha + ps;
    at_packP8(p0, p1, PA);
}
__device__ __forceinline__ void pv8(f32x16* o, const LAS char* vs, int vk0, int vk1, const at_v8i& PA) {
#define PV8_RD(D0, N) const u32x4 N##a = *(const LAS u32x4*)(vs + vk0 + 2048 * (D0)), N##b = *(const LAS u32x4*)(vs + vk1 + 2048 * (D0))
#define PV8_MM(D0, N) o[D0] = __builtin_amdgcn_mfma_scale_f32_32x32x64_f8f6f4(PA, at_cat8(N##a, N##b), o[D0], 1, 0, 0, 0, 0, 0)
    PV8_RD(0, f0); PV8_RD(1, f1);
    asm volatile("s_waitcnt lgkmcnt(2)" ::: "memory"); __builtin_amdgcn_sched_barrier(0); PV8_MM(0, f0);
    PV8_RD(2, f2);
    asm volatile("s_waitcnt lgkmcnt(2)" ::: "memory"); __builtin_amdgcn_sched_barrier(0); PV8_MM(1, f1);
    PV8_RD(3, f3);
    asm volatile("s_waitcnt lgkmcnt(2)" ::: "memory"); __builtin_amdgcn_sched_barrier(0); PV8_MM(2, f2);
    asm volatile("s_waitcnt lgkmcnt(0)" ::: "memory"); __builtin_amdgcn_sched_barrier(0); PV8_MM(3, f3);
#undef PV8_RD
#undef PV8_MM
}
#if ATT_CREF
__device__ __forceinline__ f32x16 at_mfma8_c(at_v8i a, at_v8i b, const f32x16& c) { f32x16 d; asm volatile("s_nop 1\n\tv_mfma_f32_32x32x64_f8f6f4 %0, %1, %2, %3" : "=&v"(d) : "v"(a), "v"(b), "v"(c)); return d; }
__device__ __forceinline__ void at_qkt8c(f32x16& p0, f32x16& p1, const LAS char* ks, int kb0, int kb1, const at_v8i* qf, const f32x16& cinit) {
    { const u32x4 a0 = *(const LAS u32x4*)(ks + kb0), a1 = *(const LAS u32x4*)(ks + kb1);
      const u32x4 b0 = *(const LAS u32x4*)(ks + kb0 + 6144), b1 = *(const LAS u32x4*)(ks + kb1 + 6144);
      p0 = at_mfma8_c(at_cat8(a0, a1), qf[0], cinit); p1 = at_mfma8_c(at_cat8(b0, b1), qf[0], cinit); }
#pragma unroll
    for (int s = 1; s < 3; ++s) {
        const u32x4 a0 = *(const LAS u32x4*)(ks + kb0 + 64 * s), a1 = *(const LAS u32x4*)(ks + kb1 + 64 * s);
        const u32x4 b0 = *(const LAS u32x4*)(ks + kb0 + 64 * s + 6144), b1 = *(const LAS u32x4*)(ks + kb1 + 64 * s + 6144);
        p0 = __builtin_amdgcn_mfma_scale_f32_32x32x64_f8f6f4(at_cat8(a0, a1), qf[s], p0, 0, 0, 0, 0, 0, 0);
        p1 = __builtin_amdgcn_mfma_scale_f32_32x32x64_f8f6f4(at_cat8(b0, b1), qf[s], p1, 0, 0, 0, 0, 0, 0); }
}
template <bool FIRST> __device__ __forceinline__ void at_partialSMc(f32x16& p0, f32x16& p1, float& cval, f32x16& cinit, float& alpha) {
    constexpr float THR2 = AT_THR * 1.4426950408889634f;
    float pmax = p0[0];
#pragma unroll
    for (int r = 1; r < 16; ++r) pmax = fmaxf(pmax, p0[r]);
#pragma unroll
    for (int r = 0; r < 16; ++r) pmax = fmaxf(pmax, p1[r]);
    { auto rr = __builtin_amdgcn_permlane32_swap(__float_as_uint(pmax), __float_as_uint(pmax), false, false);
      pmax = fmaxf(__uint_as_float(rr[0]), __uint_as_float(rr[1])); }
    const float d = pmax - 4.f;
    if (FIRST || !__builtin_expect(__all(d <= THR2), 1)) { const float dd = FIRST ? d : fmaxf(d, 0.f); alpha = FIRST ? 1.f : __builtin_amdgcn_exp2f(-dd); cval -= dd;
#pragma unroll
        for (int r = 0; r < 16; ++r) { p0[r] -= dd; p1[r] -= dd; cinit[r] = cval; } }
    else alpha = 1.f;
#pragma unroll
    for (int r = 0; r < 16; ++r) p0[r] = __builtin_amdgcn_exp2f(p0[r]);
}
#endif
#endif
__device__ __forceinline__ int v_rd_base(int lane) { return ((lane & 3) << 3) | (((lane >> 2) & 3) << 6) | (((lane >> 4) & 1) << 5) | (((lane >> 5) & 1) << 8); }
constexpr int v_rd_off(int d0, int ks, int half) { return d0 * 512 + ks * 4096 + half * 2048; }
template <int OFF> __device__ __forceinline__ s16x4 tr_read(int vb) { s16x4 r; asm volatile("ds_read_b64_tr_b16 %0, %1 offset:%2" : "=&v"(r) : "v"(vb), "i"(OFF) : "memory"); return r; }
template <int D0> __device__ __forceinline__ void pv_one(f32x16& od, int vb, bf16x8 pa0, bf16x8 pa1, bf16x8 pa2, bf16x8 pa3) {
    const s16x4 l0 = tr_read<v_rd_off(D0, 0, 0)>(vb), h0 = tr_read<v_rd_off(D0, 0, 1)>(vb), l1 = tr_read<v_rd_off(D0, 1, 0)>(vb), h1 = tr_read<v_rd_off(D0, 1, 1)>(vb);
    const s16x4 l2 = tr_read<v_rd_off(D0, 2, 0)>(vb), h2 = tr_read<v_rd_off(D0, 2, 1)>(vb), l3 = tr_read<v_rd_off(D0, 3, 0)>(vb), h3 = tr_read<v_rd_off(D0, 3, 1)>(vb);
    asm volatile("s_waitcnt lgkmcnt(0)" ::: "memory"); SBAR();
#define PKV(L, H) (bf16x8){L[0], L[1], L[2], L[3], H[0], H[1], H[2], H[3]}
    od = __builtin_amdgcn_mfma_f32_32x32x16_bf16(pa0, PKV(l0, h0), od, 0, 0, 0);
    od = __builtin_amdgcn_mfma_f32_32x32x16_bf16(pa1, PKV(l1, h1), od, 0, 0, 0);
    od = __builtin_amdgcn_mfma_f32_32x32x16_bf16(pa2, PKV(l2, h2), od, 0, 0, 0);
    od = __builtin_amdgcn_mfma_f32_32x32x16_bf16(pa3, PKV(l3, h3), od, 0, 0, 0);
#undef PKV
}
#if PV_PIPE
__device__ __forceinline__ void pv_d0(f32x16* o, int vb, bf16x8 pa0, bf16x8 pa1, bf16x8 pa2, bf16x8 pa3) {
#define TRSET(D0, N) const s16x4 N##0 = tr_read<v_rd_off(D0, 0, 0)>(vb), N##1 = tr_read<v_rd_off(D0, 0, 1)>(vb), N##2 = tr_read<v_rd_off(D0, 1, 0)>(vb), N##3 = tr_read<v_rd_off(D0, 1, 1)>(vb), \
                                   N##4 = tr_read<v_rd_off(D0, 2, 0)>(vb), N##5 = tr_read<v_rd_off(D0, 2, 1)>(vb), N##6 = tr_read<v_rd_off(D0, 3, 0)>(vb), N##7 = tr_read<v_rd_off(D0, 3, 1)>(vb)
#define PKV(L, H) (bf16x8){L[0], L[1], L[2], L[3], H[0], H[1], H[2], H[3]}
#define PVM(OD, N) do { OD = __builtin_amdgcn_mfma_f32_32x32x16_bf16(pa0, PKV(N##0, N##1), OD, 0, 0, 0); OD = __builtin_amdgcn_mfma_f32_32x32x16_bf16(pa1, PKV(N##2, N##3), OD, 0, 0, 0); \
                        OD = __builtin_amdgcn_mfma_f32_32x32x16_bf16(pa2, PKV(N##4, N##5), OD, 0, 0, 0); OD = __builtin_amdgcn_mfma_f32_32x32x16_bf16(pa3, PKV(N##6, N##7), OD, 0, 0, 0); } while (0)
    TRSET(0, a); TRSET(1, b);
    asm volatile("s_waitcnt lgkmcnt(8)" ::: "memory"); SBAR(); PVM(o[0], a);
    TRSET(2, c);
    asm volatile("s_waitcnt lgkmcnt(8)" ::: "memory"); SBAR(); PVM(o[1], b);
    TRSET(3, d);
    asm volatile("s_waitcnt lgkmcnt(8)" ::: "memory"); SBAR(); PVM(o[2], c);
    asm volatile("s_waitcnt lgkmcnt(0)" ::: "memory"); SBAR(); PVM(o[3], d);
#undef TRSET
#undef PKV
#undef PVM
}
#else
__device__ __forceinline__ void pv_d0(f32x16* o, int vb, bf16x8 pa0, bf16x8 pa1, bf16x8 pa2, bf16x8 pa3) {
    pv_one<0>(o[0], vb, pa0, pa1, pa2, pa3); pv_one<1>(o[1], vb, pa0, pa1, pa2, pa3); pv_one<2>(o[2], vb, pa0, pa1, pa2, pa3); pv_one<3>(o[3], vb, pa0, pa1, pa2, pa3);
}
#endif
#define AT_WAITBAR(N) asm volatile("s_waitcnt vmcnt(" #N ") lgkmcnt(0)\n\ts_barrier" ::: "memory")
#define AT_WAITBAR_N(N) AT_WAITBAR(N)

__device__ __forceinline__ void attn_unit(const Ctx& C, int b, int h, int qb) {
    const bf16_t* Qb = WSP(bf16_t, WS_Q); float* ya = WSP(float, WS_YATT);
    const int lane = C.lane, wid = C.wave, r32 = lane & 31, hi = lane >> 5;
    const int rowbase = b * SEQ, q0 = qb * 256;
    const unsigned lds0 = (unsigned)(uintptr_t)C.lds;
    LAS float* wsf = (LAS float*)(C.lds + AT_WS) + wid * 64; LAS float* li_l = wsf; LAS float* al_l = wsf + 32;
    const unsigned char* kimg = uniform_ptr(C.ws + WS_KIMG + ((size_t)rowbase * 768 + h * 192) * (ATT_QK8 ? 1 : 2));
#if ATT_PV8
    const unsigned char* vimg = uniform_ptr(C.ws + WS_VIMG + ((size_t)(rowbase / 64) * 4 + h) * 8192);
#else
    const unsigned char* vimg = uniform_ptr(C.ws + WS_VIMG + ((size_t)rowbase * 512 + h * 128) * 2);
#endif
#if ATT_QK8
    unsigned kvoff[2];
#pragma unroll
    for (int i = 0; i < 2; ++i) { const int q = 64 * (wid + 8 * i) + lane, row = q / 12, cp = q % 12, c = (cp & ~3) | ((cp & 3) ^ ((row >> 2) & 3)); kvoff[i] = (unsigned)(row * 768 + c * 16); }
#else
    unsigned kvoff[3];
#pragma unroll
    for (int i = 0; i < 3; ++i) { const int q = 64 * (wid + 8 * i) + lane, row = q / 24, cp = q % 24, c = (cp & ~7) | ((cp & 7) ^ ((row >> 1) & 7)); kvoff[i] = (unsigned)(row * 1536 + c * 16); }
#endif
#if ATT_PV8
    unsigned vvoff[1];
    { const int q = 64 * wid + lane, row = q >> 2, cp = q & 3; vvoff[0] = (unsigned)(row * 64 + ((cp ^ ((row >> 2) & 3)) * 16)); }
#else
    unsigned vvoff[2];
#pragma unroll
    for (int j = 0; j < 2; ++j) { const int P = wid + 8 * j, sub = 2 * P + (lane >> 5), kk = (sub >> 2) * 8 + ((lane & 31) >> 2), k = (kk & ~0xC) | ((kk & 4) << 1) | ((kk & 8) >> 1), col = (sub & 3) * 32 + (lane & 3) * 8;
        vvoff[j] = (unsigned)(k * 1024 + col * 2); }
#endif
    const unsigned kdst = lds0 + AT_K + wid * 1024, vdst = lds0 + AT_V + wid * 1024;
#if ATT_PV8
#define AT_DMA(t, slot) do { const unsigned char* ks_ = kimg + (size_t)(t) * (64 * 768); const unsigned char* vs_ = vimg + (size_t)(t) * 32768; \
        const unsigned kd_ = (unsigned)__builtin_amdgcn_readfirstlane(kdst + (slot) * AT_KB), vd_ = (unsigned)__builtin_amdgcn_readfirstlane(vdst + (slot) * AT_VB); \
        glds16(vs_, vvoff[0], vd_); glds16(ks_, kvoff[0], kd_); if (wid < 4) glds16(ks_, kvoff[1], kd_ + 8192); } while (0)
#define AT_NDMA 2
#elif ATT_QK8
#define AT_DMA(t, slot) do { const unsigned char* ks_ = kimg + (size_t)(t) * (64 * 768); const unsigned char* vs_ = vimg + (size_t)(t) * (64 * 1024); \
        const unsigned kd_ = (unsigned)__builtin_amdgcn_readfirstlane(kdst + (slot) * AT_KB), vd_ = (unsigned)__builtin_amdgcn_readfirstlane(vdst + (slot) * AT_VB); \
        glds16(vs_, vvoff[0], vd_); glds16(vs_, vvoff[1], vd_ + 8192); glds16(ks_, kvoff[0], kd_); if (wid < 4) glds16(ks_, kvoff[1], kd_ + 8192); } while (0)
#define AT_NDMA 3
#else
#define AT_DMA(t, slot) do { const unsigned char* ks_ = kimg + (size_t)(t) * (64 * 1536); const unsigned char* vs_ = vimg + (size_t)(t) * (64 * 1024); \
        const unsigned kd_ = (unsigned)__builtin_amdgcn_readfirstlane(kdst + (slot) * AT_KB), vd_ = (unsigned)__builtin_amdgcn_readfirstlane(vdst + (slot) * AT_VB); \
        glds16(ks_, kvoff[0], kd_); glds16(ks_, kvoff[1], kd_ + 8192); glds16(ks_, kvoff[2], kd_ + 16384); glds16(vs_, vvoff[0], vd_); glds16(vs_, vvoff[1], vd_ + 8192); } while (0)
#define AT_NDMA 5
#endif
    const int NT = 4 * qb + 4, jlim = 4 * qb + (wid >> 1);
#if ATT_QK8
    at_v8i qf[3];
    { const unsigned char* Qw = (const unsigned char*)Qb + (size_t)(rowbase + q0 + wid * 32 + r32) * 768 + h * 192 + hi * 32;
#pragma unroll
      for (int s = 0; s < 3; ++s) qf[s] = at_cat8(*(const u32x4*)(Qw + 64 * s), *(const u32x4*)(Qw + 64 * s + 16)); }
    const int kb0 = r32 * 192 + 16 * ((2 * hi) ^ ((r32 >> 2) & 3)), kb1 = kb0 ^ 16;
#define AT_QKT(C0, C1, KS) at_qkt8(C0, C1, KS, kb0, kb1, qf)
#else
    bf16x8 qr[12];
    { const bf16_t* Qw = Qb + (size_t)(rowbase + q0 + wid * 32 + r32) * 768 + h * 192 + hi * 8;
#pragma unroll
      for (int d0 = 0; d0 < 12; ++d0) qr[d0] = *(const bf16x8*)(Qw + d0 * 16); }
#define AT_QKT(C0, C1, KS) at_qkt(C0, C1, KS, kro, qr)
#endif
    AT_DMA(0, 0); AT_DMA(1, 1);
    const LAS char* kp0 = (const LAS char*)C.lds + AT_K;
#if !ATT_QK8
    int kro[4];
#pragma unroll
    for (int j = 0; j < 4; ++j) kro[j] = r32 * 384 + 16 * ((2 * j + hi) ^ ((r32 >> 1) & 7));
#endif
    float m_reg = -1e30f, l_reg = 0.f; f32x16 o[4] = {};
    f32x16 pA0, pA1, pB0, pB1; float mnA, mnB, alA, alB;
#if ATT_PV8
    const LAS char* vp0 = (const LAS char*)C.lds + AT_V; const int vk0 = r32 * 64 + 16 * ((2 * hi) ^ ((r32 >> 2) & 3)), vk1 = vk0 ^ 16;
    at_v8i PA;
#define AT_FIN(P0, P1, ALP) at_finishSM8(P0, P1, ALP, l_reg, PA)
#define AT_PV(SLOT) pv8(o, vp0 + (SLOT) * AT_VB, vk0, vk1, PA)
#else
    const int vb0 = (int)(lds0 + AT_V) + v_rd_base(lane);
    bf16x8 pa0, pa1, pa2, pa3;
#define AT_FIN(P0, P1, ALP) at_finishSM(P0, P1, ALP, l_reg, pa0, pa1, pa2, pa3)
#define AT_PV(SLOT) pv_d0(o, vb0 + (SLOT) * AT_VB, pa0, pa1, pa2, pa3)
#endif
#define AT_RESC(a) do { if (__any((a) < 1.f)) { if (hi == 0) al_l[r32] = (a); asm volatile("s_waitcnt lgkmcnt(0)" ::: "memory"); \
        _Pragma("unroll") for (int d = 0; d < 4; ++d) _Pragma("unroll") for (int r = 0; r < 16; ++r) o[d][r] *= al_l[crow(r, hi)]; } } while (0)
#define AT_MASKED(P0, P1) do { _Pragma("unroll") for (int r = 0; r < 16; ++r) { P0[r] = -1e30f; P1[r] = -1e30f; } } while (0)
#if ATT_PV8
#define AT_W_FIRST() do { if (wid < 4) AT_WAITBAR(9); else AT_WAITBAR(6); } while (0)
#define AT_W_STEADY() do { if (wid < 4) AT_WAITBAR(6); else AT_WAITBAR(4); } while (0)
#define AT_STEP(C0, C1, MNC, ALC, P0, P1, ALP, j) do { const int sj_ = (j) % 5, sp_ = ((j) + 4) % 5; \
        SBAR(); AT_SCORE(C0, C1, kp0 + sj_ * AT_KB, j);    \
        AT_FIN(P0, P1, ALP); SBAR(); \
        if ((j) - 1 <= jlim) AT_PV(sp_); \
        AT_PART(C0, C1, MNC, ALC, j); \
        if ((j) + 3 < NT) AT_W_STEADY(); else AT_WAITBAR(0); \
        if ((j) + 4 < NT) AT_DMA((j) + 4, sp_); \
        AT_RESC(ALC); } while (0)
#if ATT_CREF
    float cval = 4.f; f32x16 cinit;
#pragma unroll
    for (int r = 0; r < 16; ++r) cinit[r] = 4.f;
#define AT_SCORE(C0, C1, KS, j) do { if ((j) == jlim + 1) { asm volatile("" ::: "memory"); _Pragma("unroll") for (int r = 0; r < 16; ++r) cinit[r] = -1e30f; } at_qkt8c(C0, C1, KS, kb0, kb1, qf, cinit); } while (0)
#define AT_PART(C0, C1, MNC, ALC, j) at_partialSMc<false>(C0, C1, cval, cinit, ALC)
#else
#define AT_SCORE(C0, C1, KS, j) AT_QKT(C0, C1, KS)
#define AT_PART(C0, C1, MNC, ALC, j) at_partialSM(C0, C1, m_reg, MNC, ALC, (j) > jlim)
#endif
    AT_DMA(2, 2); AT_DMA(3, 3);
    AT_W_FIRST();
#if ATT_CREF
    at_qkt8c(pA0, pA1, kp0, kb0, kb1, qf, cinit); at_partialSMc<true>(pA0, pA1, cval, cinit, alA);
#else
    AT_QKT(pA0, pA1, kp0); at_partialSM(pA0, pA1, m_reg, mnA, alA);
#endif
    AT_W_STEADY();
    if (4 < NT) AT_DMA(4, 4);
    AT_RESC(alA);
    for (int j = 1; j + 1 < NT; j += 2) {
        AT_STEP(pB0, pB1, mnB, alB, pA0, pA1, alA, j);
        AT_STEP(pA0, pA1, mnA, alA, pB0, pB1, alB, j + 1);
    }
    AT_STEP(pB0, pB1, mnB, alB, pA0, pA1, alA, NT - 1);
    AT_FIN(pB0, pB1, alB); SBAR();
    if (NT - 1 <= jlim) AT_PV((NT - 1) % 5);
#undef AT_W_FIRST
#undef AT_W_STEADY
#undef AT_SCORE
#undef AT_PART
#else
#define AT_STEP(C0, C1, MNC, ALC, P0, P1, ALP, j) do { const int sj_ = (j) % 3, sp_ = ((j) + 2) % 3; \
        SBAR(); if ((j) <= jlim) AT_QKT(C0, C1, kp0 + sj_ * AT_KB); else AT_MASKED(C0, C1); \
        AT_FIN(P0, P1, ALP); SBAR(); \
        if ((j) - 1 <= jlim) AT_PV(sp_); \
        at_partialSM(C0, C1, m_reg, MNC, ALC); \
        AT_WAITBAR(0); \
        if ((j) + 2 < NT) AT_DMA((j) + 2, sp_); \
        AT_RESC(ALC); } while (0)
    AT_WAITBAR_N(AT_NDMA);
    AT_QKT(pA0, pA1, kp0); at_partialSM(pA0, pA1, m_reg, mnA, alA);
    AT_DMA(2, 2);
    AT_WAITBAR_N(AT_NDMA);
    AT_RESC(alA);
    for (int j = 1; j + 1 < NT; j += 2) {
        AT_STEP(pB0, pB1, mnB, alB, pA0, pA1, alA, j);
        AT_STEP(pA0, pA1, mnA, alA, pB0, pB1, alB, j + 1);
    }
    AT_STEP(pB0, pB1, mnB, alB, pA0, pA1, alA, NT - 1);
    AT_FIN(pB0, pB1, alB); SBAR();
    if (NT - 1 <= jlim) AT_PV((NT - 1) % 3);
#endif
    if (hi == 0) li_l[r32] = l_reg;
    asm volatile("s_waitcnt lgkmcnt(0)" ::: "memory");
    float rli[16];
#pragma unroll
    for (int r = 0; r < 16; ++r) rli[r] = __builtin_amdgcn_rcpf(li_l[crow(r, hi)]);
#if YATT_BF16
    { bf16_t* Ob = (bf16_t*)ya + (size_t)(rowbase + q0 + wid * 32) * 512 + h * 128 + (r32 & ~1); const bool odd = (lane & 1) != 0;
#pragma unroll
      for (int k = 0; k < 8; ++k) { const int orow = crow(2 * k + (odd ? 1 : 0), hi);
#pragma unroll
          for (int d0 = 0; d0 < 4; ++d0) { const float ve = o[d0][2 * k] * rli[2 * k], vo = o[d0][2 * k + 1] * rli[2 * k + 1];
              const float got = DPPF(odd ? ve : vo, 0xB1);
              *(unsigned*)(Ob + (size_t)orow * 512 + d0 * 32) = odd ? pk2(got, vo) : pk2(ve, got); } } }
#else
    float* Ow = ya + (size_t)(rowbase + q0 + wid * 32) * 512 + h * 128;
#pragma unroll
    for (int r = 0; r < 16; ++r) { const int orow = crow(r, hi);
#pragma unroll
        for (int d0 = 0; d0 < 4; ++d0) Ow[(size_t)orow * 512 + d0 * 32 + r32] = o[d0][r] * rli[r]; }
#endif
    AT_WAITBAR(0);
#undef AT_FIN
#undef AT_PV
#undef AT_DMA
#undef AT_NDMA
#undef AT_QKT
#undef AT_RESC
#undef AT_MASKED
#undef AT_STEP
}
__device__ __forceinline__ void ph_attn(const Ctx& C, int l) {
    const int vcu = (C.G % 8 == 0) ? (C.bid % 8) * (C.G / 8) + C.bid / 8 : C.bid;
    for (int p = vcu; p < 256; p += C.G) { const int bh = p >> 3, s = p & 7;
        for (int u = 0; u < 2; ++u) attn_unit(C, bh >> 2, bh & 3, u ? s : 15 - s); }
}
#if YATT_BF16 && DENSE_I8 && !OUTPROJ_FP8
struct MnIn { u32x2 p, q; u32x4 a; };
__device__ __forceinline__ void ph_mixnorm(const Ctx& C, int l) {
    const bf16_t* ymix = WSP(bf16_t, WS_YMIX); const bf16_t* ya = (const bf16_t*)WSP(float, WS_YATT);
    const int lane = C.lane, stride = C.G * NWAVE; int t = C.bid * NWAVE + C.wave;
    if (t >= T) return;
#define MN_LD(S, TT) do { const size_t tt_ = (size_t)(TT); S.p = *(const u32x2*)(ymix + tt_ * 512 + 4 * lane); S.q = *(const u32x2*)(ymix + tt_ * 512 + 256 + 4 * lane); S.a = *(const u32x4*)(ya + tt_ * 512 + 8 * lane); } while (0)
#define MN_BODY(S, TT, TNEXT) do { const int tc_ = (TT); \
        const float p0 = bflo(S.p.x), p1 = bfhi(S.p.x), p2 = bflo(S.p.y), p3 = bfhi(S.p.y), q0 = bflo(S.q.x), q1 = bfhi(S.q.x), q2 = bflo(S.q.y), q3 = bfhi(S.q.y); \
        const f32x4 a0 = (f32x4){bflo(S.a.x), bfhi(S.a.x), bflo(S.a.y), bfhi(S.a.y)}, a1 = (f32x4){bflo(S.a.z), bfhi(S.a.z), bflo(S.a.w), bfhi(S.a.w)}; \
        if ((TNEXT) < T) MN_LD(S, TNEXT); \
        const float rp = rsqrtf(wave_sum((p0 * p0 + p1 * p1) + (p2 * p2 + p3 * p3)) * (1.f / 256.f) + EPS); \
        const float rq = rsqrtf(wave_sum((q0 * q0 + q1 * q1) + (q2 * q2 + q3 * q3)) * (1.f / 256.f) + EPS); \
        const float ra = rsqrtf(wave_sum((a0.x * a0.x + a0.y * a0.y) + (a0.z * a0.z + a0.w * a0.w) + (a1.x * a1.x + a1.y * a1.y) + (a1.z * a1.z + a1.w * a1.w)) * (1.f / 512.f) + EPS); \
        const float n0 = p0 * rp, n1 = p1 * rp, n2 = p2 * rp, n3 = p3 * rp, n4 = q0 * rq, n5 = q1 * rq, n6 = q2 * rq, n7 = q3 * rq;     \
        const f32x4 b0 = a0 * ra, b1 = a1 * ra; \
        float am = fmaxf(fmaxf(fmaxf(fabsf(n0), fabsf(n1)), fmaxf(fabsf(n2), fabsf(n3))), fmaxf(fmaxf(fabsf(n4), fabsf(n5)), fmaxf(fabsf(n6), fabsf(n7)))); \
        am = fmaxf(am, fmaxf(fmaxf(fmaxf(fabsf(b0.x), fabsf(b0.y)), fmaxf(fabsf(b0.z), fabsf(b0.w))), fmaxf(fmaxf(fabsf(b1.x), fabsf(b1.y)), fmaxf(fabsf(b1.z), fabsf(b1.w))))); \
        am = wave_max(am); const float qi = am > 0.f ? 127.f * __builtin_amdgcn_rcpf(am) : 0.f;     \
        unsigned char* mr8 = C.ws + WS_MIX + (size_t)tc_ * 1024; \
        *(unsigned*)(mr8 + 4 * lane) = pk4_i8(n0 * qi, n1 * qi, n2 * qi, n3 * qi); \
        *(unsigned*)(mr8 + 256 + 4 * lane) = pk4_i8(n4 * qi, n5 * qi, n6 * qi, n7 * qi); \
        *(u32x2*)(mr8 + 512 + 8 * lane) = (u32x2){pk4_i8(b0.x * qi, b0.y * qi, b0.z * qi, b0.w * qi), pk4_i8(b1.x * qi, b1.y * qi, b1.z * qi, b1.w * qi)}; \
        if (lane == 0) WSP(float, WS_MS)[tc_] = am * (1.f / 127.f); } while (0)
    MnIn cur[4], nxt[4]; MN_LD(cur[0], t);
#pragma unroll
    for (int k = 1; k < 4; ++k) { cur[k] = cur[0]; if (t + k * stride < T) MN_LD(cur[k], t + k * stride); }
    for (; t < T; t += 4 * stride) {
#pragma unroll
        for (int k = 0; k < 4; ++k) { nxt[k] = cur[k]; if (t + (4 + k) * stride < T) MN_LD(nxt[k], t + (4 + k) * stride); }
#pragma unroll
        for (int k = 0; k < 4; ++k) if (t + k * stride < T) MN_BODY(cur[k], t + k * stride, T);
#pragma unroll
        for (int k = 0; k < 4; ++k) cur[k] = nxt[k];
    }
#undef MN_LD
#undef MN_BODY
}
#else
__device__ __forceinline__ void ph_mixnorm(const Ctx& C, int l) {
    const bf16_t* ymix = WSP(bf16_t, WS_YMIX); const float* ya = WSP(float, WS_YATT); bf16_t* mix = WSP(bf16_t, WS_MIX);
    const int lane = C.lane, stride = C.G * NWAVE; int t = C.bid * NWAVE + C.wave;
    if (t >= T) return;
    u32x2 pn = *(const u32x2*)(ymix + (size_t)t * 512 + 4 * lane), qn = *(const u32x2*)(ymix + (size_t)t * 512 + 256 + 4 * lane);
#if YATT_BF16
#define YA_LD(TT) (*(const u32x4*)((const bf16_t*)ya + (size_t)(TT) * 512 + 8 * lane))
    u32x4 an = YA_LD(t);
    u32x2 pn2 = pn, qn2 = qn; u32x4 an2 = an;
    if (t + stride < T) { const int tn = t + stride;
        pn2 = *(const u32x2*)(ymix + (size_t)tn * 512 + 4 * lane); qn2 = *(const u32x2*)(ymix + (size_t)tn * 512 + 256 + 4 * lane); an2 = YA_LD(tn); }
    for (; t < T; t += stride) {
        const u32x2 p = pn, q = qn; const u32x4 aw = an;
        const f32x4 a0 = (f32x4){bflo(aw.x), bfhi(aw.x), bflo(aw.y), bfhi(aw.y)}, a1 = (f32x4){bflo(aw.z), bfhi(aw.z), bflo(aw.w), bfhi(aw.w)};
        pn = pn2; qn = qn2; an = an2;
        if (t + 2 * stride < T) { const int tn = t + 2 * stride;
            pn2 = *(const u32x2*)(ymix + (size_t)tn * 512 + 4 * lane); qn2 = *(const u32x2*)(ymix + (size_t)tn * 512 + 256 + 4 * lane); an2 = YA_LD(tn); }
#undef YA_LD
#else
    f32x4 a0n = *(const f32x4*)(ya + (size_t)t * 512 + 8 * lane), a1n = *(const f32x4*)(ya + (size_t)t * 512 + 8 * lane + 4);
    u32x2 pn2 = pn, qn2 = qn; f32x4 a0n2 = a0n, a1n2 = a1n;
    if (t + stride < T) { const int tn = t + stride;
        pn2 = *(const u32x2*)(ymix + (size_t)tn * 512 + 4 * lane); qn2 = *(const u32x2*)(ymix + (size_t)tn * 512 + 256 + 4 * lane);
        a0n2 = *(const f32x4*)(ya + (size_t)tn * 512 + 8 * lane); a1n2 = *(const f32x4*)(ya + (size_t)tn * 512 + 8 * lane + 4); }
    for (; t < T; t += stride) {
        const u32x2 p = pn, q = qn; const f32x4 a0 = a0n, a1 = a1n;
        pn = pn2; qn = qn2; a0n = a0n2; a1n = a1n2;
        if (t + 2 * stride < T) { const int tn = t + 2 * stride;
            pn2 = *(const u32x2*)(ymix + (size_t)tn * 512 + 4 * lane); qn2 = *(const u32x2*)(ymix + (size_t)tn * 512 + 256 + 4 * lane);
            a0n2 = *(const f32x4*)(ya + (size_t)tn * 512 + 8 * lane); a1n2 = *(const f32x4*)(ya + (size_t)tn * 512 + 8 * lane + 4); }
#endif
        const float p0 = bflo(p.x), p1 = bfhi(p.x), p2 = bflo(p.y), p3 = bfhi(p.y), q0 = bflo(q.x), q1 = bfhi(q.x), q2 = bflo(q.y), q3 = bfhi(q.y);
        const float rp = rsqrtf(wave_sum((p0 * p0 + p1 * p1) + (p2 * p2 + p3 * p3)) * (1.f / 256.f) + EPS);
        const float rq = rsqrtf(wave_sum((q0 * q0 + q1 * q1) + (q2 * q2 + q3 * q3)) * (1.f / 256.f) + EPS);
        const float ra = rsqrtf(wave_sum((a0.x * a0.x + a0.y * a0.y) + (a0.z * a0.z + a0.w * a0.w) + (a1.x * a1.x + a1.y * a1.y) + (a1.z * a1.z + a1.w * a1.w)) * (1.f / 512.f) + EPS);
#if OUTPROJ_FP8
        unsigned char* mr8 = C.ws + WS_MIX + (size_t)t * 1024;
        *(unsigned*)(mr8 + 4 * lane) = pk4_fp8(p0 * rp, p1 * rp, p2 * rp, p3 * rp);
        *(unsigned*)(mr8 + 256 + 4 * lane) = pk4_fp8(q0 * rq, q1 * rq, q2 * rq, q3 * rq);
        *(u32x2*)(mr8 + 512 + 8 * lane) = (u32x2){pk4_fp8(a0.x * ra, a0.y * ra, a0.z * ra, a0.w * ra), pk4_fp8(a1.x * ra, a1.y * ra, a1.z * ra, a1.w * ra)};
#elif DENSE_I8
        { const float n0 = p0 * rp, n1 = p1 * rp, n2 = p2 * rp, n3 = p3 * rp, n4 = q0 * rq, n5 = q1 * rq, n6 = q2 * rq, n7 = q3 * rq;
          const f32x4 b0 = a0 * ra, b1 = a1 * ra;
          float am = fmaxf(fmaxf(fmaxf(fabsf(n0), fabsf(n1)), fmaxf(fabsf(n2), fabsf(n3))), fmaxf(fmaxf(fabsf(n4), fabsf(n5)), fmaxf(fabsf(n6), fabsf(n7))));
          am = fmaxf(am, fmaxf(fmaxf(fmaxf(fabsf(b0.x), fabsf(b0.y)), fmaxf(fabsf(b0.z), fabsf(b0.w))), fmaxf(fmaxf(fabsf(b1.x), fabsf(b1.y)), fmaxf(fabsf(b1.z), fabsf(b1.w)))));
          am = wave_max(am); const float qi = am > 0.f ? 127.f * __builtin_amdgcn_rcpf(am) : 0.f;
          unsigned char* mr8 = C.ws + WS_MIX + (size_t)t * 1024;
          *(unsigned*)(mr8 + 4 * lane) = pk4_i8(n0 * qi, n1 * qi, n2 * qi, n3 * qi);
          *(unsigned*)(mr8 + 256 + 4 * lane) = pk4_i8(n4 * qi, n5 * qi, n6 * qi, n7 * qi);
          *(u32x2*)(mr8 + 512 + 8 * lane) = (u32x2){pk4_i8(b0.x * qi, b0.y * qi, b0.z * qi, b0.w * qi), pk4_i8(b1.x * qi, b1.y * qi, b1.z * qi, b1.w * qi)};
          if (lane == 0) WSP(float, WS_MS)[t] = am * (1.f / 127.f); }
#else
        bf16_t* mr = mix + (size_t)t * 1024;
        *(u32x2*)(mr + 4 * lane) = (u32x2){pk2(p0 * rp, p1 * rp), pk2(p2 * rp, p3 * rp)};
        *(u32x2*)(mr + 256 + 4 * lane) = (u32x2){pk2(q0 * rq, q1 * rq), pk2(q2 * rq, q3 * rq)};
        *(u32x4*)(mr + 512 + 8 * lane) = (u32x4){pk2(a0.x * ra, a0.y * ra), pk2(a0.z * ra, a0.w * ra), pk2(a1.x * ra, a1.y * ra), pk2(a1.z * ra, a1.w * ra)};
#endif
    }
}
#endif
__device__ __forceinline__ void ph_outproj(const Ctx& C, int l) {
    const bf16_t* mix = WSP(bf16_t, WS_MIX); const bf16_t* W = WSP(bf16_t, WS_WO) + (size_t)l * 1024 * 1024;
    const float* xin = (l == 0) ? C.x : C.out; float* xo = C.out;
    for (int u = C.bid; u < 256 * 8; u += C.G) { const int rt = u / 8, ct = u % 8;
        sg_tile<1>(C, [&](int r) { return mix + (size_t)(rt * 128 + r) * 1024; }, W + (size_t)ct * 128 * 1024, nullptr, 1024,
                   [&](int r, int c, float v, float) { const size_t o = (size_t)(rt * 128 + r) * 1024 + ct * 128 + c; xo[o] = xin[o] + v; });
    }
}
typedef float f32x16_r __attribute__((ext_vector_type(16)));
__device__ __forceinline__ void ph_route(const Ctx& C, int l, int dummy = 0) {
    const bf16_t* x = WSP(bf16_t, WS_XB); const bf16_t* Wh = WSP(bf16_t, WS_WR) + (size_t)(l * 2) * 32 * 1024; const bf16_t* Wl = Wh + 32 * 1024;
    int* ltok = dummy ? WSP(int, WS_YB) : WSP(int, WS_LTOK); float* lgate = dummy ? WSP(float, WS_YB + 8 * MiB) : WSP(float, WS_LGATE); unsigned* asg = dummy ? WSP(unsigned, WS_YB + 16 * MiB) : WSP(unsigned, WS_ASG);
    unsigned* gcnt = WSP(unsigned, WS_CTL) + CW_GCNT + l * NEXP * 64 + (dummy ? 8192 : 0);
    constexpr int XROW = 2064;
    LAS unsigned char* xt = C.lds;
    LAS float* red = (LAS float*)(C.lds + 66048);
    LAS float* lg = (LAS float*)(C.lds + 98816);
    LAS float* rsv = (LAS float*)(C.lds + 102912);
    LAS float* tmpv = (LAS float*)(C.lds + 107520) + C.wave * 16;
    LAS int* sel_e = (LAS int*)(C.lds + 103424);
    LAS float* sel_g = (LAS float*)(C.lds + 105472);
    LAS int* ctl = (LAS int*)(C.lds + LDS_CTL);
    const int lane = C.lane, w = C.wave, tid = C.tid, r32 = lane & 31, hi = lane >> 5;
    bf16x8 ah[8], al[8];
#pragma unroll
    for (int ks = 0; ks < 8; ++ks) { ah[ks] = *(const bf16x8*)(Wh + (size_t)r32 * 1024 + 128 * w + 16 * ks + 8 * hi); al[ks] = *(const bf16x8*)(Wl + (size_t)r32 * 1024 + 128 * w + 16 * ks + 8 * hi); }
    const float* bias = WSP(float, WS_PAR) + P_BR + l * 32;
    for (int chunk = C.bid; chunk < T / 128; chunk += C.G) {
        const int tok0 = chunk * 128;
        if (tid < 32) ctl[96 + tid] = 0;
        u32x4 q[4][2];
#pragma unroll
        for (int i = 0; i < 4; ++i) { const u32x4* xr = (const u32x4*)(x + (size_t)(tok0 + 4 * w + i) * DM + 16 * lane); q[i][0] = xr[0]; q[i][1] = xr[1]; }
        for (int tile = 0; tile < 4; ++tile) {
#pragma unroll
            for (int i = 0; i < 4; ++i) { const int t = tok0 + 32 * tile + 4 * w + i; const u32x4 a = q[i][0], b = q[i][1];
                float v[16] = {bflo(a.x), bfhi(a.x), bflo(a.y), bfhi(a.y), bflo(a.z), bfhi(a.z), bflo(a.w), bfhi(a.w), bflo(b.x), bfhi(b.x), bflo(b.y), bfhi(b.y), bflo(b.z), bfhi(b.z), bflo(b.w), bfhi(b.w)};
                float ss = 0.f;
#pragma unroll
                for (int j = 0; j < 16; ++j) ss += v[j] * v[j];
                const float rs = rsqrtf(wave_sum(ss) * (1.f / DM) + EPS);
                *(u32x4*)(C.ws + WS_HB8 + (size_t)t * 1024 + 16 * lane) = (u32x4){pk4_fp8(v[0] * rs, v[1] * rs, v[2] * rs, v[3] * rs), pk4_fp8(v[4] * rs, v[5] * rs, v[6] * rs, v[7] * rs),
                                                                                 pk4_fp8(v[8] * rs, v[9] * rs, v[10] * rs, v[11] * rs), pk4_fp8(v[12] * rs, v[13] * rs, v[14] * rs, v[15] * rs)};
                LAS u32x4* dst = (LAS u32x4*)(xt + (4 * w + i) * XROW + 32 * lane); dst[0] = a; dst[1] = b;
                if (lane == 0) rsv[4 * w + i] = rs; }
            if (tile < 3) {
#pragma unroll
                for (int i = 0; i < 4; ++i) { const u32x4* xr = (const u32x4*)(x + (size_t)(tok0 + 32 * (tile + 1) + 4 * w + i) * DM + 16 * lane); q[i][0] = xr[0]; q[i][1] = xr[1]; } }
            __syncthreads();
            { f32x16_r d = {};
#pragma unroll
              for (int h4 = 0; h4 < 2; ++h4) { bf16x8 bxa[4];
#pragma unroll
                  for (int c = 0; c < 4; ++c) bxa[c] = *(const LAS bf16x8*)(xt + r32 * XROW + (128 * w + 16 * (4 * h4 + c) + 8 * hi) * 2);
                  __builtin_amdgcn_sched_barrier(0);
#pragma unroll
                  for (int c = 0; c < 4; ++c) { const int ks = 4 * h4 + c;
                      d = __builtin_amdgcn_mfma_f32_32x32x16_bf16(ah[ks], bxa[c], d, 0, 0, 0); d = __builtin_amdgcn_mfma_f32_32x32x16_bf16(al[ks], bxa[c], d, 0, 0, 0); } }
#pragma unroll
              for (int r = 0; r < 16; ++r) red[(w * 16 + r) * 64 + lane] = d[r]; }
            __syncthreads();
            { const int tk = tid & 31, hi_ = (tid >> 5) & 1, r0 = tid >> 6; const float rs = rsv[tk];
#pragma unroll
              for (int rr = 0; rr < 2; ++rr) { const int r = r0 + 8 * rr; float sm = 0.f;
#pragma unroll
                  for (int ww = 0; ww < 8; ++ww) sm += red[(ww * 16 + r) * 64 + tk + 32 * hi_];
                  const int e = (r & 3) + 8 * (r >> 2) + 4 * hi_; lg[tk * 32 + e] = sm * rs + bias[e]; } }
            __syncthreads();
            float mine4[4]; int rank4[4];
#pragma unroll
            for (int i = 0; i < 4; ++i) { const int tk = 4 * w + i, e = lane & 31; const float mine = lg[tk * 32 + e]; int rank = 0;
#pragma unroll
                for (int h4 = 0; h4 < 2; ++h4) { f32x4 qa[4];
#pragma unroll
                    for (int c = 0; c < 4; ++c) qa[c] = *(const LAS f32x4*)(lg + tk * 32 + 16 * h4 + 4 * c);
                    __builtin_amdgcn_sched_barrier(0);
#pragma unroll
                    for (int c = 0; c < 4; ++c) { const f32x4 qv = qa[c]; const int c4 = 4 * h4 + c;
                        rank += (qv.x > mine || (qv.x == mine && 4 * c4 + 0 < e)) ? 1 : 0; rank += (qv.y > mine || (qv.y == mine && 4 * c4 + 1 < e)) ? 1 : 0;
                        rank += (qv.z > mine || (qv.z == mine && 4 * c4 + 2 < e)) ? 1 : 0; rank += (qv.w > mine || (qv.w == mine && 4 * c4 + 3 < e)) ? 1 : 0; } }
                mine4[i] = mine; rank4[i] = rank;
                if (lane < 32 && rank < 4) tmpv[4 * i + rank] = mine; }
            asm volatile("s_waitcnt lgkmcnt(0)" ::: "memory");
#pragma unroll
            for (int i = 0; i < 4; ++i) { const int tk = 4 * w + i, e = lane & 31, rank = rank4[i]; const float mine = mine4[i];
                const f32x4 tv = *(const LAS f32x4*)(tmpv + 4 * i);
                const float inv = __builtin_amdgcn_rcpf(1.f + __expf(tv.y - tv.x) + __expf(tv.z - tv.x) + __expf(tv.w - tv.x));
                if (lane < 32 && rank < 4) { const int tl = 32 * tile + tk; sel_e[tl * 4 + rank] = e; sel_g[tl * 4 + rank] = __expf(mine - tv.x) * inv; } }
        }
        __syncthreads();
        const int e = sel_e[tid]; const float gt = sel_g[tid];
        const int rank = __hip_atomic_fetch_add(&ctl[96 + e], 1, __ATOMIC_RELAXED, __HIP_MEMORY_SCOPE_WORKGROUP);
        __syncthreads();
        if (tid < 32) ctl[128 + tid] = (int)__hip_atomic_fetch_add(gcnt + tid * 64, (unsigned)ctl[96 + tid], __ATOMIC_RELAXED, __HIP_MEMORY_SCOPE_AGENT);
        __syncthreads();
        const int slot = ctl[128 + e] + rank, tok = tok0 + (tid >> 2);
        ltok[(size_t)e * T + slot] = tok; lgate[(size_t)tok * 4 + (tid & 3)] = gt; asg[(size_t)tok * 4 + (tid & 3)] = ((unsigned)e << 24) | (unsigned)slot;
        __syncthreads();
    }
}
__device__ __forceinline__ void ph_gateup(const Ctx& C, int l) {
    moe_tables(C, l);
    LAS int* ctl = (LAS int*)(C.lds + LDS_CTL);
    const bf16_t* hb = WSP(bf16_t, WS_HB); const int* ltok = WSP(int, WS_LTOK); bf16_t* act = WSP(bf16_t, WS_ACT);
    const int nrt = ctl[32 + NEXP];
    for (int u = C.bid; u < nrt * 2 * 8; u += C.G) { const int rt128 = u >> 3, pn = u & 7, rt = rt128 >> 1, sub = rt128 & 1;
        const int e = moe_find_expert(C, rt), cnt = ctl[e], lrow0 = (rt - ctl[32 + e]) * 256 + sub * 128;
        const bf16_t* W = WSP(bf16_t, WS_WGU) + ((size_t)(l * NEXP + e) * 2048 + pn * 256) * 1024;
        const float* bg = WSP(float, WS_PAR) + P_BGU + (size_t)(l * NEXP + e) * 2048;
        const size_t arow0 = (size_t)rt * 256 + sub * 128;
        sg_tile<2>(C, [&](int r) { const int li = lrow0 + r; const int tok = (li < cnt) ? ltok[(size_t)e * T + li] : 0; return hb + (size_t)tok * 1024; }, W, W + (size_t)128 * 1024, 1024,
                   [&](int r, int c, float vg, float vl) { const int j = pn * 128 + c; vg += bg[2 * j]; vl += bg[2 * j + 1];
                       const float xg = fminf(vg, 7.f), xl = fminf(fmaxf(vl, -7.f), 7.f);
                       act[(arow0 + r) * 1024 + j] = (bf16_t)f2bf(xg * sigmoidf_(1.702f * xg) * (xl + 1.f)); });
    }
}
__device__ __forceinline__ void ph_down(const Ctx& C, int l) {
    moe_tables(C, l);
    LAS int* ctl = (LAS int*)(C.lds + LDS_CTL);
    const bf16_t* act = WSP(bf16_t, WS_ACT); const float* lgate = WSP(float, WS_LGATE); bf16_t* yb = WSP(bf16_t, WS_YB);
    const int nrt = ctl[32 + NEXP];
    for (int u = C.bid; u < nrt * 2 * 8; u += C.G) { const int rt128 = u >> 3, ct = u & 7, rt = rt128 >> 1, sub = rt128 & 1;
        const int e = moe_find_expert(C, rt), cnt = ctl[e], lrow0 = (rt - ctl[32 + e]) * 256 + sub * 128;
        const bf16_t* W = WSP(bf16_t, WS_WD) + ((size_t)(l * NEXP + e) * 1024 + ct * 128) * 1024;
        const float* bd = WSP(float, WS_PAR) + P_BDN + (size_t)(l * NEXP + e) * 1024;
        const size_t arow0 = (size_t)rt * 256 + sub * 128;
        sg_tile<1>(C, [&](int r) { return act + (arow0 + r) * 1024; }, W, nullptr, 1024,
                   [&](int r, int c, float v, float) { const int li = lrow0 + r; const float g = (li < cnt) ? lgate[(size_t)e * T + li] : 0.f;
                       yb[(arow0 + r) * 1024 + ct * 128 + c] = (bf16_t)f2bf((v + bd[ct * 128 + c]) * g); });
    }
}
static_assert(MOE_FP8 == 1, "the combine phase reads the expert outputs as fp8 x16 (the MOE_FP8 path)");
struct CmbIn { u32x4 x0, x1; u32x4 y[4]; f32x4 g; };
__device__ __forceinline__ CmbIn cmb_load(const Ctx& C, int t, u32x4 a4, int lane) {
    LAS int* ctl = (LAS int*)(C.lds + LDS_CTL); CmbIn r;
    const u32x4* xr = (const u32x4*)(WSP(bf16_t, WS_XB) + (size_t)t * DM + 16 * lane); r.x0 = xr[0]; r.x1 = xr[1]; r.g = *(const f32x4*)(WSP(float, WS_LGATE) + (size_t)t * 4); int rb[4];
#pragma unroll
    for (int k = 0; k < 4; ++k) rb[k] = ctl[32 + (a4[k] >> 24)];
    __builtin_amdgcn_sched_barrier(0);
#pragma unroll
    for (int k = 0; k < 4; ++k) { const unsigned a = a4[k]; const int slot = a & 0xffffff; const size_t row = (size_t)rb[k] * 256 + slot;
        r.y[k] = *(const u32x4*)(C.ws + WS_YB + row * 1024 + 16 * lane); }
    return r;
}
__device__ __forceinline__ void ph_combine(const Ctx& C, int l, float ysc = 1.f, bool have_tab = false) {
    if (!have_tab) moe_tables(C, l);
    const unsigned* asg = WSP(unsigned, WS_ASG); bf16_t* xb = WSP(bf16_t, WS_XB);
    const int lane = C.lane; const bool last_layer = (l == NLAYER - 1) && ysc == 1.f;
    const int stride = C.G * NWAVE; int t = C.bid * NWAVE + C.wave;
    if (t >= T) return;
    auto body = [&](const CmbIn& in, int tt) {
        f32x4 v[4];
        v[0] = (f32x4){bflo(in.x0.x), bfhi(in.x0.x), bflo(in.x0.y), bfhi(in.x0.y)}; v[1] = (f32x4){bflo(in.x0.z), bfhi(in.x0.z), bflo(in.x0.w), bfhi(in.x0.w)};
        v[2] = (f32x4){bflo(in.x1.x), bfhi(in.x1.x), bflo(in.x1.y), bfhi(in.x1.y)}; v[3] = (f32x4){bflo(in.x1.z), bfhi(in.x1.z), bflo(in.x1.w), bfhi(in.x1.w)};
#pragma unroll
        for (int k = 0; k < 4; ++k) { const float sc = ysc * (1.f / g8::YB_SCALE) * in.g[k];
#pragma unroll
            for (int j = 0; j < 4; ++j) { const f32x2 lo = __builtin_amdgcn_cvt_pk_f32_fp8((int)in.y[k][j], false), hi = __builtin_amdgcn_cvt_pk_f32_fp8((int)in.y[k][j], true);
                v[j].x += sc * lo.x; v[j].y += sc * lo.y; v[j].z += sc * hi.x; v[j].w += sc * hi.y; } }
        if (last_layer) { f32x4* o = (f32x4*)(C.out + (size_t)tt * DM + 16 * lane);
#pragma unroll
            for (int j = 0; j < 4; ++j) o[j] = v[j];
            return; }
        float s = 0.f;
#pragma unroll
        for (int j = 0; j < 4; ++j) s += (v[j].x * v[j].x + v[j].y * v[j].y) + (v[j].z * v[j].z + v[j].w * v[j].w);
        u32x4* xr = (u32x4*)(xb + (size_t)tt * DM + 16 * lane);
        xr[0] = (u32x4){pk2(v[0].x, v[0].y), pk2(v[0].z, v[0].w), pk2(v[1].x, v[1].y), pk2(v[1].z, v[1].w)};
        xr[1] = (u32x4){pk2(v[2].x, v[2].y), pk2(v[2].z, v[2].w), pk2(v[3].x, v[3].y), pk2(v[3].z, v[3].w)};
        const float rs = rsqrtf(wave_sum(s) * (1.f / DM) + EPS);
#if DENSE_I8
        { float am = 0.f;
#pragma unroll
          for (int j = 0; j < 4; ++j) am = fmaxf(am, fmaxf(fmaxf(fabsf(v[j].x), fabsf(v[j].y)), fmaxf(fabsf(v[j].z), fabsf(v[j].w))));
          am = wave_max(am); const float qi = am > 0.f ? 127.f * __builtin_amdgcn_rcpf(am) : 0.f;
          *(u32x4*)(C.ws + WS_XQ + (size_t)tt * DM + 16 * lane) = (u32x4){pk4_i8(v[0].x * qi, v[0].y * qi, v[0].z * qi, v[0].w * qi), pk4_i8(v[1].x * qi, v[1].y * qi, v[1].z * qi, v[1].w * qi),
                                                                            pk4_i8(v[2].x * qi, v[2].y * qi, v[2].z * qi, v[2].w * qi), pk4_i8(v[3].x * qi, v[3].y * qi, v[3].z * qi, v[3].w * qi)};
          if (lane == 0) WSP(float, WS_RS)[tt] = rs * am * (1.f / 127.f); }
#else
        if (lane == 0) WSP(float, WS_RS)[tt] = rs;
#endif
    };
    const u32x4 a_t0 = *(const u32x4*)(asg + (size_t)t * 4);
    CmbIn cur[2], nxt[2]; u32x4 aw[2] = {a_t0, a_t0};
    cur[0] = cmb_load(C, t, a_t0, lane); cur[1] = cur[0];
    if (t + stride < T) { const u32x4 a1 = *(const u32x4*)(asg + (size_t)(t + stride) * 4); cur[1] = cmb_load(C, t + stride, a1, lane); }
    if (t + 2 * stride < T) aw[0] = *(const u32x4*)(asg + (size_t)(t + 2 * stride) * 4);
    if (t + 3 * stride < T) aw[1] = *(const u32x4*)(asg + (size_t)(t + 3 * stride) * 4);
    for (; t < T; t += 2 * stride) {
        nxt[0] = cur[0]; nxt[1] = cur[1];
        if (t + 2 * stride < T) nxt[0] = cmb_load(C, t + 2 * stride, aw[0], lane);
        if (t + 3 * stride < T) nxt[1] = cmb_load(C, t + 3 * stride, aw[1], lane);
        if (t + 4 * stride < T) aw[0] = *(const u32x4*)(asg + (size_t)(t + 4 * stride) * 4);
        if (t + 5 * stride < T) aw[1] = *(const u32x4*)(asg + (size_t)(t + 5 * stride) * 4);
        body(cur[0], t);
        if (t + stride < T) body(cur[1], t + stride);
        cur[0] = nxt[0]; cur[1] = nxt[1];
    }
}

#ifndef FAST_INPROJ
#define FAST_INPROJ 1
#endif
#ifndef FAST_SMALL
#define FAST_SMALL 1
#endif
#ifndef FAST_OUTPROJ
#define FAST_OUTPROJ 1
#endif
#ifndef FAST_GATEUP
#define FAST_GATEUP 1
#endif
#ifndef FAST_DOWN
#define FAST_DOWN 1
#endif
#ifndef G8_SP2
#define G8_SP2 true
#endif
#ifndef G8_ALIGN
#define G8_ALIGN true
#endif
__device__ __forceinline__ void ph_inproj_f(const Ctx& C, int l) {
#if DENSE_I8
    const g8::DenseSched S{C.ws + WS_XQ, C.ws + WS_WIN + (size_t)l * DINP * 1024, 1024, 1024, T / 256, DINP / 256, C.G, C.bid, 1};
    const g8::EpiI8Rs E{WSP(bf16_t, WS_Z), DINP, WSP(float, WS_RS), (const float*)(WSP(unsigned, WS_CTL) + CW_WQ + 32 + (2 * l) * 1280)};
    g8::gemm_phase<g8::EpiI8Rs, g8::DenseSched, G8_ALIGN, G8_SP2, false, 0, true>(C.lds, 1024, S, E);
#else
    const g8::DenseSched S{C.ws + WS_XB, C.ws + WS_WIN + (size_t)l * DINP * 1024 * 2, 1024, 1024, T / 256, DINP / 256, C.G, C.bid, 2};
    const g8::EpiBf16Rs E{WSP(bf16_t, WS_Z), DINP, WSP(float, WS_RS)};
    g8::gemm_phase<g8::EpiBf16Rs, g8::DenseSched, G8_ALIGN, G8_SP2>(C.lds, 1024, S, E);
#endif
}
__device__ __forceinline__ void ph_mixgemm_f(const Ctx& C, int l) {
    const g8::DenseSched S{C.ws + WS_A2, C.ws + WS_WMIX + (size_t)l * 512 * 512 * 2, 512, 512, T / 256, 2, C.G, C.bid, 2};
    const g8::EpiBf16 E{WSP(bf16_t, WS_YMIX), 512, WSP(float, WS_PAR) + P_MIXB + l * 512};
    g8::gemm_phase<g8::EpiBf16, g8::DenseSched, G8_ALIGN, G8_SP2>(C.lds, 512, S, E);
}
__device__ __forceinline__ void ph_qkvgemm_f(const Ctx& C, int l) {
    { const g8::DenseSched S{C.ws + WS_Z + 768 * 2, C.ws + WS_WQ + (size_t)l * 768 * 256 * 2, DINP, 256, T / 256, 3, C.G, C.bid, 2};
      const g8::EpiBf16 E{WSP(bf16_t, WS_QRAW), 768, nullptr};
      g8::gemm_phase<g8::EpiBf16, g8::DenseSched, G8_ALIGN, G8_SP2>(C.lds, 256, S, E); }
    { const g8::DenseSched S{C.ws + WS_Z + 1024 * 2, C.ws + WS_WKV + (size_t)l * 1024 * 128 * 2, DINP, 128, T / 256, 4, C.G, C.bid, 2};
      const g8::EpiBf16 E{WSP(bf16_t, WS_KVRAW), 1024, nullptr};
      int kk_ = 128; asm volatile("" : "+s"(kk_));
      g8::gemm_phase<g8::EpiBf16, g8::DenseSched, G8_ALIGN, G8_SP2>(C.lds, kk_, S, E); }
}
__device__ __forceinline__ void ph_smallgemm_f(const Ctx& C, int l) { ph_mixgemm_f(C, l); ph_qkvgemm_f(C, l); }
__device__ __forceinline__ void ph_outproj_f(const Ctx& C, int l) {
#if OUTPROJ_FP8
    const g8::DenseSched S{C.ws + WS_MIX, C.ws + WS_WO + (size_t)l * 1024 * 1024, 1024, 1024, T / 256, 4, C.G, C.bid, 1};
    const g8::EpiResF32 E{(l == 0) ? C.x : C.out, C.out, 1024, 1.f / 32.f};
    g8::gemm_phase<g8::EpiResF32, g8::DenseSched, G8_ALIGN, G8_SP2, true>(C.lds, 1024, S, E);
#elif DENSE_I8
    const g8::DenseSched S{C.ws + WS_MIX, C.ws + WS_WO + (size_t)l * 1024 * 1024, 1024, 1024, T / 256, 4, C.G, C.bid, 1};
    const g8::EpiI8Res E{WSP(bf16_t, WS_XB), WSP(bf16_t, WS_XB), WSP(float, WS_MS), (const float*)(WSP(unsigned, WS_CTL) + CW_WQ + 32 + (2 * l + 1) * 1280)};
    g8::gemm_phase<g8::EpiI8Res, g8::DenseSched, G8_ALIGN, G8_SP2, false, 0, true>(C.lds, 1024, S, E);
#else
    const g8::DenseSched S{C.ws + WS_MIX, C.ws + WS_WO + (size_t)l * 1024 * 1024 * 2, 1024, 1024, T / 256, 4, C.G, C.bid, 2};
    const g8::EpiResBf16 E{nullptr, WSP(bf16_t, WS_XB), WSP(bf16_t, WS_XB)};
    g8::gemm_phase<g8::EpiResBf16, g8::DenseSched, G8_ALIGN, G8_SP2>(C.lds, 1024, S, E);
#endif
}
template <int PM = 0> __device__ __forceinline__ void ph_gateup_f(const Ctx& C, int l) {
    moe_tables(C, l);
    LAS const int* ctl = (LAS const int*)(C.lds + LDS_CTL);
    LAS unsigned short* tokt = (LAS unsigned short*)(C.lds + LDS_TOKT); LAS float* btab = (LAS float*)(C.lds + LDS_BIAST); constexpr int NTAB = 28, NBT = 17;
    g8::MoeSched<true, 1024> S{C.ws + WS_HB8, C.ws + WS_WGU + (size_t)l * NEXP * 2048 * 1024, WSP(int, WS_LTOK), ctl, 8, C.G, C.bid, tokt, 0, 0};
    const float* bgu_l = WSP(float, WS_PAR) + P_BGU + (size_t)l * NEXP * 2048;
    int nu = 0;
    for (int i = 0; i < NTAB; ++i) { int pm, pn, e, rb; if (!S.locate(i, pm, pn, e, rb)) break; nu = i + 1;
        if (C.tid < 256) { const int li = (pm - rb) * 256 + C.tid, nv = ctl[e]; tokt[i * 256 + C.tid] = (unsigned short)S.ltok[(size_t)e * T + (li < nv ? li : nv - 1)]; }
        else if (i < NBT) btab[i * 256 + (C.tid - 256)] = bgu_l[(size_t)e * 2048 + pn * 256 + (C.tid - 256)]; }
    S.ntab = nu;
    __syncthreads();
    const g8::EpiGlu8 E{C.ws + (PM ? 1600 * MiB : WS_ACT), bgu_l, btab, nu < NBT ? nu : NBT};
    if constexpr (PM == 3) { const g8::MoeSched<false, 1024> S2{C.ws + WS_HB8, C.ws + WS_WGU + (size_t)l * NEXP * 2048 * 1024, WSP(int, WS_LTOK), ctl, 8, C.G, C.bid, nullptr, 0, PROBE_FIX};
        g8::gemm_phase<g8::EpiGlu8, g8::MoeSched<false, 1024>, G8_ALIGN, G8_SP2, true, 1>(C.lds, 1024, S2, E); }
    else g8::gemm_phase<g8::EpiGlu8, g8::MoeSched<true, 1024>, G8_ALIGN, G8_SP2, true, PM>(C.lds, 1024, S, E);
}
template <int PM = 0> __device__ __forceinline__ void ph_down_f(const Ctx& C, int l, bool have_tab = false) {
    if (!have_tab) moe_tables(C, l);
    LAS const int* ctl = (LAS const int*)(C.lds + LDS_CTL);
    LAS float* btab = (LAS float*)(C.lds + LDS_BIAST); constexpr int NBT = 17;
    const g8::MoeSched<false, 1024> S{C.ws + WS_ACT, C.ws + WS_WD + (size_t)l * NEXP * 1024 * 1024, WSP(int, WS_LTOK), ctl, 4, C.G, C.bid, nullptr, 0, PM ? PROBE_FIX : 0};
    const float* bdn_l = WSP(float, WS_PAR) + P_BDN + (size_t)l * NEXP * 1024;
    int nu = 0;
    for (int i = 0; i < NBT; ++i) { int pm, pn, e, rb; if (!S.locate(i, pm, pn, e, rb)) break; nu = i + 1;
        if (C.tid < 256) btab[i * 256 + C.tid] = bdn_l[(size_t)e * 1024 + pn * 256 + C.tid]; }
    __syncthreads();
    const g8::EpiDown8 E{C.ws + (PM ? 1600 * MiB : WS_YB), bdn_l, btab, nu};
    g8::gemm_phase<g8::EpiDown8, g8::MoeSched<false, 1024>, G8_ALIGN, G8_SP2, true, PM>(C.lds, 1024, S, E);
}

#define XB_TMO      128
#define XB_XCNT(j)  (256  + 64 * (j))
#define XB_XSUB(j)  (1280 + 64 * (j))
#define XB_XGEN(j)  (2304 + 64 * (j))
#define XB_TOP      3328
#define XB_TOPGEN   3392
#define XCD_BAR_WORDS 3456
#define XB_SPIN_CAP (1u << 24)

__device__ __forceinline__ unsigned xb_ld(unsigned* p)              { return __hip_atomic_load(p, __ATOMIC_RELAXED, __HIP_MEMORY_SCOPE_AGENT); }
__device__ __forceinline__ unsigned xb_add(unsigned* p, unsigned v) { return __hip_atomic_fetch_add(p, v, __ATOMIC_RELAXED, __HIP_MEMORY_SCOPE_AGENT); }
__device__ __forceinline__ unsigned xb_xcc_id() { return (unsigned)__builtin_amdgcn_s_getreg((3 << 11) | 20) & 0xFu; }
#define XB_SPIN(cond, bar) do { unsigned _sp = 0; while (cond) { __builtin_amdgcn_s_sleep(1); \
    if ((++_sp & 255u) == 0u) { if (xb_ld(&(bar)[XB_TMO])) break; if (_sp > XB_SPIN_CAP) { atomicAdd(&(bar)[XB_TMO], 1u); break; } } } } while (0)

struct XcdBarrier {
    unsigned* bar; unsigned x;
    volatile LAS unsigned* st;
};

__device__ __forceinline__ XcdBarrier xcd_barrier_post(unsigned* bar, volatile LAS unsigned* st) {
    XcdBarrier b; b.bar = bar; b.x = xb_xcc_id(); b.st = st;
    if (threadIdx.x == 0) (void)xb_add(&bar[XB_XCNT(b.x)], 1u);
    return b;
}
__device__ __forceinline__ void xcd_barrier_complete(unsigned* bar, unsigned x, unsigned& nloc, unsigned& nx) {
    const unsigned G = gridDim.x * gridDim.y * gridDim.z;
    unsigned sum, cnt, mine, sp = 0u;
    for (;;) {
        sum = 0u; cnt = 0u; mine = 0u;
#pragma unroll
        for (unsigned j = 0; j < 16; ++j) { const unsigned c = xb_ld(&bar[XB_XCNT(j)]); sum += c; cnt += (c > 0u) ? 1u : 0u; mine = (j == x) ? c : mine; }
        if (sum == G) break;
        __builtin_amdgcn_s_sleep(1);
        if ((++sp & 255u) == 0u) { if (xb_ld(&bar[XB_TMO])) break; if (sp > XB_SPIN_CAP) { atomicAdd(&bar[XB_TMO], 1u); break; } }
    }
    nloc = mine > 0u ? mine : 1u; nx = cnt > 0u ? cnt : 1u;
}

__device__ __forceinline__ void xcd_barrier(const XcdBarrier& b) {
    asm volatile("s_waitcnt vmcnt(0)" ::: "memory");
    __syncthreads();
    if (threadIdx.x == 0) {
        unsigned* bar = b.bar;
        __builtin_amdgcn_s_waitcnt(0);
        unsigned nloc = b.st[0], nx = b.st[1];
        if (nloc == 0u) { xcd_barrier_complete(bar, b.x, nloc, nx); b.st[0] = nloc; b.st[1] = nx; }
        const unsigned old = xb_add(&bar[XB_XSUB(b.x)], 1u);
        const unsigned gen = old / nloc;
        if (old + 1u == (gen + 1u) * nloc) {
            __builtin_amdgcn_fence(__ATOMIC_RELEASE, "agent");
            asm volatile("s_waitcnt vmcnt(0)" ::: "memory");
            const unsigned og = xb_add(&bar[XB_TOP], 1u);
            const unsigned tg = og / nx;
            if (og + 1u == (tg + 1u) * nx) xb_add(&bar[XB_TOPGEN], 1u);
            else XB_SPIN(xb_ld(&bar[XB_TOPGEN]) == tg, bar);
            __builtin_amdgcn_fence(__ATOMIC_ACQUIRE, "agent");
            xb_add(&bar[XB_XGEN(b.x)], 1u);
            asm volatile("s_waitcnt vmcnt(0)" ::: "memory");
        } else {
            XB_SPIN(xb_ld(&bar[XB_XGEN(b.x)]) == gen, bar);
            __builtin_amdgcn_fence(__ATOMIC_ACQUIRE, "agent");
            asm volatile("s_waitcnt vmcnt(0)" ::: "memory");
        }
    }
    __syncthreads();
}

constexpr int NPH = 11;
struct Args { const float* in[N_IN]; float* out; unsigned char* ws; int ph_lo, ph_hi; };
__global__ void __launch_bounds__(NTHR, 2) fwd(Args args) {
    extern __shared__ __attribute__((aligned(16))) unsigned char lds_raw[];
    Ctx C;
    C.x = args.in[I_X]; C.out = args.out; C.ws = args.ws; C.lds = (LAS unsigned char*)lds_raw;
    C.tid = threadIdx.x; C.lane = C.tid & 63; C.wave = __builtin_amdgcn_readfirstlane(C.tid >> 6); C.G = gridDim.x; C.bid = blockIdx.x;
    const int lo = args.ph_lo, hi = args.ph_hi;
    if (C.tid < 4) ((LAS unsigned*)(C.lds + LDS_CTL))[160 + C.tid] = 0u;
    __syncthreads();
    XcdBarrier bar = xcd_barrier_post(WSP(unsigned, WS_CTL) + CW_BAR, (volatile LAS unsigned*)(C.lds + LDS_CTL) + 160);
#define IN(k) (lo <= (k) && (k) < hi)
#ifndef PROBE_DUP
#define PROBE_DUP 0
#endif
#ifndef PROBE_PM
#define PROBE_PM 0
#endif
#ifndef PROBE_BAR2
#define PROBE_BAR2 0
#endif
#define DUPN(bit) (((PROBE_DUP) >> (bit)) & 1 ? 2 : 1)
#define SEAM(k) do { if (IN(k) && IN((k) + 1)) { XcdBarrier b2_ = bar; unsigned long long p_ = (unsigned long long)b2_.bar; asm volatile("" : "+s"(p_)); b2_.bar = (unsigned*)p_; xcd_barrier(b2_); if (PROBE_BAR2) xcd_barrier(b2_); } } while (0)
    if (IN(0)) for (int r_ = 0; r_ < DUPN(0); ++r_) { const Ctx L = phase_enter(C); ph_prologue(L, args.in); }
    SEAM(0);
    for (int l = 0; l < NLAYER; ++l) {
        const int p0 = 1 + l * NPH;
        if (IN(p0 + 0)) for (int r_ = 0; r_ < (DUPN(1)); ++r_) { const Ctx L = phase_enter(C);
#if FAST_INPROJ
            ph_inproj_f(L, l);
#else
            ph_inproj(L, l);
#endif
        }
        SEAM(p0 + 0);
        if (IN(p0 + 1)) { for (int r_ = 0; r_ < (DUPN(2)); ++r_) { const Ctx L = phase_enter(C); if (r_ == 0 && DUPN(2) == 2 && PROBE_PM) ph_mix1<PROBE_PM>(L, l); else ph_mix1<0>(L, l); }
            for (int r_ = 0; r_ < (DUPN(3)); ++r_) { const Ctx L = phase_enter(C); ph_qkvgemm_f(L, l); } }
        SEAM(p0 + 1);
        if (IN(p0 + 2)) { for (int r_ = 0; r_ < (DUPN(3)); ++r_) { const Ctx L = phase_enter(C); ph_mixgemm_f(L, l); }
            for (int r_ = 0; r_ < (DUPN(4)); ++r_) { const Ctx L = phase_enter(C); if (r_ == 0 && DUPN(4) == 2 && PROBE_PM) ph_qkfin<PROBE_PM>(L, l); else ph_qkfin<0>(L, l); }
#if ATT_PV8
            { const Ctx L = phase_enter(C); ph_vtbuild(L, l); }
#endif
        }
        if (IN(p0 + 2) && !IN(p0 + 3)) {   }
        SEAM(p0 + 3);
                if (IN(p0 + 4)) for (int r_ = 0; r_ < (DUPN(5)); ++r_) { const Ctx L = phase_enter(C); ph_attn(L, l); }
        SEAM(p0 + 4);
        if (IN(p0 + 5)) for (int r_ = 0; r_ < (DUPN(6)); ++r_) { const Ctx L = phase_enter(C); ph_mixnorm(L, l); }
        SEAM(p0 + 5);
        if (IN(p0 + 6)) for (int r_ = 0; r_ < (l == 0 ? DUPN(7) : 1); ++r_) { const Ctx L = phase_enter(C);
#if FAST_OUTPROJ
            ph_outproj_f(L, l);
#else
            ph_outproj(L, l);
#endif
        }
        SEAM(p0 + 6);
        if (IN(p0 + 7)) { if (DUPN(10) == 2) { const Ctx L = phase_enter(C); ph_route(L, l, 1); } const Ctx L = phase_enter(C); ph_route(L, l); }
        SEAM(p0 + 7);
        if (IN(p0 + 8)) for (int r_ = 0; r_ < (DUPN(8)); ++r_) { const Ctx L = phase_enter(C);
#if FAST_GATEUP
            if (r_ == 0 && DUPN(8) == 2 && PROBE_PM) ph_gateup_f<PROBE_PM>(L, l); else ph_gateup_f<0>(L, l);
#else
            ph_gateup(L, l);
#endif
        }
        SEAM(p0 + 8);
        if (IN(p0 + 9)) for (int r_ = 0; r_ < (DUPN(9)); ++r_) { const Ctx L = phase_enter(C);
#if FAST_DOWN
            if (r_ == 0 && DUPN(9) == 2 && PROBE_PM) ph_down_f<PROBE_PM>(L, l); else ph_down_f<0>(L, l, IN(p0 + 8));
#else
            ph_down(L, l);
#endif
        }
        SEAM(p0 + 9);
        if (IN(p0 + 10)) { if (DUPN(11) == 2) { { const Ctx L = phase_enter(C); ph_combine(L, l, 0.5f); } xcd_barrier(bar); { const Ctx L = phase_enter(C); ph_combine(L, l, 0.5f); } } else { const Ctx L = phase_enter(C); ph_combine(L, l, 1.f, IN(p0 + 8)); } }
        SEAM(p0 + 10);
    }
#undef SEAM
#undef IN
}

extern "C" void kernel_launch(void* const* d_in, const int* in_sizes, int n_in, void* d_out, int out_size, void* d_ws, size_t ws_size, hipStream_t stream) {
    static int grid = 0;
    if (grid == 0) {
        if (n_in != N_IN || in_sizes[0] != T * DM || out_size != T * DM || ws_size < WS_END) {
            fprintf(stderr, "kernel_launch: shape mismatch (n_in %d, in0 %d, out %d, ws %zu need %zu)\n", n_in, n_in > 0 ? in_sizes[0] : -1, out_size, ws_size, (size_t)WS_END); grid = -1; return; }
        int dev = 0, cus = 0;
        if (hipGetDevice(&dev) != hipSuccess || hipDeviceGetAttribute(&cus, hipDeviceAttributeMultiprocessorCount, dev) != hipSuccess) { grid = -1; return; }
        if (hipFuncSetAttribute((const void*)fwd, hipFuncAttributeMaxDynamicSharedMemorySize, LDS_BYTES) != hipSuccess) { fprintf(stderr, "kernel_launch: hipFuncSetAttribute failed\n"); grid = -1; return; }
        if (cus < 160) { fprintf(stderr, "kernel_launch: built for a >= 160-CU device (per-workgroup unit tables); %d CUs\n", cus); grid = -1; return; }
        grid = cus;
    }
    if (grid < 0) return;
    (void)hipMemsetAsync((char*)d_ws + WS_CTL, 0, CTL_ZERO_BYTES, stream);
    Args a{};
    for (int i = 0; i < N_IN; ++i) a.in[i] = (const float*)d_in[i];
    a.out = (float*)d_out; a.ws = (unsigned char*)d_ws;
    const int nphase = 1 + NLAYER * NPH;
#if defined(MK_PER_PHASE)
    for (int p = 0; p < nphase; ++p) { a.ph_lo = p; a.ph_hi = p + 1; hipLaunchKernelGGL(fwd, dim3(grid), dim3(NTHR), LDS_BYTES, stream, a); }
#else
    a.ph_lo = 0; a.ph_hi = nphase;
    hipLaunchKernelGGL(fwd, dim3(grid), dim3(NTHR), LDS_BYTES, stream, a);
#endif
}
```
